# Optimizing an MI355X kernel written in HIP

```python
import jax, jax.numpy as jnp
from jax import lax
import numpy as np

D_MODEL = 2048
BATCH = 8
SEQ = 2048
DEPTH = 4

N_META = 16
N_CONV_LAYERS = max(DEPTH // 2, 1)
N_ATTN_LAYERS = max(DEPTH - N_CONV_LAYERS, 1)
CONV_WIDTH = 3
N_HEADS = 16
HEAD_DIM = D_MODEL // N_HEADS
D_FF = ((8 * D_MODEL // 3 + 255) // 256) * 256
Q_BLOCK = 128
DEEPNORM_ALPHA = (2 * DEPTH) ** 0.25
DEEPNORM_BETA = (8 * DEPTH) ** -0.25
LN_EPS = 1e-5

kernel_name = "yoco_shortconv_stickbreaking_macaron"


def layer_norm(x, g, b):
    xf = x.astype(jnp.float32)
    mu = jnp.mean(xf, axis=-1, keepdims=True)
    var = jnp.mean(jnp.square(xf - mu), axis=-1, keepdims=True)
    y = (xf - mu) * lax.rsqrt(var + LN_EPS)
    return (y * g.astype(jnp.float32) + b.astype(jnp.float32)).astype(x.dtype)


def swiglu(x, w_in, w_out):
    hid = x @ w_in
    gate = hid[..., :D_FF]
    up = hid[..., D_FF:]
    return (jax.nn.silu(gate) * up) @ w_out


def short_conv_mixer(x, w_in, conv_w, conv_b, w_out):
    T = x.shape[1]
    D = x.shape[2]
    proj = x @ w_in
    b_gate = proj[..., :D]
    c_gate = proj[..., D:2 * D]
    u = proj[..., 2 * D:]
    v = c_gate * u
    vp = jnp.pad(v, ((0, 0), (CONV_WIDTH - 1, 0), (0, 0)))
    conv = vp[:, 0:T] * conv_w[0]
    for tap in range(1, CONV_WIDTH):
        conv = conv + vp[:, tap:tap + T] * conv_w[tap]
    conv = conv + conv_b
    return (b_gate * conv) @ w_out


def split_heads(t):
    bsz, T = t.shape[0], t.shape[1]
    return t.reshape(bsz, T, N_HEADS, HEAD_DIM).transpose(0, 2, 1, 3)


def block_bounds(T):
    bounds = [0]
    if T > N_META:
        bounds.append(N_META)
        pos = N_META + Q_BLOCK
        while pos < T:
            bounds.append(pos)
            pos += Q_BLOCK
    bounds.append(T)
    out = []
    for s, e in zip(bounds[:-1], bounds[1:]):
        if e > s:
            out.append((int(s), int(e)))
    return out


def stick_breaking_attention(q, k, v):
    T = q.shape[2]
    scale = HEAD_DIM ** -0.5
    outs = []
    for s, e in block_bounds(T):
        qb = q[:, :, s:e]
        kb = k[:, :, :e]
        vb = v[:, :, :e]
        z = jnp.einsum('bhqd,bhkd->bhqk', qb, kb).astype(jnp.float32) * scale
        tq = jnp.arange(s, e, dtype=jnp.int32)[:, None]
        tk = jnp.arange(0, e, dtype=jnp.int32)[None, :]
        causal = tk < tq
        ls_neg = jax.nn.log_sigmoid(-z)
        log_keep = jnp.where(causal, ls_neg, 0.0)
        log_survive = lax.cumsum(log_keep, axis=3, reverse=True) - log_keep
        a = jnp.where(causal, jnp.exp(z + ls_neg + log_survive), 0.0)
        outs.append(jnp.einsum('bhqk,bhkd->bhqd', a.astype(vb.dtype), vb))
    return jnp.concatenate(outs, axis=2)


def setup_inputs(seed: int = 0) -> dict:
    key = jax.random.key(seed)
    ks = jax.random.split(key, 13)
    f32 = jnp.float32
    d, F = D_MODEL, D_FF
    return {
        "x": jax.random.normal(ks[0], (BATCH, SEQ, d), f32),
        "meta_tokens": jax.random.normal(ks[1], (N_META, d), f32),
        "ln_gain": 1.0 + 0.02 * jax.random.normal(ks[2], (DEPTH, 3, d), f32),
        "ln_bias": 0.02 * jax.random.normal(ks[3], (DEPTH, 3, d), f32),
        "ffn_w_in": jax.random.normal(ks[4], (DEPTH, 2, d, 2 * F), f32) * d ** -0.5,
        "ffn_w_out": jax.random.normal(ks[5], (DEPTH, 2, F, d), f32) * (F ** -0.5 * DEEPNORM_BETA),
        "conv_w_in": jax.random.normal(ks[6], (N_CONV_LAYERS, d, 3 * d), f32) * d ** -0.5,
        "conv_w": jax.random.normal(ks[7], (N_CONV_LAYERS, CONV_WIDTH, d), f32) * CONV_WIDTH ** -0.5,
        "conv_b": 0.02 * jax.random.normal(ks[8], (N_CONV_LAYERS, d), f32),
        "conv_w_out": jax.random.normal(ks[9], (N_CONV_LAYERS, d, d), f32) * (d ** -0.5 * DEEPNORM_BETA),
        "sb_w_q": jax.random.normal(ks[10], (N_ATTN_LAYERS, d, d), f32) * d ** -0.5,
        "sb_w_kv": jax.random.normal(ks[11], (d, 2 * d), f32) * d ** -0.5,
        "sb_w_o": jax.random.normal(ks[12], (N_ATTN_LAYERS, d, d), f32) * (d ** -0.5 * DEEPNORM_BETA),
    }


def reference(x, meta_tokens, ln_gain, ln_bias, ffn_w_in, ffn_w_out, conv_w_in, conv_w,
              conv_b, conv_w_out, sb_w_q, sb_w_kv, sb_w_o):
    bsz = x.shape[0]
    meta = jnp.broadcast_to(meta_tokens[None].astype(x.dtype), (bsz, N_META, x.shape[2]))
    h = jnp.concatenate([meta, x], axis=1)
    k_shared = None
    v_shared = None
    for i in range(DEPTH):
        h = layer_norm(DEEPNORM_ALPHA * h + 0.5 * swiglu(h, ffn_w_in[i, 0], ffn_w_out[i, 0]),
                       ln_gain[i, 0], ln_bias[i, 0])
        if i < N_CONV_LAYERS:
            mix = short_conv_mixer(h, conv_w_in[i], conv_w[i], conv_b[i], conv_w_out[i])
        else:
            j = i - N_CONV_LAYERS
            q = split_heads(h @ sb_w_q[j])
            o = stick_breaking_attention(q, k_shared, v_shared)
            o = o.transpose(0, 2, 1, 3).reshape(h.shape)
            mix = o @ sb_w_o[j]
        h = layer_norm(DEEPNORM_ALPHA * h + mix, ln_gain[i, 1], ln_bias[i, 1])
        h = layer_norm(DEEPNORM_ALPHA * h + 0.5 * swiglu(h, ffn_w_in[i, 1], ffn_w_out[i, 1]),
                       ln_gain[i, 2], ln_bias[i, 2])
        if i == N_CONV_LAYERS - 1:
            kv = h @ sb_w_kv
            k_shared = split_heads(kv[..., :D_MODEL])
            v_shared = split_heads(kv[..., D_MODEL:])
    return h[:, N_META:]
```

```cpp
#include <hip/hip_runtime.h>
#include <cstdio>
#include <cstdint>

constexpr int D = 2048, NB = 8, SEQ = 2048, NMETA = 16, NH = 16, HD = 128, FF = 5632, FF2 = 11264, DEPTH = 4, NCONV = 2;
constexpr int MREAL = NB * SEQ;
constexpr int MROWS = MREAL + NMETA;
constexpr int MCAP = 16640;
constexpr int TS = 2080;
constexpr float ALPHA = 1.6817928305074290f, LN_EPS = 1e-5f, QSCALE = 0.08838834764831845f;

constexpr size_t MiB = 1u << 20;
constexpr size_t WS_CTL = 0, CTL_ZERO_BYTES = 1 * MiB;
constexpr size_t WS_W1T = 2 * MiB, W1T_BYTES = 44 * MiB;
constexpr size_t WS_W2T = WS_W1T + 8 * W1T_BYTES, W2T_BYTES = 22 * MiB;
constexpr size_t WS_WCIN = WS_W2T + 8 * W2T_BYTES, WCIN_BYTES = 24 * MiB;
constexpr size_t SQ_BYTES = 8 * MiB;
constexpr size_t WS_WCOUT = WS_WCIN + 2 * WCIN_BYTES;
constexpr size_t WS_WQ = WS_WCOUT + 2 * SQ_BYTES;
constexpr size_t WS_WO = WS_WQ + 2 * SQ_BYTES;
constexpr size_t WS_WKV = WS_WO + 2 * SQ_BYTES;
constexpr size_t WS_HB = WS_WKV + 16 * MiB;
constexpr size_t WS_X32 = WS_HB + 65 * MiB;
constexpr size_t WS_ACT = WS_X32 + 130 * MiB;
constexpr size_t ACT_SUB = 65 * MiB;
constexpr size_t WS_KB = WS_ACT + 195 * MiB;
constexpr size_t WS_VT = WS_KB + 65 * MiB;
constexpr size_t WS_END = WS_VT + 65 * MiB;
constexpr int CW_BAR = 4096;

constexpr int RING_OFF = 0, RING_BYTES = 131072;
constexpr int LDSCTL_OFF = RING_BYTES, MISC_OFF = LDSCTL_OFF + 320;
constexpr int LDS_BYTES = 147456;
constexpr int NWAVES = 8;

#define GAS __attribute__((address_space(1)))
#define LAS __attribute__((address_space(3)))
typedef unsigned short bf16_t;
typedef short bf16x8 __attribute__((ext_vector_type(8)));
typedef short s16x4 __attribute__((ext_vector_type(4)));
typedef float f32x4 __attribute__((ext_vector_type(4)));
typedef float f32x16 __attribute__((ext_vector_type(16)));
typedef unsigned u32x4 __attribute__((ext_vector_type(4)));
typedef unsigned u32x2 __attribute__((ext_vector_type(2)));
typedef __bf16 bf2_t __attribute__((ext_vector_type(2)));
typedef float f2_t __attribute__((ext_vector_type(2)));
__device__ __forceinline__ unsigned pk2(float lo, float hi) { f2_t v = {lo, hi}; bf2_t r = __builtin_convertvector(v, bf2_t); return __builtin_bit_cast(unsigned, r); }
__device__ __forceinline__ float bf_lo(unsigned w) { return __uint_as_float(w << 16); }
__device__ __forceinline__ float bf_hi(unsigned w) { return __uint_as_float(w & 0xffff0000u); }

namespace pg8 {
#define PG8_LAS __attribute__((address_space(3)))
constexpr int BM = 256, BK = 64, HALF = 128, HTB = HALF * BK * 2, STAGE_BYTES = 8 * HTB, NXCD = 8, WGM = 8;
__host__ __device__ __forceinline__ int lds_byte(int r, int c) { const int st = (r >> 4) * 2 + (c >> 5), rr = r & 15, cc = c & 31, ob = rr * 64 + cc * 2; return st * 1024 + (ob ^ (((ob >> 9) & 1) << 5)); }
__host__ __device__ __forceinline__ void stage_rc(int b, int& R, int& C) { const int st = b / 1024, sb = b % 1024, swz = sb ^ (((sb >> 9) & 1) << 5); R = (st >> 1) * 16 + swz / 64; C = (st & 1) * 32 + (swz % 64) / 2; }
__host__ __device__ __forceinline__ int perm32(int rho) { const int n = rho >> 4, i = rho & 15; return 8 * (i >> 2) + 4 * n + (i & 3); }
struct Unit { int pm, pn; };
struct Gemm { const bf16_t* A; const bf16_t* Bt; int M, N, K; };
struct StaticOrder {
    int nM, nN, nwg, G, c;
    __host__ __device__ void init(int M, int N, int G_, int c_) { nM = M / BM; nN = N / BM; nwg = nM * nN; G = G_; c = c_; }
    __host__ __device__ bool next(int i, Unit& u) const {
        const long L = (long)i * G + c; if (L >= nwg) return false;
        int wgid = (int)L; { const int q = nwg / NXCD, r = nwg % NXCD, xcd = wgid % NXCD, off = wgid / NXCD; wgid = (xcd < r ? xcd * (q + 1) : r * (q + 1) + (xcd - r) * q) + off; }
        const int nig = WGM * nN, gid = wgid / nig, fm = gid * WGM, gsz = (nM - fm) < WGM ? (nM - fm) : WGM;
        u.pm = fm + ((wgid % nig) % gsz); u.pn = (wgid % nig) / gsz; return true;
    }
    __device__ __forceinline__ void a_ready(const Unit&) const {}
    __device__ __forceinline__ void done(const Unit&) const {}
};

template <class Epi, class Sched, bool ALIGN_EPI = false, bool SP2 = false>
__device__ __forceinline__ void gemm_phase(PG8_LAS unsigned char* lds, const Gemm g, const Sched& S, const Epi& E) {
    int tid_ = threadIdx.x; asm volatile("" : "+v"(tid_));
    const int tid = tid_, wid = __builtin_amdgcn_readfirstlane(tid >> 6), lane = tid & 63, wr = wid >> 2, wc = wid & 3, fr = lane & 15, fq = lane >> 4;
    const int K = g.K, nt = K / BK;
    unsigned voffA[2], voffB[2];
#pragma unroll
    for (int i = 0; i < 2; ++i) { int R, C; stage_rc(tid * 16 + i * 8192, R, C); const int Rb = Epi::PERM ? ((R & ~31) + perm32(R & 31)) : R;
        voffA[i] = (unsigned)(R * K + C) * 2u; voffB[i] = (unsigned)(Rb * K + C) * 2u; }
    const size_t kstep = (size_t)(BK * 2);
    const size_t hstep = (size_t)HALF * K * 2;
    const size_t tstep = 2 * hstep;
    const unsigned ldsw = (unsigned)wid * 1024u;
    const int aoff = lds_byte(wr * 64 + fr, fq * 8), boff = lds_byte(wc * 32 + fr, fq * 8);
#define PG8_SA(b, h) (((b) * 2 + (h)) * HTB)
#define PG8_SB(b, h) ((4 + (b) * 2 + (h)) * HTB)
#define PG8_STAGE(bufoff, gbase, voff) do { _Pragma("unroll") for (int _i = 0; _i < 2; ++_i) \
        __builtin_amdgcn_global_load_lds((const unsigned*)((const char*)(gbase) + (voff)[_i]), (PG8_LAS unsigned*)(lds + (bufoff) + ldsw + _i * 8192), 16, 0, 0); } while (0)
#define PG8_LDA(dst, b, h) do { _Pragma("unroll") for (int m = 0; m < 4; ++m) _Pragma("unroll") for (int k = 0; k < 2; ++k) dst[m][k] = *(const PG8_LAS bf16x8*)(lds + PG8_SA(b, h) + aoff + m * 2048 + k * 1024); } while (0)
#define PG8_LDB(dst, b, h) do { _Pragma("unroll") for (int n = 0; n < 2; ++n) _Pragma("unroll") for (int k = 0; k < 2; ++k) dst[n][k] = *(const PG8_LAS bf16x8*)(lds + PG8_SB(b, h) + boff + n * 2048 + k * 1024); } while (0)
#define PG8_MMA(ai, bj, At, Bt) do { __builtin_amdgcn_s_setprio(1); _Pragma("unroll") for (int m = 0; m < 4; ++m) _Pragma("unroll") for (int n = 0; n < 2; ++n) _Pragma("unroll") for (int k = 0; k < 2; ++k) \
        acc[ai][bj][m][n] = __builtin_amdgcn_mfma_f32_16x16x32_bf16(Bt[n][k], At[m][k], acc[ai][bj][m][n], 0, 0, 0); __builtin_amdgcn_s_setprio(0); } while (0)
#define PG8_WAIT_V(n) asm volatile("s_waitcnt vmcnt(" #n ")" ::: "memory")
#define PG8_WAIT_L(n) asm volatile("s_waitcnt lgkmcnt(" #n ")" ::: "memory")
#define PG8_BAR __builtin_amdgcn_s_barrier()
#define PG8_SCHED __builtin_amdgcn_sched_barrier(0)
    Unit cur, nxt; int ui = 0;
    if (!S.next(0, cur)) return;
    f32x4 acc[2][2][4][2];
#pragma unroll
    for (int a = 0; a < 2; ++a)
#pragma unroll
        for (int b = 0; b < 2; ++b)
#pragma unroll
            for (int m = 0; m < 4; ++m)
#pragma unroll
                for (int n = 0; n < 2; ++n) acc[a][b][m][n] = (f32x4){0.f, 0.f, 0.f, 0.f};
    bf16x8 At[4][2], B0[2][2], B1[2][2];
    const char* cA = (const char*)g.A + (size_t)cur.pm * tstep; const char* cB = (const char*)g.Bt + (size_t)cur.pn * tstep;
    S.a_ready(cur);
    if constexpr (SP2) {
        PG8_STAGE(PG8_SB(0, 0), cB, voffB); PG8_STAGE(PG8_SB(0, 1), cB + hstep, voffB); PG8_STAGE(PG8_SA(0, 0), cA, voffA); PG8_STAGE(PG8_SA(0, 1), cA + hstep, voffA);
        if (wr == 1) PG8_BAR;
        PG8_WAIT_V(2); PG8_BAR;
        PG8_STAGE(PG8_SB(1, 0), cB + kstep, voffB); PG8_STAGE(PG8_SA(1, 0), cA + kstep, voffA); PG8_STAGE(PG8_SB(1, 1), cB + hstep + kstep, voffB);
        PG8_WAIT_V(6); PG8_BAR;
    } else {
        PG8_STAGE(PG8_SB(0, 0), cB, voffB); PG8_STAGE(PG8_SA(0, 0), cA, voffA); PG8_STAGE(PG8_SB(0, 1), cB + hstep, voffB); PG8_STAGE(PG8_SA(0, 1), cA + hstep, voffA);
        if (wr == 1) PG8_BAR;
        PG8_WAIT_V(4); PG8_BAR;
        PG8_STAGE(PG8_SB(1, 0), cB + kstep, voffB); PG8_STAGE(PG8_SA(1, 0), cA + kstep, voffA); PG8_STAGE(PG8_SB(1, 1), cB + hstep + kstep, voffB);
        PG8_WAIT_V(6); PG8_BAR;
    }
    for (;;) {
        const bool has_next = S.next(ui + 1, nxt);
        const char* nA = has_next ? (const char*)g.A + (size_t)nxt.pm * tstep : cA; const char* nB = has_next ? (const char*)g.Bt + (size_t)nxt.pn * tstep : cB;
        for (int t = 0; t < nt; t += 2) {
            const bool last = (t == nt - 2);
            const char* a1 = cA + (size_t)(t + 1) * kstep;
            const char* a2 = last ? nA : cA + (size_t)(t + 2) * kstep; const char* b2 = last ? nB : cB + (size_t)(t + 2) * kstep;
            const char* a3 = a2 + kstep; const char* b3 = b2 + kstep;
            if (last && has_next) S.a_ready(nxt);
            if constexpr (SP2) {
            PG8_LDB(B0, 0, 0); PG8_LDB(B1, 0, 1); PG8_SCHED; PG8_LDA(At, 0, 0); PG8_STAGE(PG8_SA(1, 1), a1 + hstep, voffA);
            PG8_WAIT_V(8); PG8_WAIT_L(0); PG8_BAR; PG8_MMA(0, 0, At, B0); PG8_MMA(0, 1, At, B1); PG8_BAR; PG8_SCHED;
            PG8_LDA(At, 0, 1); PG8_STAGE(PG8_SB(0, 0), b2, voffB); PG8_STAGE(PG8_SB(0, 1), b2 + hstep, voffB); PG8_STAGE(PG8_SA(0, 0), a2, voffA);
            PG8_WAIT_V(8); PG8_WAIT_L(0); PG8_BAR; PG8_MMA(1, 0, At, B0); PG8_MMA(1, 1, At, B1); PG8_BAR; PG8_SCHED;
            PG8_LDB(B0, 1, 0); PG8_LDB(B1, 1, 1); PG8_SCHED; PG8_LDA(At, 1, 0); PG8_STAGE(PG8_SA(0, 1), a2 + hstep, voffA);
            PG8_WAIT_V(8); PG8_WAIT_L(0); PG8_BAR; PG8_MMA(0, 0, At, B0); PG8_MMA(0, 1, At, B1); PG8_BAR; PG8_SCHED;
            PG8_LDA(At, 1, 1); PG8_STAGE(PG8_SB(1, 0), b3, voffB); PG8_STAGE(PG8_SB(1, 1), b3 + hstep, voffB); PG8_STAGE(PG8_SA(1, 0), a3, voffA);
            PG8_WAIT_V(8); PG8_WAIT_L(0); PG8_BAR; PG8_MMA(1, 0, At, B0); PG8_MMA(1, 1, At, B1); PG8_BAR; PG8_SCHED;
            } else {
            PG8_LDB(B0, 0, 0); PG8_SCHED; PG8_LDA(At, 0, 0); PG8_STAGE(PG8_SA(1, 1), a1 + hstep, voffA);
            PG8_WAIT_L(8); PG8_BAR; PG8_WAIT_L(0); PG8_MMA(0, 0, At, B0); PG8_BAR; PG8_SCHED;
            PG8_LDB(B1, 0, 1); PG8_STAGE(PG8_SB(0, 0), b2, voffB);
            PG8_BAR; PG8_WAIT_L(0); PG8_MMA(0, 1, At, B1); PG8_BAR;
            PG8_LDA(At, 0, 1); PG8_STAGE(PG8_SA(0, 0), a2, voffA);
            PG8_BAR; PG8_WAIT_L(0); PG8_MMA(1, 0, At, B0); PG8_BAR; PG8_SCHED;
            PG8_STAGE(PG8_SB(0, 1), b2 + hstep, voffB);
            PG8_WAIT_V(6); PG8_BAR; PG8_MMA(1, 1, At, B1); PG8_BAR;
            PG8_LDB(B0, 1, 0); PG8_SCHED; PG8_LDA(At, 1, 0); PG8_STAGE(PG8_SA(0, 1), a2 + hstep, voffA);
            PG8_WAIT_L(8); PG8_BAR; PG8_WAIT_L(0); PG8_MMA(0, 0, At, B0); PG8_BAR; PG8_SCHED;
            PG8_LDB(B1, 1, 1); PG8_STAGE(PG8_SB(1, 0), b3, voffB);
            PG8_BAR; PG8_WAIT_L(0); PG8_MMA(0, 1, At, B1); PG8_BAR;
            PG8_LDA(At, 1, 1); PG8_STAGE(PG8_SA(1, 0), a3, voffA);
            PG8_BAR; PG8_WAIT_L(0); PG8_MMA(1, 0, At, B0); PG8_BAR; PG8_SCHED;
            PG8_STAGE(PG8_SB(1, 1), b3 + hstep, voffB);
            PG8_WAIT_V(6); PG8_BAR; PG8_MMA(1, 1, At, B1); PG8_BAR;
            }
        }
        if constexpr (ALIGN_EPI) { if (wr == 0) PG8_BAR; }
        E(acc, cur, wr, wc, fr, fq);
        if (!has_next) break;
#pragma unroll
        for (int a = 0; a < 2; ++a)
#pragma unroll
            for (int b = 0; b < 2; ++b)
#pragma unroll
                for (int m = 0; m < 4; ++m)
#pragma unroll
                    for (int n = 0; n < 2; ++n) acc[a][b][m][n] = (f32x4){0.f, 0.f, 0.f, 0.f};
        cur = nxt; cA = nA; cB = nB; ++ui;
        if constexpr (ALIGN_EPI) { if (wr == 1) PG8_BAR; }
    }
    PG8_WAIT_V(0);
    if constexpr (!ALIGN_EPI) { if (wr == 0) PG8_BAR; }
    PG8_BAR;
#undef PG8_SA
#undef PG8_SB
#undef PG8_STAGE
#undef PG8_LDA
#undef PG8_LDB
#undef PG8_MMA
#undef PG8_WAIT_V
#undef PG8_WAIT_L
#undef PG8_BAR
#undef PG8_SCHED
}
}

__device__ __forceinline__ float silu_mul(float g, float u) { return g * u * __builtin_amdgcn_rcpf(1.0f + __builtin_amdgcn_exp2f(-1.4426950408889634f * g)); }
__device__ __forceinline__ f32x4 silu_mul4(f32x4 g, f32x4 u) { return (f32x4){silu_mul(g[0], u[0]), silu_mul(g[1], u[1]), silu_mul(g[2], u[2]), silu_mul(g[3], u[3])}; }
__device__ __forceinline__ u32x2 pk4(f32x4 v) { u32x2 w; w.x = pk2(v[0], v[1]); w.y = pk2(v[2], v[3]); return w; }

struct EpiSwiglu {
    static constexpr bool PERM = true;
    bf16_t* O;
    __device__ __forceinline__ void operator()(const f32x4 (&acc)[2][2][4][2], const pg8::Unit& u, int wr, int wc, int fr, int fq) const {
        const int row0 = u.pm * 256 + wr * 64 + fr, col0 = u.pn * 128 + wc * 32 + 8 * fq;
#pragma unroll
        for (int ai = 0; ai < 2; ++ai)
#pragma unroll
            for (int m = 0; m < 4; ++m) { bf16_t* p = O + (size_t)(row0 + ai * 128 + m * 16) * FF + col0;
                const u32x2 a = pk4(silu_mul4(acc[ai][0][m][0], acc[ai][1][m][0])), b = pk4(silu_mul4(acc[ai][0][m][1], acc[ai][1][m][1]));
                *(u32x4*)p = (u32x4){a.x, a.y, b.x, b.y}; }
    }
    __device__ __forceinline__ void meta(int r, int col, f32x4 g, f32x4 up) const { *(u32x2*)(O + (size_t)(MREAL + r) * FF + col) = pk4(silu_mul4(g, up)); }
};
struct EpiResid {
    static constexpr bool PERM = false;
    float* X; float coef;
    __device__ __forceinline__ void operator()(const f32x4 (&acc)[2][2][4][2], const pg8::Unit& u, int wr, int wc, int fr, int fq) const {
        const int row0 = u.pm * 256 + wr * 64 + fr, col0 = u.pn * 256 + wc * 32 + 4 * fq;
#pragma unroll
        for (int ai = 0; ai < 2; ++ai)
#pragma unroll
            for (int m = 0; m < 4; ++m) { float* p = X + (size_t)(row0 + ai * 128 + m * 16) * D + col0;
                f32x4 h[2][2];
#pragma unroll
                for (int bj = 0; bj < 2; ++bj)
#pragma unroll
                    for (int n = 0; n < 2; ++n) h[bj][n] = *(const f32x4*)(p + bj * 128 + n * 16);
#pragma unroll
                for (int bj = 0; bj < 2; ++bj)
#pragma unroll
                    for (int n = 0; n < 2; ++n) *(f32x4*)(p + bj * 128 + n * 16) = h[bj][n] * ALPHA + acc[ai][bj][m][n] * coef;
                asm volatile("" ::: "memory"); }
    }
    __device__ __forceinline__ void meta(int r, int col, f32x4 a, f32x4) const { float* p = X + (size_t)(MREAL + r) * D + col; const f32x4 h = *(const f32x4*)p; *(f32x4*)p = h * ALPHA + a * coef; }
};
struct EpiConvIn {
    static constexpr bool PERM = true;
    bf16_t* V; bf16_t* BG;
    __device__ __forceinline__ void operator()(const f32x4 (&acc)[2][2][4][2], const pg8::Unit& u, int wr, int wc, int fr, int fq) const {
        const int row0 = u.pm * 256 + wr * 64 + fr;
        if (u.pn < 16) {
            const int col0 = u.pn * 128 + wc * 32 + 8 * fq;
#pragma unroll
            for (int ai = 0; ai < 2; ++ai)
#pragma unroll
                for (int m = 0; m < 4; ++m) { bf16_t* p = V + (size_t)(row0 + ai * 128 + m * 16) * D + col0;
                    const u32x2 a = pk4(acc[ai][0][m][0] * acc[ai][1][m][0]), b = pk4(acc[ai][0][m][1] * acc[ai][1][m][1]);
                    *(u32x4*)p = (u32x4){a.x, a.y, b.x, b.y}; }
        } else {
            const int col0 = (u.pn - 16) * 256 + wc * 32 + 8 * fq;
#pragma unroll
            for (int ai = 0; ai < 2; ++ai)
#pragma unroll
                for (int m = 0; m < 4; ++m) { bf16_t* p = BG + (size_t)(row0 + ai * 128 + m * 16) * D + col0;
#pragma unroll
                    for (int bj = 0; bj < 2; ++bj) { const u32x2 a = pk4(acc[ai][bj][m][0]), b = pk4(acc[ai][bj][m][1]); *(u32x4*)(p + bj * 128) = (u32x4){a.x, a.y, b.x, b.y}; } }
        }
    }
};
struct MetaConvV { bf16_t* V; __device__ __forceinline__ void meta(int r, int col, f32x4 c, f32x4 uu) const { *(u32x2*)(V + (size_t)(MREAL + r) * D + col) = pk4(c * uu); } };
struct EpiBf16S {
    static constexpr bool PERM = true;
    bf16_t* O; float scale;
    __device__ __forceinline__ void operator()(const f32x4 (&acc)[2][2][4][2], const pg8::Unit& u, int wr, int wc, int fr, int fq) const {
        const int row0 = u.pm * 256 + wr * 64 + fr, col0 = u.pn * 256 + wc * 32 + 8 * fq;
#pragma unroll
        for (int ai = 0; ai < 2; ++ai)
#pragma unroll
            for (int m = 0; m < 4; ++m) { bf16_t* p = O + (size_t)(row0 + ai * 128 + m * 16) * D + col0;
#pragma unroll
                for (int bj = 0; bj < 2; ++bj) { const u32x2 a = pk4(acc[ai][bj][m][0] * scale), b = pk4(acc[ai][bj][m][1] * scale); *(u32x4*)(p + bj * 128) = (u32x4){a.x, a.y, b.x, b.y}; } }
    }
    __device__ __forceinline__ void meta(int r, int col, f32x4 a, f32x4) const { *(u32x2*)(O + (size_t)(MREAL + r) * D + col) = pk4(a * scale); }
};
struct EpiKV {
    static constexpr bool PERM = true;
    bf16_t* KB; bf16_t* VT;
    __device__ __forceinline__ void operator()(const f32x4 (&acc)[2][2][4][2], const pg8::Unit& u, int wr, int wc, int fr, int fq) const {
        const int row0 = u.pm * 256 + wr * 64 + fr, d0 = wc * 32 + 8 * fq;
        if (u.pn < 8) {
#pragma unroll
            for (int ai = 0; ai < 2; ++ai)
#pragma unroll
                for (int m = 0; m < 4; ++m) { const int row = row0 + ai * 128 + m * 16, b = row >> 11, ts = 32 + (row & 2047);
#pragma unroll
                    for (int bj = 0; bj < 2; ++bj) { const int h = 2 * u.pn + bj; bf16_t* p = KB + ((size_t)(b * NH + h) * TS + ts) * HD + d0;
                        const u32x2 a = pk4(acc[ai][bj][m][0]), bq = pk4(acc[ai][bj][m][1]); *(u32x4*)p = (u32x4){a.x, a.y, bq.x, bq.y}; } }
        } else {
#pragma unroll
            for (int ai = 0; ai < 2; ++ai)
#pragma unroll
                for (int m = 0; m < 4; ++m) { const int row = row0 + ai * 128 + m * 16, b = row >> 11, ts = 32 + (row & 2047);
#pragma unroll
                    for (int bj = 0; bj < 2; ++bj) { const int h = 2 * (u.pn - 8) + bj; bf16_t* p = VT + ((size_t)(b * NH + h) * HD + d0) * TS + ts;
#pragma unroll
                        for (int n = 0; n < 2; ++n) { const u32x2 w = pk4(acc[ai][bj][m][n]);
                            p[(size_t)(4 * n + 0) * TS] = (bf16_t)(w.x & 0xffffu); p[(size_t)(4 * n + 1) * TS] = (bf16_t)(w.x >> 16);
                            p[(size_t)(4 * n + 2) * TS] = (bf16_t)(w.y & 0xffffu); p[(size_t)(4 * n + 3) * TS] = (bf16_t)(w.y >> 16); } } }
        }
    }
    __device__ __forceinline__ void meta(int r, int col, f32x4 a, f32x4) const {
        const u32x2 w = pk4(a); const int ts = 16 + r;
        if (col < D) { const int h = col >> 7, d = col & 127;
            for (int b = 0; b < NB; ++b) *(u32x2*)(KB + ((size_t)(b * NH + h) * TS + ts) * HD + d) = w;
        } else { const int c2 = col - D, h = c2 >> 7, d = c2 & 127;
            for (int b = 0; b < NB; ++b) { bf16_t* p = VT + ((size_t)(b * NH + h) * HD + d) * TS + ts;
                p[0] = (bf16_t)(w.x & 0xffffu); p[(size_t)TS] = (bf16_t)(w.x >> 16); p[(size_t)2 * TS] = (bf16_t)(w.y & 0xffffu); p[(size_t)3 * TS] = (bf16_t)(w.y >> 16); } }
    }
};

template <bool PAIR, class F>
__device__ __forceinline__ void meta_gemm(const bf16_t* A, int lda, const bf16_t* Bt, int K, int ncols, int gw, int ngw, int lane, const F& f) {
    const int fr = lane & 15, fq = lane >> 4, nunits = ncols >> 4;
    for (int u = gw; u < nunits; u += ngw) {
        int br0 = 16 * u, br1 = 0;
        if (PAIR) { const int j0 = 16 * u; br0 = 256 * (j0 >> 7) + (j0 & 127); br1 = br0 + 128; }
        const bf16_t* ap = A + (size_t)fr * lda + 8 * fq;
        const bf16_t* bp0 = Bt + (size_t)(br0 + fr) * K + 8 * fq;
        const bf16_t* bp1 = Bt + (size_t)(br1 + fr) * K + 8 * fq;
        f32x4 acc0 = {0.f, 0.f, 0.f, 0.f}, acc1 = {0.f, 0.f, 0.f, 0.f};
#pragma unroll 4
        for (int k0 = 0; k0 < K; k0 += 32) {
            const bf16x8 a = *(const bf16x8*)(ap + k0), b0 = *(const bf16x8*)(bp0 + k0);
            acc0 = __builtin_amdgcn_mfma_f32_16x16x32_bf16(b0, a, acc0, 0, 0, 0);
            if (PAIR) { const bf16x8 b1 = *(const bf16x8*)(bp1 + k0); acc1 = __builtin_amdgcn_mfma_f32_16x16x32_bf16(b1, a, acc1, 0, 0, 0); }
        }
        f.meta(fr, 16 * u + 4 * fq, acc0, acc1);
    }
}

#define XB_TMO      128
#define XB_XCNT(j)  (256  + 64 * (j))
#define XB_XSUB(j)  (1280 + 64 * (j))
#define XB_XGEN(j)  (2304 + 64 * (j))
#define XB_TOP      3328
#define XB_TOPGEN   3392
#define XCD_BAR_WORDS 3456
#define XB_SPIN_CAP (1u << 18)
__device__ __forceinline__ unsigned xb_ld(unsigned* p)              { return __hip_atomic_load(p, __ATOMIC_RELAXED, __HIP_MEMORY_SCOPE_AGENT); }
__device__ __forceinline__ unsigned xb_add(unsigned* p, unsigned v) { return __hip_atomic_fetch_add(p, v, __ATOMIC_RELAXED, __HIP_MEMORY_SCOPE_AGENT); }
__device__ __forceinline__ unsigned xb_xcc_id() { return (unsigned)__builtin_amdgcn_s_getreg((3 << 11) | 20) & 0xFu; }
#define XB_SPIN(cond, bar) do { unsigned _sp = 0; while (cond) { __builtin_amdgcn_s_sleep(1); \
    if ((++_sp & 255u) == 0u) { if (xb_ld(&(bar)[XB_TMO])) break; if (_sp > XB_SPIN_CAP) { atomicAdd(&(bar)[XB_TMO], 1u); break; } } } } while (0)
struct XcdBarrier { unsigned* bar; unsigned x; volatile LAS unsigned* st; };
__device__ __forceinline__ XcdBarrier xcd_barrier_post(unsigned* bar, volatile LAS unsigned* st) {
    XcdBarrier b; b.bar = bar; b.x = xb_xcc_id(); b.st = st;
    if (threadIdx.x == 0) (void)xb_add(&bar[XB_XCNT(b.x)], 1u);
    return b;
}
__device__ __forceinline__ void xcd_barrier_complete(unsigned* bar, unsigned x, unsigned& nloc, unsigned& nx) {
    const unsigned G = gridDim.x * gridDim.y * gridDim.z;
    unsigned sum, cnt, mine, sp = 0u;
    for (;;) {
        sum = 0u; cnt = 0u; mine = 0u;
#pragma unroll
        for (unsigned j = 0; j < 16; ++j) { const unsigned c = xb_ld(&bar[XB_XCNT(j)]); sum += c; cnt += (c > 0u) ? 1u : 0u; mine = (j == x) ? c : mine; }
        if (sum == G) break;
        __builtin_amdgcn_s_sleep(1);
        if ((++sp & 255u) == 0u) { if (xb_ld(&bar[XB_TMO])) break; if (sp > XB_SPIN_CAP) { atomicAdd(&bar[XB_TMO], 1u); break; } }
    }
    nloc = mine > 0u ? mine : 1u; nx = cnt > 0u ? cnt : 1u;
}
__device__ __forceinline__ void xcd_barrier(const XcdBarrier& b) {
    asm volatile("s_waitcnt vmcnt(0)" ::: "memory");
    __syncthreads();
    if (threadIdx.x == 0) {
        unsigned* bar = b.bar;
        __builtin_amdgcn_s_waitcnt(0);
        unsigned nloc = b.st[0], nx = b.st[1];
        if (nloc == 0u) { xcd_barrier_complete(bar, b.x, nloc, nx); b.st[0] = nloc; b.st[1] = nx; }
        const unsigned old = xb_add(&bar[XB_XSUB(b.x)], 1u);
        const unsigned gen = old / nloc;
        if (old + 1u == (gen + 1u) * nloc) {
            __builtin_amdgcn_fence(__ATOMIC_RELEASE, "agent");
            asm volatile("s_waitcnt vmcnt(0)" ::: "memory");
            const unsigned og = xb_add(&bar[XB_TOP], 1u);
            const unsigned tg = og / nx;
            if (og + 1u == (tg + 1u) * nx) xb_add(&bar[XB_TOPGEN], 1u);
            else XB_SPIN(xb_ld(&bar[XB_TOPGEN]) == tg, bar);
            __builtin_amdgcn_fence(__ATOMIC_ACQUIRE, "agent");
            xb_add(&bar[XB_XGEN(b.x)], 1u);
            asm volatile("s_waitcnt vmcnt(0)" ::: "memory");
        } else {
            XB_SPIN(xb_ld(&bar[XB_XGEN(b.x)]) == gen, bar);
            __builtin_amdgcn_fence(__ATOMIC_ACQUIRE, "agent");
            asm volatile("s_waitcnt vmcnt(0)" ::: "memory");
        }
    }
    __syncthreads();
}

struct Frame {
    LAS unsigned char* lds;
    int tid, lane, wave, vcu, G, gw, ngw;
    unsigned char* ws;
};
#define LDS_WAIT() asm volatile("s_waitcnt lgkmcnt(0)" ::: "memory")
__device__ __forceinline__ float wave_sum(float v) {
#pragma unroll
    for (int o = 1; o < 64; o <<= 1) v += __shfl_xor(v, o);
    return v;
}

__device__ __forceinline__ void transpose_item(const float* W, int K, int Nsrc, int srccol0, bf16_t* WT, int dstrow0, int k0, LAS float* scr, int lane) {
#pragma unroll 8
    for (int i = 0; i < 32; ++i) { const int kk = 2 * i + (lane >> 5); scr[kk * 33 + (lane & 31)] = W[(size_t)(k0 + kk) * Nsrc + srccol0 + (lane & 31)]; }
    LDS_WAIT(); asm volatile("" ::: "memory");
    const int c = lane & 7;
#pragma unroll
    for (int j = 0; j < 4; ++j) { const int n = (lane >> 3) + 8 * j; const LAS float* s = scr + (8 * c) * 33 + n;
        u32x4 o; o.x = pk2(s[0 * 33], s[1 * 33]); o.y = pk2(s[2 * 33], s[3 * 33]); o.z = pk2(s[4 * 33], s[5 * 33]); o.w = pk2(s[6 * 33], s[7 * 33]);
        *(u32x4*)(WT + (size_t)(dstrow0 + n) * K + k0 + 8 * c) = o; }
    LDS_WAIT(); asm volatile("" ::: "memory");
}
constexpr int IT_W1 = (D / 64) * (FF2 / 32), IT_W2 = (FF / 64) * (D / 32), IT_CIN = (D / 64) * (3 * D / 32), IT_SQ = (D / 64) * (D / 32), IT_KV = (D / 64) * (2 * D / 32);
constexpr int IT_END_W1 = 8 * IT_W1, IT_END_W2 = IT_END_W1 + 8 * IT_W2, IT_END_CIN = IT_END_W2 + 2 * IT_CIN, IT_END_COUT = IT_END_CIN + 2 * IT_SQ, IT_END_WQ = IT_END_COUT + 2 * IT_SQ,
              IT_END_WO = IT_END_WQ + 2 * IT_SQ, IT_TOTAL = IT_END_WO + IT_KV;
__device__ __forceinline__ void prologue_item(Frame& F, const float* w_in, const float* w_out, const float* cw_in, const float* cw_out, const float* wq, const float* wo, const float* wkv, int it, LAS float* scr) {
    const float* W; bf16_t* WT; int K, Nsrc, nb, kb, srccol0, dstrow0;
    if (it < IT_END_W1) { const int j = it / IT_W1, r = it % IT_W1; K = D; Nsrc = FF2; W = w_in + (size_t)j * D * FF2; WT = (bf16_t*)(F.ws + WS_W1T + (size_t)j * W1T_BYTES);
        nb = r / (D / 64); kb = r % (D / 64); dstrow0 = 32 * nb; const int pn = dstrow0 >> 8, c = dstrow0 & 255; srccol0 = (c < 128) ? (128 * pn + c) : (FF + 128 * pn + (c - 128)); }
    else if (it < IT_END_W2) { const int q = it - IT_END_W1, j = q / IT_W2, r = q % IT_W2; K = FF; Nsrc = D; W = w_out + (size_t)j * FF * D; WT = (bf16_t*)(F.ws + WS_W2T + (size_t)j * W2T_BYTES);
        nb = r / (FF / 64); kb = r % (FF / 64); dstrow0 = 32 * nb; srccol0 = dstrow0; }
    else if (it < IT_END_CIN) { const int q = it - IT_END_W2, j = q / IT_CIN, r = q % IT_CIN; K = D; Nsrc = 3 * D; W = cw_in + (size_t)j * D * 3 * D; WT = (bf16_t*)(F.ws + WS_WCIN + (size_t)j * WCIN_BYTES);
        nb = r / (D / 64); kb = r % (D / 64); dstrow0 = 32 * nb; const int pn = dstrow0 >> 8, c = dstrow0 & 255;
        srccol0 = (pn < 16) ? ((c < 128) ? (D + 128 * pn + c) : (2 * D + 128 * pn + (c - 128))) : (256 * (pn - 16) + c); }
    else if (it < IT_END_WO) { const int q = it - IT_END_CIN, j = q / IT_SQ, r = q % IT_SQ; K = D; Nsrc = D;
        const float* src = (j < 2) ? cw_out : (j < 4) ? wq : wo; const size_t wsoff = (j < 2) ? WS_WCOUT : (j < 4) ? WS_WQ : WS_WO; const int l = j & 1;
        W = src + (size_t)l * D * D; WT = (bf16_t*)(F.ws + wsoff + (size_t)l * SQ_BYTES);
        nb = r / (D / 64); kb = r % (D / 64); dstrow0 = 32 * nb; srccol0 = dstrow0; }
    else { const int r = it - IT_END_WO; K = D; Nsrc = 2 * D; W = wkv; WT = (bf16_t*)(F.ws + WS_WKV); nb = r / (D / 64); kb = r % (D / 64); dstrow0 = 32 * nb; srccol0 = dstrow0; }
    transpose_item(W, K, Nsrc, srccol0, WT, dstrow0, 64 * kb, scr, F.lane);
}
__device__ __forceinline__ void p0_prologue(Frame& F, const float* x, const float* meta, const float* w_in, const float* w_out, const float* cw_in, const float* cw_out, const float* wq, const float* wo, const float* wkv) {
    LAS float* scr = (LAS float*)(F.lds + RING_OFF + F.wave * 16384);
    for (int it = F.gw; it < IT_TOTAL; it += F.ngw) prologue_item(F, w_in, w_out, cw_in, cw_out, wq, wo, wkv, it, scr);
    float* X32 = (float*)(F.ws + WS_X32); bf16_t* HB = (bf16_t*)(F.ws + WS_HB);
    for (int row = F.gw; row < MROWS; row += F.ngw) {
        const float* src = (row < MREAL) ? x + (size_t)row * D : meta + (size_t)(row - MREAL) * D;
#pragma unroll
        for (int j = 0; j < 8; ++j) { const f32x4 v = *(const f32x4*)(src + 4 * F.lane + 256 * j);
            *(f32x4*)(X32 + (size_t)row * D + 4 * F.lane + 256 * j) = v; *(u32x2*)(HB + (size_t)row * D + 4 * F.lane + 256 * j) = pk4(v); }
    }
    bf16_t* KB = (bf16_t*)(F.ws + WS_KB); bf16_t* VT = (bf16_t*)(F.ws + WS_VT);
    for (int bh = F.gw; bh < NB * NH; bh += F.ngw) {
        for (int i = F.lane; i < 16 * HD / 8; i += 64) *(u32x4*)(KB + (size_t)bh * TS * HD + 8 * i) = (u32x4){0u, 0u, 0u, 0u};
        for (int i = F.lane; i < HD * 2; i += 64) *(u32x4*)(VT + ((size_t)bh * HD + (i >> 1)) * TS + 8 * (i & 1)) = (u32x4){0u, 0u, 0u, 0u};
    }
}

__device__ __forceinline__ void ln_phase(Frame& F, const float* gain, const float* bias, bool final_out, float* out) {
    float* X32 = (float*)(F.ws + WS_X32); bf16_t* HB = (bf16_t*)(F.ws + WS_HB);
    f32x4 g[8], bb[8];
#pragma unroll
    for (int j = 0; j < 8; ++j) { g[j] = *(const f32x4*)(gain + 4 * F.lane + 256 * j); bb[j] = *(const f32x4*)(bias + 4 * F.lane + 256 * j); }
    for (int row = F.gw; row < MROWS; row += F.ngw) {
        float* xr = X32 + (size_t)row * D + 4 * F.lane;
        f32x4 v[8]; float s = 0.f;
#pragma unroll
        for (int j = 0; j < 8; ++j) { v[j] = *(const f32x4*)(xr + 256 * j); s += (v[j][0] + v[j][1]) + (v[j][2] + v[j][3]); }
        const float mean = wave_sum(s) * (1.f / D); float s2 = 0.f;
#pragma unroll
        for (int j = 0; j < 8; ++j) { v[j] = v[j] - mean; s2 += (v[j][0] * v[j][0] + v[j][1] * v[j][1]) + (v[j][2] * v[j][2] + v[j][3] * v[j][3]); }
        const float rstd = 1.f / sqrtf(wave_sum(s2) * (1.f / D) + LN_EPS);
        if (final_out) {
            if (row < MREAL) { float* o = out + (size_t)row * D + 4 * F.lane;
#pragma unroll
                for (int j = 0; j < 8; ++j) *(f32x4*)(o + 256 * j) = v[j] * rstd * g[j] + bb[j]; }
        } else {
            bf16_t* hr = HB + (size_t)row * D + 4 * F.lane;
#pragma unroll
            for (int j = 0; j < 8; ++j) { const f32x4 y = v[j] * rstd * g[j] + bb[j]; *(f32x4*)(xr + 256 * j) = y; *(u32x2*)(hr + 256 * j) = pk4(y); }
        }
    }
}

__device__ __forceinline__ void unpack8(u32x4 w, float (&f)[8]) { f[0] = bf_lo(w.x); f[1] = bf_hi(w.x); f[2] = bf_lo(w.y); f[3] = bf_hi(w.y); f[4] = bf_lo(w.z); f[5] = bf_hi(w.z); f[6] = bf_lo(w.w); f[7] = bf_hi(w.w); }
__device__ __forceinline__ void conv_phase(Frame& F, const float* cw, const float* cb) {
    const bf16_t* V = (const bf16_t*)(F.ws + WS_ACT); const bf16_t* BG = (const bf16_t*)(F.ws + WS_ACT + ACT_SUB); bf16_t* GG = (bf16_t*)(F.ws + WS_ACT + 2 * ACT_SUB);
    for (int row = F.gw; row < MROWS; row += F.ngw) {
        const bf16_t* cur = V + (size_t)row * D; const bf16_t* p1 = cur; const bf16_t* p2 = cur; float m1 = 1.f, m2 = 1.f;
        if (row < MREAL) { const int t = row & (SEQ - 1);
            if (t >= 2) { p1 = cur - D; p2 = cur - 2 * D; }
            else if (t == 1) { p1 = cur - D; p2 = V + (size_t)(MREAL + 15) * D; }
            else { p1 = V + (size_t)(MREAL + 15) * D; p2 = V + (size_t)(MREAL + 14) * D; }
        } else { const int i = row - MREAL; if (i >= 1) p1 = cur - D; else m1 = 0.f; if (i >= 2) p2 = cur - 2 * D; else m2 = 0.f; }
#pragma unroll
        for (int j = 0; j < 4; ++j) { const int c0 = 8 * (F.lane + 64 * j);
            float a[8], b1[8], b2[8], bg[8];
            unpack8(*(const u32x4*)(cur + c0), a); unpack8(*(const u32x4*)(p1 + c0), b1); unpack8(*(const u32x4*)(p2 + c0), b2); unpack8(*(const u32x4*)(BG + (size_t)row * D + c0), bg);
            float o[8];
#pragma unroll
            for (int h = 0; h < 2; ++h) { const f32x4 w0 = *(const f32x4*)(cw + c0 + 4 * h), w1 = *(const f32x4*)(cw + D + c0 + 4 * h), w2 = *(const f32x4*)(cw + 2 * D + c0 + 4 * h), bbv = *(const f32x4*)(cb + c0 + 4 * h);
#pragma unroll
                for (int e = 0; e < 4; ++e) o[4 * h + e] = bg[4 * h + e] * (w0[e] * (b2[4 * h + e] * m2) + w1[e] * (b1[4 * h + e] * m1) + w2[e] * a[4 * h + e] + bbv[e]); }
            *(u32x4*)(GG + (size_t)row * D + c0) = (u32x4){pk2(o[0], o[1]), pk2(o[2], o[3]), pk2(o[4], o[5]), pk2(o[6], o[7])};
        }
    }
}

#ifndef ATTN_EARLY_EXIT
#define ATTN_EARLY_EXIT 1
#endif
__device__ __forceinline__ void attn_unit(Frame& F, const bf16_t* Qb, bf16_t* Ob, const bf16_t* KB, const bf16_t* VT, int b, int h, int qi) {
    const int lane = F.lane, ql = lane & 31, hh = lane >> 5;
    const bool qvalid = (qi > 0) || (ql >= 16);
    const int qrow = (qi > 0) ? (b * SEQ + 32 * (qi - 1) + ql) : (MREAL + (qvalid ? ql - 16 : 0));
    const bf16_t* qp = Qb + (size_t)qrow * D + h * HD + 8 * hh;
    bf16x8 qf[8];
#pragma unroll
    for (int s = 0; s < 8; ++s) qf[s] = *(const bf16x8*)(qp + 16 * s);
    const bf16_t* kbase = KB + (size_t)(b * NH + h) * TS * HD + (size_t)ql * HD + 8 * hh;
    const bf16_t* vbase = VT + ((size_t)(b * NH + h) * HD + ql) * TS + 4 * hh;
    f32x16 oacc[4];
#pragma unroll
    for (int i = 0; i < 4; ++i)
#pragma unroll
        for (int r = 0; r < 16; ++r) oacc[i][r] = 0.f;
    float C = qvalid ? 0.f : -1e30f;
    const int qs = 32 * qi + ql;
    for (int kt = qi; kt >= 0; --kt) {
        const bf16_t* kp = kbase + (size_t)(32 * kt) * HD;
        bf16x8 kf[8];
#pragma unroll
        for (int s = 0; s < 8; ++s) kf[s] = *(const bf16x8*)(kp + 16 * s);
        f32x16 z;
#pragma unroll
        for (int r = 0; r < 16; ++r) z[r] = 0.f;
#pragma unroll
        for (int s = 0; s < 8; ++s) z = __builtin_amdgcn_mfma_f32_32x32x16_bf16(kf[s], qf[s], z, 0, 0, 0);
        float lk[16], lb[16]; bool vld[16];
#pragma unroll
        for (int r = 0; r < 16; ++r) { const int ks = 32 * kt + (r & 3) + 8 * (r >> 2) + 4 * hh; vld[r] = (ks < qs) && (ks >= 16);
            const float zz = z[r], e = __expf(-fabsf(zz)), sp = fmaxf(zz, 0.f) + __logf(1.f + e); lb[r] = zz - sp; lk[r] = vld[r] ? -sp : 0.f; }
        float G[4], PG[4];
#pragma unroll
        for (int g = 0; g < 4; ++g) { G[g] = (lk[4 * g] + lk[4 * g + 1]) + (lk[4 * g + 2] + lk[4 * g + 3]); PG[g] = __shfl_xor(G[g], 32); }
        float suf[4]; suf[3] = 0.f; suf[2] = G[3] + PG[3]; suf[1] = suf[2] + (G[2] + PG[2]); suf[0] = suf[1] + (G[1] + PG[1]);
        const float TT = suf[0] + (G[0] + PG[0]);
        float a[16];
#pragma unroll
        for (int g = 0; g < 4; ++g) { const float base = C + suf[g] + (hh == 0 ? PG[g] : 0.f);
            const float s3 = 0.f, s2 = lk[4 * g + 3], s1 = s2 + lk[4 * g + 2], s0 = s1 + lk[4 * g + 1];
            a[4 * g + 0] = vld[4 * g + 0] ? __expf(lb[4 * g + 0] + base + s0) : 0.f; a[4 * g + 1] = vld[4 * g + 1] ? __expf(lb[4 * g + 1] + base + s1) : 0.f;
            a[4 * g + 2] = vld[4 * g + 2] ? __expf(lb[4 * g + 2] + base + s2) : 0.f; a[4 * g + 3] = vld[4 * g + 3] ? __expf(lb[4 * g + 3] + base + s3) : 0.f; }
        C += TT;
        bf16x8 pf[2];
#pragma unroll
        for (int s2 = 0; s2 < 2; ++s2) { const u32x4 w = {pk2(a[8 * s2], a[8 * s2 + 1]), pk2(a[8 * s2 + 2], a[8 * s2 + 3]), pk2(a[8 * s2 + 4], a[8 * s2 + 5]), pk2(a[8 * s2 + 6], a[8 * s2 + 7])}; pf[s2] = __builtin_bit_cast(bf16x8, w); }
        const bf16_t* vp = vbase + 32 * kt;
#pragma unroll
        for (int blk = 0; blk < 4; ++blk)
#pragma unroll
            for (int s2 = 0; s2 < 2; ++s2) { const bf16_t* p = vp + (size_t)(32 * blk) * TS + 16 * s2;
                const u32x2 lo = *(const u32x2*)p, hi = *(const u32x2*)(p + 8); const u32x4 w = {lo.x, lo.y, hi.x, hi.y};
                oacc[blk] = __builtin_amdgcn_mfma_f32_32x32x16_bf16(__builtin_bit_cast(bf16x8, w), pf[s2], oacc[blk], 0, 0, 0); }
#if ATTN_EARLY_EXIT
        if (__all(C < -104.0f)) break;
#endif
    }
    if (qvalid) { bf16_t* op = Ob + (size_t)qrow * D + h * HD + 4 * hh;
#pragma unroll
        for (int blk = 0; blk < 4; ++blk)
#pragma unroll
            for (int g = 0; g < 4; ++g) *(u32x2*)(op + 32 * blk + 8 * g) = pk4((f32x4){oacc[blk][4 * g], oacc[blk][4 * g + 1], oacc[blk][4 * g + 2], oacc[blk][4 * g + 3]}); }
}
__device__ __forceinline__ void attn_phase(Frame& F) {
    const bf16_t* Qb = (const bf16_t*)(F.ws + WS_ACT); bf16_t* Ob = (bf16_t*)(F.ws + WS_ACT + ACT_SUB);
    const bf16_t* KB = (const bf16_t*)(F.ws + WS_KB); const bf16_t* VT = (const bf16_t*)(F.ws + WS_VT);
    int k = 0;
    for (int u = F.gw; u < NB * NH * 64 + NH; u += F.ngw, ++k) {
        if (u < NB * NH * 64) { const int bh = u >> 6, q0 = u & 63, qi = (k & 1) ? (64 - q0) : (1 + q0); attn_unit(F, Qb, Ob, KB, VT, bh >> 4, bh & 15, qi); }
        else attn_unit(F, Qb, Ob, KB, VT, 0, u - NB * NH * 64, 0);
    }
}

struct Args { const float* in[13]; float* out; unsigned char* ws; };
__global__ void __launch_bounds__(NWAVES * 64, 2) yoco_fwd(Args args) {
    extern __shared__ __attribute__((aligned(16))) unsigned char lds[];
    Frame F;
    F.lds = (LAS unsigned char*)lds;
    F.tid = threadIdx.x; F.lane = F.tid & 63; F.wave = __builtin_amdgcn_readfirstlane(F.tid >> 6);
    F.G = gridDim.x; { const int bx = blockIdx.x; F.vcu = (F.G % 8 == 0) ? (bx % 8) * (F.G / 8) + bx / 8 : bx; }
    F.gw = F.vcu * NWAVES + F.wave; F.ngw = F.G * NWAVES;
    F.ws = args.ws;
    for (int u = F.tid; u < (LDS_BYTES - LDSCTL_OFF) / 4; u += NWAVES * 64) ((LAS unsigned*)(F.lds + LDSCTL_OFF))[u] = 0u;
    __syncthreads();
    unsigned* ctl = (unsigned*)(F.ws + WS_CTL);
    XcdBarrier bar = xcd_barrier_post(ctl + CW_BAR, (volatile LAS unsigned*)(F.lds + MISC_OFF) + 8);
#define GRID_BAR() do { xcd_barrier(bar); PHASE_BEGIN(); } while (0)
#define PHASE_BEGIN() do { int t_ = threadIdx.x; asm volatile("" : "+v"(t_)); F.tid = t_; F.lane = t_ & 63; F.wave = __builtin_amdgcn_readfirstlane(t_ >> 6); F.gw = F.vcu * NWAVES + F.wave; \
        unsigned long long w_ = (unsigned long long)args.ws; asm volatile("" : "+s"(w_)); F.ws = (unsigned char*)w_; } while (0)
#define HB ((bf16_t*)(F.ws + WS_HB))
#define X32 ((float*)(F.ws + WS_X32))
#define ACT ((bf16_t*)(F.ws + WS_ACT))
#define bgw ((int)blockIdx.x * NWAVES + F.wave)

    PHASE_BEGIN();
    p0_prologue(F, args.in[0], args.in[1], args.in[4], args.in[5], args.in[6], args.in[9], args.in[10], args.in[12], args.in[11]);
    GRID_BAR();

    for (int l = 0; l < DEPTH; ++l) {
        for (int s = 0; s < 2; ++s) {
            { const bf16_t* W1 = (const bf16_t*)(F.ws + WS_W1T + (size_t)(2 * l + s) * W1T_BYTES);
              pg8::Gemm g{HB, W1, MREAL, FF2, D}; pg8::StaticOrder S; S.init(MREAL, FF2, F.G, (int)blockIdx.x); EpiSwiglu E{ACT};
              pg8::gemm_phase<EpiSwiglu, pg8::StaticOrder, true, true>(F.lds + RING_OFF, g, S, E);
              meta_gemm<true>(HB + (size_t)MREAL * D, D, W1, D, FF, bgw, F.ngw, F.lane, E); }
            GRID_BAR();
            { const bf16_t* W2 = (const bf16_t*)(F.ws + WS_W2T + (size_t)(2 * l + s) * W2T_BYTES);
              pg8::Gemm g{ACT, W2, MREAL, D, FF}; pg8::StaticOrder S; S.init(MREAL, D, F.G, (int)blockIdx.x); EpiResid E{X32, 0.5f};
              pg8::gemm_phase<EpiResid, pg8::StaticOrder, true, true>(F.lds + RING_OFF, g, S, E);
              meta_gemm<false>(ACT + (size_t)MREAL * FF, FF, W2, FF, D, bgw, F.ngw, F.lane, E); }
            GRID_BAR();
            { const int li = (s == 0) ? 0 : 2; ln_phase(F, args.in[2] + (size_t)(l * 3 + li) * D, args.in[3] + (size_t)(l * 3 + li) * D, l == DEPTH - 1 && s == 1, args.out); }
            GRID_BAR();
            if (s == 0) {
                if (l < NCONV) {
                    { const bf16_t* Wc = (const bf16_t*)(F.ws + WS_WCIN + (size_t)l * WCIN_BYTES);
                      pg8::Gemm g{HB, Wc, MREAL, 3 * D, D}; pg8::StaticOrder S; S.init(MREAL, 3 * D, F.G, (int)blockIdx.x);
                      EpiConvIn E{ACT, (bf16_t*)(F.ws + WS_ACT + ACT_SUB)};
                      pg8::gemm_phase<EpiConvIn, pg8::StaticOrder, true, true>(F.lds + RING_OFF, g, S, E);
                      MetaConvV EV{ACT}; meta_gemm<true>(HB + (size_t)MREAL * D, D, Wc, D, D, bgw, F.ngw, F.lane, EV);
                      EpiBf16S EB{(bf16_t*)(F.ws + WS_ACT + ACT_SUB), 1.0f}; meta_gemm<false>(HB + (size_t)MREAL * D, D, Wc + (size_t)(2 * D) * D, D, D, bgw, F.ngw, F.lane, EB); }
                    GRID_BAR();
                    conv_phase(F, args.in[7] + (size_t)l * 3 * D, args.in[8] + (size_t)l * D);
                    GRID_BAR();
                    { const bf16_t* Wo = (const bf16_t*)(F.ws + WS_WCOUT + (size_t)l * SQ_BYTES); const bf16_t* GG = (const bf16_t*)(F.ws + WS_ACT + 2 * ACT_SUB);
                      pg8::Gemm g{GG, Wo, MREAL, D, D}; pg8::StaticOrder S; S.init(MREAL, D, F.G, (int)blockIdx.x); EpiResid E{X32, 1.0f};
                      pg8::gemm_phase<EpiResid, pg8::StaticOrder, true, true>(F.lds + RING_OFF, g, S, E);
                      meta_gemm<false>(GG + (size_t)MREAL * D, D, Wo, D, D, bgw, F.ngw, F.lane, E); }
                } else {
                    const int j = l - NCONV;
                    { const bf16_t* Wq = (const bf16_t*)(F.ws + WS_WQ + (size_t)j * SQ_BYTES);
                      pg8::Gemm g{HB, Wq, MREAL, D, D}; pg8::StaticOrder S; S.init(MREAL, D, F.G, (int)blockIdx.x); EpiBf16S E{ACT, QSCALE};
                      pg8::gemm_phase<EpiBf16S, pg8::StaticOrder, true, true>(F.lds + RING_OFF, g, S, E);
                      meta_gemm<false>(HB + (size_t)MREAL * D, D, Wq, D, D, bgw, F.ngw, F.lane, E); }
                    GRID_BAR();
                    attn_phase(F);
                    GRID_BAR();
                    { const bf16_t* Wo = (const bf16_t*)(F.ws + WS_WO + (size_t)j * SQ_BYTES); const bf16_t* Ob = (const bf16_t*)(F.ws + WS_ACT + ACT_SUB);
                      pg8::Gemm g{Ob, Wo, MREAL, D, D}; pg8::StaticOrder S; S.init(MREAL, D, F.G, (int)blockIdx.x); EpiResid E{X32, 1.0f};
                      pg8::gemm_phase<EpiResid, pg8::StaticOrder, true, true>(F.lds + RING_OFF, g, S, E);
                      meta_gemm<false>(Ob + (size_t)MREAL * D, D, Wo, D, D, bgw, F.ngw, F.lane, E); }
                }
                GRID_BAR();
                ln_phase(F, args.in[2] + (size_t)(l * 3 + 1) * D, args.in[3] + (size_t)(l * 3 + 1) * D, false, args.out);
                GRID_BAR();
            }
        }
        if (l == NCONV - 1) {
            const bf16_t* Wkv = (const bf16_t*)(F.ws + WS_WKV);
            pg8::Gemm g{HB, Wkv, MREAL, 2 * D, D}; pg8::StaticOrder S; S.init(MREAL, 2 * D, F.G, (int)blockIdx.x); EpiKV E{(bf16_t*)(F.ws + WS_KB), (bf16_t*)(F.ws + WS_VT)};
            pg8::gemm_phase<EpiKV, pg8::StaticOrder, true, true>(F.lds + RING_OFF, g, S, E);
            meta_gemm<false>(HB + (size_t)MREAL * D, D, Wkv, D, 2 * D, bgw, F.ngw, F.lane, E);
            GRID_BAR();
        }
    }
}

extern "C" void kernel_launch(void* const* d_in, const int* in_sizes, int n_in, void* d_out, int out_size, void* d_ws, size_t ws_size, hipStream_t stream) {
    static int grid = 0;
    if (grid == 0) {
        if (n_in != 13 || in_sizes[0] != MREAL * D || out_size != MREAL * D || ws_size < WS_END) { fprintf(stderr, "kernel_launch: unexpected shapes (n_in %d, in0 %d, out %d, ws %zu)\n", n_in, n_in > 0 ? in_sizes[0] : -1, out_size, ws_size); grid = -1; return; }
        int dev = 0, cus = 0;
        if (hipGetDevice(&dev) != hipSuccess || hipDeviceGetAttribute(&cus, hipDeviceAttributeMultiprocessorCount, dev) != hipSuccess) { grid = -1; return; }
        if (hipFuncSetAttribute((const void*)yoco_fwd, hipFuncAttributeMaxDynamicSharedMemorySize, LDS_BYTES) != hipSuccess) { fprintf(stderr, "kernel_launch: hipFuncSetAttribute failed\n"); grid = -1; return; }
        int per_cu = 0;
        if (hipOccupancyMaxActiveBlocksPerMultiprocessor(&per_cu, (const void*)yoco_fwd, NWAVES * 64, LDS_BYTES) != hipSuccess || per_cu < 1) fprintf(stderr, "kernel_launch: occupancy query says %d\n", per_cu);
        (void)hipGetLastError();
        grid = cus;
    }
    if (grid < 0) return;
    if (hipMemsetAsync((char*)d_ws + WS_CTL, 0, CTL_ZERO_BYTES, stream) != hipSuccess) return;
    Args a{};
    for (int i = 0; i < 13; ++i) a.in[i] = (const float*)d_in[i];
    a.out = (float*)d_out; a.ws = (unsigned char*)d_ws;
    hipLaunchKernelGGL(yoco_fwd, dim3(grid), dim3(NWAVES * 64), LDS_BYTES, stream, a);
}
```

```cpp
#include <hip/hip_runtime.h>
#include <cstdio>
#include <cstdint>

constexpr int D = 2048, NB = 8, SEQ = 2048, NMETA = 16, NH = 16, HD = 128, FF = 5632, FF2 = 11264, DEPTH = 4, NCONV = 2;
constexpr int MREAL = NB * SEQ;
constexpr int MROWS = MREAL + NMETA;
constexpr int MCAP = 16640;
constexpr int TS = 2080;
constexpr float ALPHA = 1.6817928305074290f, LN_EPS = 1e-5f, QSCALE = 0.08838834764831845f;

constexpr size_t MiB = 1u << 20;
constexpr size_t WS_CTL = 0, CTL_ZERO_BYTES = 1 * MiB;
constexpr size_t WS_W1T = 2 * MiB, W1T_BYTES = 44 * MiB;
constexpr size_t WS_W2T = WS_W1T + 8 * W1T_BYTES, W2T_BYTES = 22 * MiB;
constexpr size_t WS_WCIN = WS_W2T + 8 * W2T_BYTES, WCIN_BYTES = 24 * MiB;
constexpr size_t SQ_BYTES = 8 * MiB;
constexpr size_t WS_WCOUT = WS_WCIN + 2 * WCIN_BYTES;
constexpr size_t WS_WQ = WS_WCOUT + 2 * SQ_BYTES;
constexpr size_t WS_WO = WS_WQ + 2 * SQ_BYTES;
constexpr size_t WS_WKV = WS_WO + 2 * SQ_BYTES;
constexpr size_t WS_HB = WS_WKV + 16 * MiB;
constexpr size_t WS_X32 = WS_HB + 65 * MiB;
constexpr size_t WS_ACT = WS_X32 + 130 * MiB;
constexpr size_t ACT_SUB = 65 * MiB;
constexpr size_t WS_KB = WS_ACT + 195 * MiB;
constexpr size_t WS_VT = WS_KB + 65 * MiB;
constexpr size_t WS_END = WS_VT + 65 * MiB;
constexpr int CW_BAR = 4096;

constexpr int RING_OFF = 0, RING_BYTES = 131072;
constexpr int LDSCTL_OFF = RING_BYTES, MISC_OFF = LDSCTL_OFF + 320;
constexpr int LDS_BYTES = 147456;
constexpr int NWAVES = 8;

#define GAS __attribute__((address_space(1)))
#define LAS __attribute__((address_space(3)))
typedef unsigned short bf16_t;
typedef short bf16x8 __attribute__((ext_vector_type(8)));
typedef short s16x4 __attribute__((ext_vector_type(4)));
typedef float f32x4 __attribute__((ext_vector_type(4)));
typedef float f32x16 __attribute__((ext_vector_type(16)));
typedef unsigned u32x4 __attribute__((ext_vector_type(4)));
typedef unsigned u32x2 __attribute__((ext_vector_type(2)));
typedef __bf16 bf2_t __attribute__((ext_vector_type(2)));
typedef float f2_t __attribute__((ext_vector_type(2)));
__device__ __forceinline__ unsigned pk2(float lo, float hi) { f2_t v = {lo, hi}; bf2_t r = __builtin_convertvector(v, bf2_t); return __builtin_bit_cast(unsigned, r); }
__device__ __forceinline__ float bf_lo(unsigned w) { return __uint_as_float(w << 16); }
__device__ __forceinline__ float bf_hi(unsigned w) { return __uint_as_float(w & 0xffff0000u); }

namespace pg8 {
#define PG8_LAS __attribute__((address_space(3)))
constexpr int BM = 256, BK = 64, HALF = 128, HTB = HALF * BK * 2, STAGE_BYTES = 8 * HTB, NXCD = 8, WGM = 8;
__host__ __device__ __forceinline__ int lds_byte(int r, int c) { const int st = (r >> 4) * 2 + (c >> 5), rr = r & 15, cc = c & 31, ob = rr * 64 + cc * 2; return st * 1024 + (ob ^ (((ob >> 9) & 1) << 5)); }
__host__ __device__ __forceinline__ void stage_rc(int b, int& R, int& C) { const int st = b / 1024, sb = b % 1024, swz = sb ^ (((sb >> 9) & 1) << 5); R = (st >> 1) * 16 + swz / 64; C = (st & 1) * 32 + (swz % 64) / 2; }
__host__ __device__ __forceinline__ int perm32(int rho) { const int n = rho >> 4, i = rho & 15; return 8 * (i >> 2) + 4 * n + (i & 3); }
struct Unit { int pm, pn; };
struct Gemm { const bf16_t* A; const bf16_t* Bt; int M, N, K; };
struct StaticOrder {
    int nM, nN, nwg, G, c;
    __host__ __device__ void init(int M, int N, int G_, int c_) { nM = M / BM; nN = N / BM; nwg = nM * nN; G = G_; c = c_; }
    __host__ __device__ bool next(int i, Unit& u) const {
        const long L = (long)i * G + c; if (L >= nwg) return false;
        int wgid = (int)L; { const int q = nwg / NXCD, r = nwg % NXCD, xcd = wgid % NXCD, off = wgid / NXCD; wgid = (xcd < r ? xcd * (q + 1) : r * (q + 1) + (xcd - r) * q) + off; }
        const int nig = WGM * nN, gid = wgid / nig, fm = gid * WGM, gsz = (nM - fm) < WGM ? (nM - fm) : WGM;
        u.pm = fm + ((wgid % nig) % gsz); u.pn = (wgid % nig) / gsz; return true;
    }
    __device__ __forceinline__ void a_ready(const Unit&) const {}
    __device__ __forceinline__ void done(const Unit&) const {}
};

template <class Epi, class Sched, bool ALIGN_EPI = false, bool SP2 = false>
__device__ __forceinline__ void gemm_phase(PG8_LAS unsigned char* lds, const Gemm g, const Sched& S, const Epi& E) {
    int tid_ = threadIdx.x; asm volatile("" : "+v"(tid_));
    const int tid = tid_, wid = __builtin_amdgcn_readfirstlane(tid >> 6), lane = tid & 63, wr = wid >> 2, wc = wid & 3, fr = lane & 15, fq = lane >> 4;
    const int K = g.K, nt = K / BK;
    unsigned voffA[2], voffB[2];
#pragma unroll
    for (int i = 0; i < 2; ++i) { int R, C; stage_rc(tid * 16 + i * 8192, R, C); const int Rb = Epi::PERM ? ((R & ~31) + perm32(R & 31)) : R;
        voffA[i] = (unsigned)(R * K + C) * 2u; voffB[i] = (unsigned)(Rb * K + C) * 2u; }
    const size_t kstep = (size_t)(BK * 2);
    const size_t hstep = (size_t)HALF * K * 2;
    const size_t tstep = 2 * hstep;
    const unsigned ldsw = (unsigned)wid * 1024u;
    const int aoff = lds_byte(wr * 64 + fr, fq * 8), boff = lds_byte(wc * 32 + fr, fq * 8);
#define PG8_SA(b, h) (((b) * 2 + (h)) * HTB)
#define PG8_SB(b, h) ((4 + (b) * 2 + (h)) * HTB)
#define PG8_STAGE(bufoff, gbase, voff) do { _Pragma("unroll") for (int _i = 0; _i < 2; ++_i) \
        __builtin_amdgcn_global_load_lds((const unsigned*)((const char*)(gbase) + (voff)[_i]), (PG8_LAS unsigned*)(lds + (bufoff) + ldsw + _i * 8192), 16, 0, 0); } while (0)
#define PG8_LDA(dst, b, h) do { _Pragma("unroll") for (int m = 0; m < 4; ++m) _Pragma("unroll") for (int k = 0; k < 2; ++k) dst[m][k] = *(const PG8_LAS bf16x8*)(lds + PG8_SA(b, h) + aoff + m * 2048 + k * 1024); } while (0)
#define PG8_LDB(dst, b, h) do { _Pragma("unroll") for (int n = 0; n < 2; ++n) _Pragma("unroll") for (int k = 0; k < 2; ++k) dst[n][k] = *(const PG8_LAS bf16x8*)(lds + PG8_SB(b, h) + boff + n * 2048 + k * 1024); } while (0)
#define PG8_MMA(ai, bj, At, Bt) do { __builtin_amdgcn_s_setprio(1); _Pragma("unroll") for (int m = 0; m < 4; ++m) _Pragma("unroll") for (int n = 0; n < 2; ++n) _Pragma("unroll") for (int k = 0; k < 2; ++k) \
        acc[ai][bj][m][n] = __builtin_amdgcn_mfma_f32_16x16x32_bf16(Bt[n][k], At[m][k], acc[ai][bj][m][n], 0, 0, 0); __builtin_amdgcn_s_setprio(0); } while (0)
#define PG8_WAIT_V(n) asm volatile("s_waitcnt vmcnt(" #n ")" ::: "memory")
#define PG8_WAIT_L(n) asm volatile("s_waitcnt lgkmcnt(" #n ")" ::: "memory")
#define PG8_BAR __builtin_amdgcn_s_barrier()
#define PG8_SCHED __builtin_amdgcn_sched_barrier(0)
    Unit cur, nxt; int ui = 0;
    if (!S.next(0, cur)) return;
    f32x4 acc[2][2][4][2];
#pragma unroll
    for (int a = 0; a < 2; ++a)
#pragma unroll
        for (int b = 0; b < 2; ++b)
#pragma unroll
            for (int m = 0; m < 4; ++m)
#pragma unroll
                for (int n = 0; n < 2; ++n) acc[a][b][m][n] = (f32x4){0.f, 0.f, 0.f, 0.f};
    bf16x8 At[4][2], B0[2][2], B1[2][2];
    const char* cA = (const char*)g.A + (size_t)cur.pm * tstep; const char* cB = (const char*)g.Bt + (size_t)cur.pn * tstep;
    S.a_ready(cur);
    if constexpr (SP2) {
        PG8_STAGE(PG8_SB(0, 0), cB, voffB); PG8_STAGE(PG8_SB(0, 1), cB + hstep, voffB); PG8_STAGE(PG8_SA(0, 0), cA, voffA); PG8_STAGE(PG8_SA(0, 1), cA + hstep, voffA);
        if (wr == 1) PG8_BAR;
        PG8_WAIT_V(2); PG8_BAR;
        PG8_STAGE(PG8_SB(1, 0), cB + kstep, voffB); PG8_STAGE(PG8_SA(1, 0), cA + kstep, voffA); PG8_STAGE(PG8_SB(1, 1), cB + hstep + kstep, voffB);
        PG8_WAIT_V(6); PG8_BAR;
    } else {
        PG8_STAGE(PG8_SB(0, 0), cB, voffB); PG8_STAGE(PG8_SA(0, 0), cA, voffA); PG8_STAGE(PG8_SB(0, 1), cB + hstep, voffB); PG8_STAGE(PG8_SA(0, 1), cA + hstep, voffA);
        if (wr == 1) PG8_BAR;
        PG8_WAIT_V(4); PG8_BAR;
        PG8_STAGE(PG8_SB(1, 0), cB + kstep, voffB); PG8_STAGE(PG8_SA(1, 0), cA + kstep, voffA); PG8_STAGE(PG8_SB(1, 1), cB + hstep + kstep, voffB);
        PG8_WAIT_V(6); PG8_BAR;
    }
    for (;;) {
        const bool has_next = S.next(ui + 1, nxt);
        const char* nA = has_next ? (const char*)g.A + (size_t)nxt.pm * tstep : cA; const char* nB = has_next ? (const char*)g.Bt + (size_t)nxt.pn * tstep : cB;
        for (int t = 0; t < nt; t += 2) {
            const bool last = (t == nt - 2);
            const char* a1 = cA + (size_t)(t + 1) * kstep;
            const char* a2 = last ? nA : cA + (size_t)(t + 2) * kstep; const char* b2 = last ? nB : cB + (size_t)(t + 2) * kstep;
            const char* a3 = a2 + kstep; const char* b3 = b2 + kstep;
            if (last && has_next) S.a_ready(nxt);
            if constexpr (SP2) {
            PG8_LDB(B0, 0, 0); PG8_LDB(B1, 0, 1); PG8_SCHED; PG8_LDA(At, 0, 0); PG8_STAGE(PG8_SA(1, 1), a1 + hstep, voffA);
            PG8_WAIT_V(8); PG8_WAIT_L(0); PG8_BAR; PG8_MMA(0, 0, At, B0); PG8_MMA(0, 1, At, B1); PG8_BAR; PG8_SCHED;
            PG8_LDA(At, 0, 1); PG8_STAGE(PG8_SB(0, 0), b2, voffB); PG8_STAGE(PG8_SB(0, 1), b2 + hstep, voffB); PG8_STAGE(PG8_SA(0, 0), a2, voffA);
            PG8_WAIT_V(8); PG8_WAIT_L(0); PG8_BAR; PG8_MMA(1, 0, At, B0); PG8_MMA(1, 1, At, B1); PG8_BAR; PG8_SCHED;
            PG8_LDB(B0, 1, 0); PG8_LDB(B1, 1, 1); PG8_SCHED; PG8_LDA(At, 1, 0); PG8_STAGE(PG8_SA(0, 1), a2 + hstep, voffA);
            PG8_WAIT_V(8); PG8_WAIT_L(0); PG8_BAR; PG8_MMA(0, 0, At, B0); PG8_MMA(0, 1, At, B1); PG8_BAR; PG8_SCHED;
            PG8_LDA(At, 1, 1); PG8_STAGE(PG8_SB(1, 0), b3, voffB); PG8_STAGE(PG8_SB(1, 1), b3 + hstep, voffB); PG8_STAGE(PG8_SA(1, 0), a3, voffA);
            PG8_WAIT_V(8); PG8_WAIT_L(0); PG8_BAR; PG8_MMA(1, 0, At, B0); PG8_MMA(1, 1, At, B1); PG8_BAR; PG8_SCHED;
            } else {
            PG8_LDB(B0, 0, 0); PG8_SCHED; PG8_LDA(At, 0, 0); PG8_STAGE(PG8_SA(1, 1), a1 + hstep, voffA);
            PG8_WAIT_L(8); PG8_BAR; PG8_WAIT_L(0); PG8_MMA(0, 0, At, B0); PG8_BAR; PG8_SCHED;
            PG8_LDB(B1, 0, 1); PG8_STAGE(PG8_SB(0, 0), b2, voffB);
            PG8_BAR; PG8_WAIT_L(0); PG8_MMA(0, 1, At, B1); PG8_BAR;
            PG8_LDA(At, 0, 1); PG8_STAGE(PG8_SA(0, 0), a2, voffA);
            PG8_BAR; PG8_WAIT_L(0); PG8_MMA(1, 0, At, B0); PG8_BAR; PG8_SCHED;
            PG8_STAGE(PG8_SB(0, 1), b2 + hstep, voffB);
            PG8_WAIT_V(6); PG8_BAR; PG8_MMA(1, 1, At, B1); PG8_BAR;
            PG8_LDB(B0, 1, 0); PG8_SCHED; PG8_LDA(At, 1, 0); PG8_STAGE(PG8_SA(0, 1), a2 + hstep, voffA);
            PG8_WAIT_L(8); PG8_BAR; PG8_WAIT_L(0); PG8_MMA(0, 0, At, B0); PG8_BAR; PG8_SCHED;
            PG8_LDB(B1, 1, 1); PG8_STAGE(PG8_SB(1, 0), b3, voffB);
            PG8_BAR; PG8_WAIT_L(0); PG8_MMA(0, 1, At, B1); PG8_BAR;
            PG8_LDA(At, 1, 1); PG8_STAGE(PG8_SA(1, 0), a3, voffA);
            PG8_BAR; PG8_WAIT_L(0); PG8_MMA(1, 0, At, B0); PG8_BAR; PG8_SCHED;
            PG8_STAGE(PG8_SB(1, 1), b3 + hstep, voffB);
            PG8_WAIT_V(6); PG8_BAR; PG8_MMA(1, 1, At, B1); PG8_BAR;
            }
        }
        if constexpr (ALIGN_EPI) { if (wr == 0) PG8_BAR; }
        E(acc, cur, wr, wc, fr, fq);
        if (!has_next) break;
#pragma unroll
        for (int a = 0; a < 2; ++a)
#pragma unroll
            for (int b = 0; b < 2; ++b)
#pragma unroll
                for (int m = 0; m < 4; ++m)
#pragma unroll
                    for (int n = 0; n < 2; ++n) acc[a][b][m][n] = (f32x4){0.f, 0.f, 0.f, 0.f};
        cur = nxt; cA = nA; cB = nB; ++ui;
        if constexpr (ALIGN_EPI) { if (wr == 1) PG8_BAR; }
    }
    PG8_WAIT_V(0);
    if constexpr (!ALIGN_EPI) { if (wr == 0) PG8_BAR; }
    PG8_BAR;
#undef PG8_SA
#undef PG8_SB
#undef PG8_STAGE
#undef PG8_LDA
#undef PG8_LDB
#undef PG8_MMA
#undef PG8_WAIT_V
#undef PG8_WAIT_L
#undef PG8_BAR
#undef PG8_SCHED
}
}

__device__ __forceinline__ float silu_mul(float g, float u) { return g * u * __builtin_amdgcn_rcpf(1.0f + __builtin_amdgcn_exp2f(-1.4426950408889634f * g)); }
__device__ __forceinline__ f32x4 silu_mul4(f32x4 g, f32x4 u) { return (f32x4){silu_mul(g[0], u[0]), silu_mul(g[1], u[1]), silu_mul(g[2], u[2]), silu_mul(g[3], u[3])}; }
__device__ __forceinline__ u32x2 pk4(f32x4 v) { u32x2 w; w.x = pk2(v[0], v[1]); w.y = pk2(v[2], v[3]); return w; }

struct EpiSwiglu {
    static constexpr bool PERM = true;
    bf16_t* O;
    __device__ __forceinline__ void operator()(const f32x4 (&acc)[2][2][4][2], const pg8::Unit& u, int wr, int wc, int fr, int fq) const {
        const int row0 = u.pm * 256 + wr * 64 + fr, col0 = u.pn * 128 + wc * 32 + 8 * fq;
#pragma unroll
        for (int ai = 0; ai < 2; ++ai)
#pragma unroll
            for (int m = 0; m < 4; ++m) { bf16_t* p = O + (size_t)(row0 + ai * 128 + m * 16) * FF + col0;
                const u32x2 a = pk4(silu_mul4(acc[ai][0][m][0], acc[ai][1][m][0])), b = pk4(silu_mul4(acc[ai][0][m][1], acc[ai][1][m][1]));
                *(u32x4*)p = (u32x4){a.x, a.y, b.x, b.y}; }
    }
    __device__ __forceinline__ void meta(int r, int col, f32x4 g, f32x4 up) const { *(u32x2*)(O + (size_t)(MREAL + r) * FF + col) = pk4(silu_mul4(g, up)); }
};
struct EpiResid {
    static constexpr bool PERM = false;
    float* X; float coef;
    __device__ __forceinline__ void operator()(const f32x4 (&acc)[2][2][4][2], const pg8::Unit& u, int wr, int wc, int fr, int fq) const {
        const int row0 = u.pm * 256 + wr * 64 + fr, col0 = u.pn * 256 + wc * 32 + 4 * fq;
#pragma unroll
        for (int ai = 0; ai < 2; ++ai) {
            f32x4 h[4][2][2];
#pragma unroll
            for (int m = 0; m < 4; ++m) { const float* p = X + (size_t)(row0 + ai * 128 + m * 16) * D + col0;
#pragma unroll
                for (int bj = 0; bj < 2; ++bj)
#pragma unroll
                    for (int n = 0; n < 2; ++n) h[m][bj][n] = *(const f32x4*)(p + bj * 128 + n * 16); }
#pragma unroll
            for (int m = 0; m < 4; ++m) { float* p = X + (size_t)(row0 + ai * 128 + m * 16) * D + col0;
#pragma unroll
                for (int bj = 0; bj < 2; ++bj)
#pragma unroll
                    for (int n = 0; n < 2; ++n) *(f32x4*)(p + bj * 128 + n * 16) = h[m][bj][n] * ALPHA + acc[ai][bj][m][n] * coef; }
            asm volatile("" ::: "memory"); }
    }
    __device__ __forceinline__ void meta(int r, int col, f32x4 a, f32x4) const { float* p = X + (size_t)(MREAL + r) * D + col; const f32x4 h = *(const f32x4*)p; *(f32x4*)p = h * ALPHA + a * coef; }
};
struct EpiConvIn {
    static constexpr bool PERM = true;
    bf16_t* V; bf16_t* BG;
    __device__ __forceinline__ void operator()(const f32x4 (&acc)[2][2][4][2], const pg8::Unit& u, int wr, int wc, int fr, int fq) const {
        const int row0 = u.pm * 256 + wr * 64 + fr;
        if (u.pn < 16) {
            const int col0 = u.pn * 128 + wc * 32 + 8 * fq;
#pragma unroll
            for (int ai = 0; ai < 2; ++ai)
#pragma unroll
                for (int m = 0; m < 4; ++m) { bf16_t* p = V + (size_t)(row0 + ai * 128 + m * 16) * D + col0;
                    const u32x2 a = pk4(acc[ai][0][m][0] * acc[ai][1][m][0]), b = pk4(acc[ai][0][m][1] * acc[ai][1][m][1]);
                    *(u32x4*)p = (u32x4){a.x, a.y, b.x, b.y}; }
        } else {
            const int col0 = (u.pn - 16) * 256 + wc * 32 + 8 * fq;
#pragma unroll
            for (int ai = 0; ai < 2; ++ai)
#pragma unroll
                for (int m = 0; m < 4; ++m) { bf16_t* p = BG + (size_t)(row0 + ai * 128 + m * 16) * D + col0;
#pragma unroll
                    for (int bj = 0; bj < 2; ++bj) { const u32x2 a = pk4(acc[ai][bj][m][0]), b = pk4(acc[ai][bj][m][1]); *(u32x4*)(p + bj * 128) = (u32x4){a.x, a.y, b.x, b.y}; } }
        }
    }
};
struct MetaConvV { bf16_t* V; __device__ __forceinline__ void meta(int r, int col, f32x4 c, f32x4 uu) const { *(u32x2*)(V + (size_t)(MREAL + r) * D + col) = pk4(c * uu); } };
struct EpiBf16S {
    static constexpr bool PERM = true;
    bf16_t* O; float scale;
    __device__ __forceinline__ void operator()(const f32x4 (&acc)[2][2][4][2], const pg8::Unit& u, int wr, int wc, int fr, int fq) const {
        const int row0 = u.pm * 256 + wr * 64 + fr, col0 = u.pn * 256 + wc * 32 + 8 * fq;
#pragma unroll
        for (int ai = 0; ai < 2; ++ai)
#pragma unroll
            for (int m = 0; m < 4; ++m) { bf16_t* p = O + (size_t)(row0 + ai * 128 + m * 16) * D + col0;
#pragma unroll
                for (int bj = 0; bj < 2; ++bj) { const u32x2 a = pk4(acc[ai][bj][m][0] * scale), b = pk4(acc[ai][bj][m][1] * scale); *(u32x4*)(p + bj * 128) = (u32x4){a.x, a.y, b.x, b.y}; } }
    }
    __device__ __forceinline__ void meta(int r, int col, f32x4 a, f32x4) const { *(u32x2*)(O + (size_t)(MREAL + r) * D + col) = pk4(a * scale); }
};
struct EpiKV {
    static constexpr bool PERM = true;
    bf16_t* KB; bf16_t* VT;
    __device__ __forceinline__ void operator()(const f32x4 (&acc)[2][2][4][2], const pg8::Unit& u, int wr, int wc, int fr, int fq) const {
        const int row0 = u.pm * 256 + wr * 64 + fr, d0 = wc * 32 + 8 * fq;
        if (u.pn < 8) {
#pragma unroll
            for (int ai = 0; ai < 2; ++ai)
#pragma unroll
                for (int m = 0; m < 4; ++m) { const int row = row0 + ai * 128 + m * 16, b = row >> 11, ts = 32 + (row & 2047);
#pragma unroll
                    for (int bj = 0; bj < 2; ++bj) { const int h = 2 * u.pn + bj; bf16_t* p = KB + ((size_t)(b * NH + h) * TS + ts) * HD + d0;
                        const u32x2 a = pk4(acc[ai][bj][m][0]), bq = pk4(acc[ai][bj][m][1]); *(u32x4*)p = (u32x4){a.x, a.y, bq.x, bq.y}; } }
        } else {
#pragma unroll
            for (int ai = 0; ai < 2; ++ai)
#pragma unroll
                for (int m = 0; m < 4; ++m) { const int row = row0 + ai * 128 + m * 16, b = row >> 11, ts = 32 + (row & 2047);
#pragma unroll
                    for (int bj = 0; bj < 2; ++bj) { const int h = 2 * (u.pn - 8) + bj; bf16_t* p = VT + ((size_t)(b * NH + h) * HD + d0) * TS + ts;
#pragma unroll
                        for (int n = 0; n < 2; ++n) { const u32x2 w = pk4(acc[ai][bj][m][n]);
                            p[(size_t)(4 * n + 0) * TS] = (bf16_t)(w.x & 0xffffu); p[(size_t)(4 * n + 1) * TS] = (bf16_t)(w.x >> 16);
                            p[(size_t)(4 * n + 2) * TS] = (bf16_t)(w.y & 0xffffu); p[(size_t)(4 * n + 3) * TS] = (bf16_t)(w.y >> 16); } } }
        }
    }
    __device__ __forceinline__ void meta(int r, int col, f32x4 a, f32x4) const {
        const u32x2 w = pk4(a); const int ts = 16 + r;
        if (col < D) { const int h = col >> 7, d = col & 127;
            for (int b = 0; b < NB; ++b) *(u32x2*)(KB + ((size_t)(b * NH + h) * TS + ts) * HD + d) = w;
        } else { const int c2 = col - D, h = c2 >> 7, d = c2 & 127;
            for (int b = 0; b < NB; ++b) { bf16_t* p = VT + ((size_t)(b * NH + h) * HD + d) * TS + ts;
                p[0] = (bf16_t)(w.x & 0xffffu); p[(size_t)TS] = (bf16_t)(w.x >> 16); p[(size_t)2 * TS] = (bf16_t)(w.y & 0xffffu); p[(size_t)3 * TS] = (bf16_t)(w.y >> 16); } }
    }
};

template <bool PAIR, class F>
__device__ __forceinline__ void meta_gemm(const bf16_t* A, int lda, const bf16_t* Bt, int K, int ncols, int wg, int nwg, int wave, int lane, LAS unsigned char* lds, const F& f) {
    const int fr = lane & 15, fq = lane >> 4, nunits = ncols >> 4, kper = K >> 3, kbeg = wave * kper;
    LAS f32x4* red = (LAS f32x4*)lds;
    for (int u = wg; u < nunits; u += nwg) {
        int br0 = 16 * u, br1 = 0;
        if (PAIR) { const int j0 = 16 * u; br0 = 256 * (j0 >> 7) + (j0 & 127); br1 = br0 + 128; }
        const bf16_t* ap = A + (size_t)fr * lda + 8 * fq + kbeg;
        const bf16_t* bp0 = Bt + (size_t)(br0 + fr) * K + 8 * fq + kbeg;
        const bf16_t* bp1 = Bt + (size_t)(br1 + fr) * K + 8 * fq + kbeg;
        f32x4 acc0 = {0.f, 0.f, 0.f, 0.f}, acc1 = {0.f, 0.f, 0.f, 0.f};
#pragma unroll 2
        for (int k0 = 0; k0 < kper; k0 += 32) {
            const bf16x8 a = *(const bf16x8*)(ap + k0), b0 = *(const bf16x8*)(bp0 + k0);
            acc0 = __builtin_amdgcn_mfma_f32_16x16x32_bf16(b0, a, acc0, 0, 0, 0);
            if (PAIR) { const bf16x8 b1 = *(const bf16x8*)(bp1 + k0); acc1 = __builtin_amdgcn_mfma_f32_16x16x32_bf16(b1, a, acc1, 0, 0, 0); }
        }
        red[(wave * 2 + 0) * 64 + lane] = acc0; if (PAIR) red[(wave * 2 + 1) * 64 + lane] = acc1;
        __syncthreads();
        if (wave == 0) {
#pragma unroll
            for (int w = 1; w < 8; ++w) { acc0 = acc0 + red[(w * 2 + 0) * 64 + lane]; if (PAIR) acc1 = acc1 + red[(w * 2 + 1) * 64 + lane]; }
            f.meta(fr, 16 * u + 4 * fq, acc0, acc1);
        }
        __syncthreads();
    }
}

#define XB_TMO      128
#define XB_XCNT(j)  (256  + 64 * (j))
#define XB_XSUB(j)  (1280 + 64 * (j))
#define XB_XGEN(j)  (2304 + 64 * (j))
#define XB_TOP      3328
#define XB_TOPGEN   3392
#define XCD_BAR_WORDS 3456
#define XB_SPIN_CAP (1u << 18)
__device__ __forceinline__ unsigned xb_ld(unsigned* p)              { return __hip_atomic_load(p, __ATOMIC_RELAXED, __HIP_MEMORY_SCOPE_AGENT); }
__device__ __forceinline__ unsigned xb_add(unsigned* p, unsigned v) { return __hip_atomic_fetch_add(p, v, __ATOMIC_RELAXED, __HIP_MEMORY_SCOPE_AGENT); }
__device__ __forceinline__ unsigned xb_xcc_id() { return (unsigned)__builtin_amdgcn_s_getreg((3 << 11) | 20) & 0xFu; }
#define XB_SPIN(cond, bar) do { unsigned _sp = 0; while (cond) { __builtin_amdgcn_s_sleep(1); \
    if ((++_sp & 255u) == 0u) { if (xb_ld(&(bar)[XB_TMO])) break; if (_sp > XB_SPIN_CAP) { atomicAdd(&(bar)[XB_TMO], 1u); break; } } } } while (0)
struct XcdBarrier { unsigned* bar; unsigned x; volatile LAS unsigned* st; };
__device__ __forceinline__ XcdBarrier xcd_barrier_post(unsigned* bar, volatile LAS unsigned* st) {
    XcdBarrier b; b.bar = bar; b.x = xb_xcc_id(); b.st = st;
    if (threadIdx.x == 0) (void)xb_add(&bar[XB_XCNT(b.x)], 1u);
    return b;
}
__device__ __forceinline__ void xcd_barrier_complete(unsigned* bar, unsigned x, unsigned& nloc, unsigned& nx) {
    const unsigned G = gridDim.x * gridDim.y * gridDim.z;
    unsigned sum, cnt, mine, sp = 0u;
    for (;;) {
        sum = 0u; cnt = 0u; mine = 0u;
#pragma unroll
        for (unsigned j = 0; j < 16; ++j) { const unsigned c = xb_ld(&bar[XB_XCNT(j)]); sum += c; cnt += (c > 0u) ? 1u : 0u; mine = (j == x) ? c : mine; }
        if (sum == G) break;
        __builtin_amdgcn_s_sleep(1);
        if ((++sp & 255u) == 0u) { if (xb_ld(&bar[XB_TMO])) break; if (sp > XB_SPIN_CAP) { atomicAdd(&bar[XB_TMO], 1u); break; } }
    }
    nloc = mine > 0u ? mine : 1u; nx = cnt > 0u ? cnt : 1u;
}
__device__ __forceinline__ void xcd_barrier(const XcdBarrier& b) {
    asm volatile("s_waitcnt vmcnt(0)" ::: "memory");
    __syncthreads();
    if (threadIdx.x == 0) {
        unsigned* bar = b.bar;
        __builtin_amdgcn_s_waitcnt(0);
        unsigned nloc = b.st[0], nx = b.st[1];
        if (nloc == 0u) { xcd_barrier_complete(bar, b.x, nloc, nx); b.st[0] = nloc; b.st[1] = nx; }
        const unsigned old = xb_add(&bar[XB_XSUB(b.x)], 1u);
        const unsigned gen = old / nloc;
        if (old + 1u == (gen + 1u) * nloc) {
            __builtin_amdgcn_fence(__ATOMIC_RELEASE, "agent");
            asm volatile("s_waitcnt vmcnt(0)" ::: "memory");
            const unsigned og = xb_add(&bar[XB_TOP], 1u);
            const unsigned tg = og / nx;
            if (og + 1u == (tg + 1u) * nx) xb_add(&bar[XB_TOPGEN], 1u);
            else XB_SPIN(xb_ld(&bar[XB_TOPGEN]) == tg, bar);
            __builtin_amdgcn_fence(__ATOMIC_ACQUIRE, "agent");
            xb_add(&bar[XB_XGEN(b.x)], 1u);
            asm volatile("s_waitcnt vmcnt(0)" ::: "memory");
        } else {
            XB_SPIN(xb_ld(&bar[XB_XGEN(b.x)]) == gen, bar);
            __builtin_amdgcn_fence(__ATOMIC_ACQUIRE, "agent");
            asm volatile("s_waitcnt vmcnt(0)" ::: "memory");
        }
    }
    __syncthreads();
}

struct Frame {
    LAS unsigned char* lds;
    int tid, lane, wave, vcu, G, gw, ngw;
    unsigned char* ws;
};
#define LDS_WAIT() asm volatile("s_waitcnt lgkmcnt(0)" ::: "memory")
__device__ __forceinline__ float wave_sum(float v) {
#pragma unroll
    for (int o = 1; o < 64; o <<= 1) v += __shfl_xor(v, o);
    return v;
}

__device__ __forceinline__ void transpose_item(const float* W, int K, int Nsrc, int srccol0, bf16_t* WT, int dstrow0, int k0, LAS float* scr, int lane) {
    f32x4 v[8];
    const float* src = W + (size_t)(k0 + (lane >> 3)) * Nsrc + srccol0 + 4 * (lane & 7);
#pragma unroll
    for (int i = 0; i < 8; ++i) v[i] = *(const f32x4*)(src + (size_t)(8 * i) * Nsrc);
#pragma unroll
    for (int i = 0; i < 8; ++i) { LAS float* d = scr + (8 * i + (lane >> 3)) * 33 + 4 * (lane & 7); d[0] = v[i][0]; d[1] = v[i][1]; d[2] = v[i][2]; d[3] = v[i][3]; }
    LDS_WAIT(); asm volatile("" ::: "memory");
    const int c = lane & 7;
#pragma unroll
    for (int j = 0; j < 4; ++j) { const int n = (lane >> 3) + 8 * j; const LAS float* s = scr + (8 * c) * 33 + n;
        u32x4 o; o.x = pk2(s[0 * 33], s[1 * 33]); o.y = pk2(s[2 * 33], s[3 * 33]); o.z = pk2(s[4 * 33], s[5 * 33]); o.w = pk2(s[6 * 33], s[7 * 33]);
        *(u32x4*)(WT + (size_t)(dstrow0 + n) * K + k0 + 8 * c) = o; }
    LDS_WAIT(); asm volatile("" ::: "memory");
}
constexpr int IT_W1 = (D / 64) * (FF2 / 32), IT_W2 = (FF / 64) * (D / 32), IT_CIN = (D / 64) * (3 * D / 32), IT_SQ = (D / 64) * (D / 32), IT_KV = (D / 64) * (2 * D / 32);
constexpr int IT_END_W1 = 8 * IT_W1, IT_END_W2 = IT_END_W1 + 8 * IT_W2, IT_END_CIN = IT_END_W2 + 2 * IT_CIN, IT_END_COUT = IT_END_CIN + 2 * IT_SQ, IT_END_WQ = IT_END_COUT + 2 * IT_SQ,
              IT_END_WO = IT_END_WQ + 2 * IT_SQ, IT_TOTAL = IT_END_WO + IT_KV;
__device__ __forceinline__ void prologue_item(Frame& F, const float* w_in, const float* w_out, const float* cw_in, const float* cw_out, const float* wq, const float* wo, const float* wkv, int it, LAS float* scr) {
    const float* W; bf16_t* WT; int K, Nsrc, nb, kb, srccol0, dstrow0;
    if (it < IT_END_W1) { const int j = it / IT_W1, r = it % IT_W1; K = D; Nsrc = FF2; W = w_in + (size_t)j * D * FF2; WT = (bf16_t*)(F.ws + WS_W1T + (size_t)j * W1T_BYTES);
        nb = r / (D / 64); kb = r % (D / 64); dstrow0 = 32 * nb; const int pn = dstrow0 >> 8, c = dstrow0 & 255; srccol0 = (c < 128) ? (128 * pn + c) : (FF + 128 * pn + (c - 128)); }
    else if (it < IT_END_W2) { const int q = it - IT_END_W1, j = q / IT_W2, r = q % IT_W2; K = FF; Nsrc = D; W = w_out + (size_t)j * FF * D; WT = (bf16_t*)(F.ws + WS_W2T + (size_t)j * W2T_BYTES);
        nb = r / (FF / 64); kb = r % (FF / 64); dstrow0 = 32 * nb; srccol0 = dstrow0; }
    else if (it < IT_END_CIN) { const int q = it - IT_END_W2, j = q / IT_CIN, r = q % IT_CIN; K = D; Nsrc = 3 * D; W = cw_in + (size_t)j * D * 3 * D; WT = (bf16_t*)(F.ws + WS_WCIN + (size_t)j * WCIN_BYTES);
        nb = r / (D / 64); kb = r % (D / 64); dstrow0 = 32 * nb; const int pn = dstrow0 >> 8, c = dstrow0 & 255;
        srccol0 = (pn < 16) ? ((c < 128) ? (D + 128 * pn + c) : (2 * D + 128 * pn + (c - 128))) : (256 * (pn - 16) + c); }
    else if (it < IT_END_WO) { const int q = it - IT_END_CIN, j = q / IT_SQ, r = q % IT_SQ; K = D; Nsrc = D;
        const float* src = (j < 2) ? cw_out : (j < 4) ? wq : wo; const size_t wsoff = (j < 2) ? WS_WCOUT : (j < 4) ? WS_WQ : WS_WO; const int l = j & 1;
        W = src + (size_t)l * D * D; WT = (bf16_t*)(F.ws + wsoff + (size_t)l * SQ_BYTES);
        nb = r / (D / 64); kb = r % (D / 64); dstrow0 = 32 * nb; srccol0 = dstrow0; }
    else { const int r = it - IT_END_WO; K = D; Nsrc = 2 * D; W = wkv; WT = (bf16_t*)(F.ws + WS_WKV); nb = r / (D / 64); kb = r % (D / 64); dstrow0 = 32 * nb; srccol0 = dstrow0; }
    transpose_item(W, K, Nsrc, srccol0, WT, dstrow0, 64 * kb, scr, F.lane);
}
__device__ __forceinline__ void p0_prologue(Frame& F, const float* x, const float* meta, const float* w_in, const float* w_out, const float* cw_in, const float* cw_out, const float* wq, const float* wo, const float* wkv) {
    LAS float* scr = (LAS float*)(F.lds + RING_OFF + F.wave * 16384);
    for (int it = F.gw; it < IT_TOTAL; it += F.ngw) prologue_item(F, w_in, w_out, cw_in, cw_out, wq, wo, wkv, it, scr);
    float* X32 = (float*)(F.ws + WS_X32); bf16_t* HB = (bf16_t*)(F.ws + WS_HB);
    for (int row = F.gw; row < MROWS; row += F.ngw) {
        const float* src = (row < MREAL) ? x + (size_t)row * D : meta + (size_t)(row - MREAL) * D;
#pragma unroll
        for (int j = 0; j < 8; ++j) { const f32x4 v = *(const f32x4*)(src + 4 * F.lane + 256 * j);
            *(f32x4*)(X32 + (size_t)row * D + 4 * F.lane + 256 * j) = v; *(u32x2*)(HB + (size_t)row * D + 4 * F.lane + 256 * j) = pk4(v); }
    }
    bf16_t* KB = (bf16_t*)(F.ws + WS_KB); bf16_t* VT = (bf16_t*)(F.ws + WS_VT);
    for (int bh = F.gw; bh < NB * NH; bh += F.ngw) {
        for (int i = F.lane; i < 16 * HD / 8; i += 64) *(u32x4*)(KB + (size_t)bh * TS * HD + 8 * i) = (u32x4){0u, 0u, 0u, 0u};
        for (int i = F.lane; i < HD * 2; i += 64) *(u32x4*)(VT + ((size_t)bh * HD + (i >> 1)) * TS + 8 * (i & 1)) = (u32x4){0u, 0u, 0u, 0u};
    }
}

__device__ __forceinline__ void ln_phase(Frame& F, const float* gain, const float* bias, bool final_out, float* out) {
    float* X32 = (float*)(F.ws + WS_X32); bf16_t* HB = (bf16_t*)(F.ws + WS_HB);
    f32x4 g[8], bb[8];
#pragma unroll
    for (int j = 0; j < 8; ++j) { g[j] = *(const f32x4*)(gain + 4 * F.lane + 256 * j); bb[j] = *(const f32x4*)(bias + 4 * F.lane + 256 * j); }
    for (int row = F.gw; row < MROWS; row += F.ngw) {
        float* xr = X32 + (size_t)row * D + 4 * F.lane;
        f32x4 v[8]; float s = 0.f;
#pragma unroll
        for (int j = 0; j < 8; ++j) { v[j] = *(const f32x4*)(xr + 256 * j); s += (v[j][0] + v[j][1]) + (v[j][2] + v[j][3]); }
        const float mean = wave_sum(s) * (1.f / D); float s2 = 0.f;
#pragma unroll
        for (int j = 0; j < 8; ++j) { v[j] = v[j] - mean; s2 += (v[j][0] * v[j][0] + v[j][1] * v[j][1]) + (v[j][2] * v[j][2] + v[j][3] * v[j][3]); }
        const float rstd = 1.f / sqrtf(wave_sum(s2) * (1.f / D) + LN_EPS);
        if (final_out) {
            if (row < MREAL) { float* o = out + (size_t)row * D + 4 * F.lane;
#pragma unroll
                for (int j = 0; j < 8; ++j) *(f32x4*)(o + 256 * j) = v[j] * rstd * g[j] + bb[j]; }
        } else {
            bf16_t* hr = HB + (size_t)row * D + 4 * F.lane;
#pragma unroll
            for (int j = 0; j < 8; ++j) { const f32x4 y = v[j] * rstd * g[j] + bb[j]; *(f32x4*)(xr + 256 * j) = y; *(u32x2*)(hr + 256 * j) = pk4(y); }
        }
    }
}

__device__ __forceinline__ void unpack8(u32x4 w, float (&f)[8]) { f[0] = bf_lo(w.x); f[1] = bf_hi(w.x); f[2] = bf_lo(w.y); f[3] = bf_hi(w.y); f[4] = bf_lo(w.z); f[5] = bf_hi(w.z); f[6] = bf_lo(w.w); f[7] = bf_hi(w.w); }
__device__ __forceinline__ void conv_phase(Frame& F, const float* cw, const float* cb) {
    const bf16_t* V = (const bf16_t*)(F.ws + WS_ACT); const bf16_t* BG = (const bf16_t*)(F.ws + WS_ACT + ACT_SUB); bf16_t* GG = (bf16_t*)(F.ws + WS_ACT + 2 * ACT_SUB);
    for (int row = F.gw; row < MROWS; row += F.ngw) {
        const bf16_t* cur = V + (size_t)row * D; const bf16_t* p1 = cur; const bf16_t* p2 = cur; float m1 = 1.f, m2 = 1.f;
        if (row < MREAL) { const int t = row & (SEQ - 1);
            if (t >= 2) { p1 = cur - D; p2 = cur - 2 * D; }
            else if (t == 1) { p1 = cur - D; p2 = V + (size_t)(MREAL + 15) * D; }
            else { p1 = V + (size_t)(MREAL + 15) * D; p2 = V + (size_t)(MREAL + 14) * D; }
        } else { const int i = row - MREAL; if (i >= 1) p1 = cur - D; else m1 = 0.f; if (i >= 2) p2 = cur - 2 * D; else m2 = 0.f; }
#pragma unroll
        for (int j = 0; j < 4; ++j) { const int c0 = 8 * (F.lane + 64 * j);
            float a[8], b1[8], b2[8], bg[8];
            unpack8(*(const u32x4*)(cur + c0), a); unpack8(*(const u32x4*)(p1 + c0), b1); unpack8(*(const u32x4*)(p2 + c0), b2); unpack8(*(const u32x4*)(BG + (size_t)row * D + c0), bg);
            float o[8];
#pragma unroll
            for (int h = 0; h < 2; ++h) { const f32x4 w0 = *(const f32x4*)(cw + c0 + 4 * h), w1 = *(const f32x4*)(cw + D + c0 + 4 * h), w2 = *(const f32x4*)(cw + 2 * D + c0 + 4 * h), bbv = *(const f32x4*)(cb + c0 + 4 * h);
#pragma unroll
                for (int e = 0; e < 4; ++e) o[4 * h + e] = bg[4 * h + e] * (w0[e] * (b2[4 * h + e] * m2) + w1[e] * (b1[4 * h + e] * m1) + w2[e] * a[4 * h + e] + bbv[e]); }
            *(u32x4*)(GG + (size_t)row * D + c0) = (u32x4){pk2(o[0], o[1]), pk2(o[2], o[3]), pk2(o[4], o[5]), pk2(o[6], o[7])};
        }
    }
}

#ifndef ATTN_EARLY_EXIT
#define ATTN_EARLY_EXIT 1
#endif
__device__ __forceinline__ void attn_unit(Frame& F, const bf16_t* Qb, bf16_t* Ob, const bf16_t* KB, const bf16_t* VT, int b, int h, int qi) {
    const int lane = F.lane, ql = lane & 31, hh = lane >> 5;
    const bool qvalid = (qi > 0) || (ql >= 16);
    const int qrow = (qi > 0) ? (b * SEQ + 32 * (qi - 1) + ql) : (MREAL + (qvalid ? ql - 16 : 0));
    const bf16_t* qp = Qb + (size_t)qrow * D + h * HD + 8 * hh;
    bf16x8 qf[8];
#pragma unroll
    for (int s = 0; s < 8; ++s) qf[s] = *(const bf16x8*)(qp + 16 * s);
    const bf16_t* kbase = KB + (size_t)(b * NH + h) * TS * HD + (size_t)ql * HD + 8 * hh;
    const bf16_t* vbase = VT + ((size_t)(b * NH + h) * HD + ql) * TS + 4 * hh;
    f32x16 oacc[4];
#pragma unroll
    for (int i = 0; i < 4; ++i)
#pragma unroll
        for (int r = 0; r < 16; ++r) oacc[i][r] = 0.f;
    float C = qvalid ? 0.f : -1e30f;
    const int qs = 32 * qi + ql;
    for (int kt = qi; kt >= 0; --kt) {
        const bf16_t* kp = kbase + (size_t)(32 * kt) * HD;
        bf16x8 kf[8];
#pragma unroll
        for (int s = 0; s < 8; ++s) kf[s] = *(const bf16x8*)(kp + 16 * s);
        f32x16 z;
#pragma unroll
        for (int r = 0; r < 16; ++r) z[r] = 0.f;
#pragma unroll
        for (int s = 0; s < 8; ++s) z = __builtin_amdgcn_mfma_f32_32x32x16_bf16(kf[s], qf[s], z, 0, 0, 0);
        float lk[16], lb[16]; bool vld[16];
#pragma unroll
        for (int r = 0; r < 16; ++r) { const int ks = 32 * kt + (r & 3) + 8 * (r >> 2) + 4 * hh; vld[r] = (ks < qs) && (ks >= 16);
            const float zz = z[r], e = __expf(-fabsf(zz)), sp = fmaxf(zz, 0.f) + __logf(1.f + e); lb[r] = zz - sp; lk[r] = vld[r] ? -sp : 0.f; }
        float G[4], PG[4];
#pragma unroll
        for (int g = 0; g < 4; ++g) { G[g] = (lk[4 * g] + lk[4 * g + 1]) + (lk[4 * g + 2] + lk[4 * g + 3]); PG[g] = __shfl_xor(G[g], 32); }
        float suf[4]; suf[3] = 0.f; suf[2] = G[3] + PG[3]; suf[1] = suf[2] + (G[2] + PG[2]); suf[0] = suf[1] + (G[1] + PG[1]);
        const float TT = suf[0] + (G[0] + PG[0]);
        float a[16];
#pragma unroll
        for (int g = 0; g < 4; ++g) { const float base = C + suf[g] + (hh == 0 ? PG[g] : 0.f);
            const float s3 = 0.f, s2 = lk[4 * g + 3], s1 = s2 + lk[4 * g + 2], s0 = s1 + lk[4 * g + 1];
            a[4 * g + 0] = vld[4 * g + 0] ? __expf(lb[4 * g + 0] + base + s0) : 0.f; a[4 * g + 1] = vld[4 * g + 1] ? __expf(lb[4 * g + 1] + base + s1) : 0.f;
            a[4 * g + 2] = vld[4 * g + 2] ? __expf(lb[4 * g + 2] + base + s2) : 0.f; a[4 * g + 3] = vld[4 * g + 3] ? __expf(lb[4 * g + 3] + base + s3) : 0.f; }
        C += TT;
        bf16x8 pf[2];
#pragma unroll
        for (int s2 = 0; s2 < 2; ++s2) { const u32x4 w = {pk2(a[8 * s2], a[8 * s2 + 1]), pk2(a[8 * s2 + 2], a[8 * s2 + 3]), pk2(a[8 * s2 + 4], a[8 * s2 + 5]), pk2(a[8 * s2 + 6], a[8 * s2 + 7])}; pf[s2] = __builtin_bit_cast(bf16x8, w); }
        const bf16_t* vp = vbase + 32 * kt;
#pragma unroll
        for (int blk = 0; blk < 4; ++blk)
#pragma unroll
            for (int s2 = 0; s2 < 2; ++s2) { const bf16_t* p = vp + (size_t)(32 * blk) * TS + 16 * s2;
                const u32x2 lo = *(const u32x2*)p, hi = *(const u32x2*)(p + 8); const u32x4 w = {lo.x, lo.y, hi.x, hi.y};
                oacc[blk] = __builtin_amdgcn_mfma_f32_32x32x16_bf16(__builtin_bit_cast(bf16x8, w), pf[s2], oacc[blk], 0, 0, 0); }
#if ATTN_EARLY_EXIT
        if (__all(C < -104.0f)) break;
#endif
    }
    if (qvalid) { bf16_t* op = Ob + (size_t)qrow * D + h * HD + 4 * hh;
#pragma unroll
        for (int blk = 0; blk < 4; ++blk)
#pragma unroll
            for (int g = 0; g < 4; ++g) *(u32x2*)(op + 32 * blk + 8 * g) = pk4((f32x4){oacc[blk][4 * g], oacc[blk][4 * g + 1], oacc[blk][4 * g + 2], oacc[blk][4 * g + 3]}); }
}
__device__ __forceinline__ void attn_phase(Frame& F) {
    const bf16_t* Qb = (const bf16_t*)(F.ws + WS_ACT); bf16_t* Ob = (bf16_t*)(F.ws + WS_ACT + ACT_SUB);
    const bf16_t* KB = (const bf16_t*)(F.ws + WS_KB); const bf16_t* VT = (const bf16_t*)(F.ws + WS_VT);
    int k = 0;
    for (int u = F.gw; u < NB * NH * 64 + NH; u += F.ngw, ++k) {
        if (u < NB * NH * 64) { const int bh = u >> 6, q0 = u & 63, qi = (k & 1) ? (64 - q0) : (1 + q0); attn_unit(F, Qb, Ob, KB, VT, bh >> 4, bh & 15, qi); }
        else attn_unit(F, Qb, Ob, KB, VT, 0, u - NB * NH * 64, 0);
    }
}

struct Args { const float* in[13]; float* out; unsigned char* ws; };
__global__ void __launch_bounds__(NWAVES * 64, 2) yoco_fwd(Args args) {
    extern __shared__ __attribute__((aligned(16))) unsigned char lds[];
    Frame F;
    F.lds = (LAS unsigned char*)lds;
    F.tid = threadIdx.x; F.lane = F.tid & 63; F.wave = __builtin_amdgcn_readfirstlane(F.tid >> 6);
    F.G = gridDim.x; { const int bx = blockIdx.x; F.vcu = (F.G % 8 == 0) ? (bx % 8) * (F.G / 8) + bx / 8 : bx; }
    F.gw = F.vcu * NWAVES + F.wave; F.ngw = F.G * NWAVES;
    F.ws = args.ws;
    for (int u = F.tid; u < (LDS_BYTES - LDSCTL_OFF) / 4; u += NWAVES * 64) ((LAS unsigned*)(F.lds + LDSCTL_OFF))[u] = 0u;
    __syncthreads();
    unsigned* ctl = (unsigned*)(F.ws + WS_CTL);
    XcdBarrier bar = xcd_barrier_post(ctl + CW_BAR, (volatile LAS unsigned*)(F.lds + MISC_OFF) + 8);
#define GRID_BAR() do { xcd_barrier(bar); PHASE_BEGIN(); } while (0)
#define PHASE_BEGIN() do { int t_ = threadIdx.x; asm volatile("" : "+v"(t_)); F.tid = t_; F.lane = t_ & 63; F.wave = __builtin_amdgcn_readfirstlane(t_ >> 6); F.gw = F.vcu * NWAVES + F.wave; \
        unsigned long long w_ = (unsigned long long)args.ws; asm volatile("" : "+s"(w_)); F.ws = (unsigned char*)w_; } while (0)
#define HB ((bf16_t*)(F.ws + WS_HB))
#define X32 ((float*)(F.ws + WS_X32))
#define ACT ((bf16_t*)(F.ws + WS_ACT))

    PHASE_BEGIN();
    p0_prologue(F, args.in[0], args.in[1], args.in[4], args.in[5], args.in[6], args.in[9], args.in[10], args.in[12], args.in[11]);
    GRID_BAR();

    for (int l = 0; l < DEPTH; ++l) {
        for (int s = 0; s < 2; ++s) {
            { const bf16_t* W1 = (const bf16_t*)(F.ws + WS_W1T + (size_t)(2 * l + s) * W1T_BYTES);
              pg8::Gemm g{HB, W1, MREAL, FF2, D}; pg8::StaticOrder S; S.init(MREAL, FF2, F.G, (int)blockIdx.x); EpiSwiglu E{ACT};
              pg8::gemm_phase<EpiSwiglu, pg8::StaticOrder, true, true>(F.lds + RING_OFF, g, S, E);
              meta_gemm<true>(HB + (size_t)MREAL * D, D, W1, D, FF, (int)blockIdx.x, F.G, F.wave, F.lane, F.lds + RING_OFF, E); }
            GRID_BAR();
            { const bf16_t* W2 = (const bf16_t*)(F.ws + WS_W2T + (size_t)(2 * l + s) * W2T_BYTES);
              pg8::Gemm g{ACT, W2, MREAL, D, FF}; pg8::StaticOrder S; S.init(MREAL, D, F.G, (int)blockIdx.x); EpiResid E{X32, 0.5f};
              pg8::gemm_phase<EpiResid, pg8::StaticOrder, true, true>(F.lds + RING_OFF, g, S, E);
              meta_gemm<false>(ACT + (size_t)MREAL * FF, FF, W2, FF, D, (int)blockIdx.x, F.G, F.wave, F.lane, F.lds + RING_OFF, E); }
            GRID_BAR();
            { const int li = (s == 0) ? 0 : 2; ln_phase(F, args.in[2] + (size_t)(l * 3 + li) * D, args.in[3] + (size_t)(l * 3 + li) * D, l == DEPTH - 1 && s == 1, args.out); }
            GRID_BAR();
            if (s == 0) {
                if (l < NCONV) {
                    { const bf16_t* Wc = (const bf16_t*)(F.ws + WS_WCIN + (size_t)l * WCIN_BYTES);
                      pg8::Gemm g{HB, Wc, MREAL, 3 * D, D}; pg8::StaticOrder S; S.init(MREAL, 3 * D, F.G, (int)blockIdx.x);
                      EpiConvIn E{ACT, (bf16_t*)(F.ws + WS_ACT + ACT_SUB)};
                      pg8::gemm_phase<EpiConvIn, pg8::StaticOrder, true, true>(F.lds + RING_OFF, g, S, E);
                      MetaConvV EV{ACT}; meta_gemm<true>(HB + (size_t)MREAL * D, D, Wc, D, D, (int)blockIdx.x, F.G, F.wave, F.lane, F.lds + RING_OFF, EV);
                      EpiBf16S EB{(bf16_t*)(F.ws + WS_ACT + ACT_SUB), 1.0f}; meta_gemm<false>(HB + (size_t)MREAL * D, D, Wc + (size_t)(2 * D) * D, D, D, (int)blockIdx.x, F.G, F.wave, F.lane, F.lds + RING_OFF, EB); }
                    GRID_BAR();
                    conv_phase(F, args.in[7] + (size_t)l * 3 * D, args.in[8] + (size_t)l * D);
                    GRID_BAR();
                    { const bf16_t* Wo = (const bf16_t*)(F.ws + WS_WCOUT + (size_t)l * SQ_BYTES); const bf16_t* GG = (const bf16_t*)(F.ws + WS_ACT + 2 * ACT_SUB);
                      pg8::Gemm g{GG, Wo, MREAL, D, D}; pg8::StaticOrder S; S.init(MREAL, D, F.G, (int)blockIdx.x); EpiResid E{X32, 1.0f};
                      pg8::gemm_phase<EpiResid, pg8::StaticOrder, true, true>(F.lds + RING_OFF, g, S, E);
                      meta_gemm<false>(GG + (size_t)MREAL * D, D, Wo, D, D, (int)blockIdx.x, F.G, F.wave, F.lane, F.lds + RING_OFF, E); }
                } else {
                    const int j = l - NCONV;
                    { const bf16_t* Wq = (const bf16_t*)(F.ws + WS_WQ + (size_t)j * SQ_BYTES);
                      pg8::Gemm g{HB, Wq, MREAL, D, D}; pg8::StaticOrder S; S.init(MREAL, D, F.G, (int)blockIdx.x); EpiBf16S E{ACT, QSCALE};
                      pg8::gemm_phase<EpiBf16S, pg8::StaticOrder, true, true>(F.lds + RING_OFF, g, S, E);
                      meta_gemm<false>(HB + (size_t)MREAL * D, D, Wq, D, D, (int)blockIdx.x, F.G, F.wave, F.lane, F.lds + RING_OFF, E); }
                    GRID_BAR();
                    attn_phase(F);
                    GRID_BAR();
                    { const bf16_t* Wo = (const bf16_t*)(F.ws + WS_WO + (size_t)j * SQ_BYTES); const bf16_t* Ob = (const bf16_t*)(F.ws + WS_ACT + ACT_SUB);
                      pg8::Gemm g{Ob, Wo, MREAL, D, D}; pg8::StaticOrder S; S.init(MREAL, D, F.G, (int)blockIdx.x); EpiResid E{X32, 1.0f};
                      pg8::gemm_phase<EpiResid, pg8::StaticOrder, true, true>(F.lds + RING_OFF, g, S, E);
                      meta_gemm<false>(Ob + (size_t)MREAL * D, D, Wo, D, D, (int)blockIdx.x, F.G, F.wave, F.lane, F.lds + RING_OFF, E); }
                }
                GRID_BAR();
                ln_phase(F, args.in[2] + (size_t)(l * 3 + 1) * D, args.in[3] + (size_t)(l * 3 + 1) * D, false, args.out);
                GRID_BAR();
            }
        }
        if (l == NCONV - 1) {
            const bf16_t* Wkv = (const bf16_t*)(F.ws + WS_WKV);
            pg8::Gemm g{HB, Wkv, MREAL, 2 * D, D}; pg8::StaticOrder S; S.init(MREAL, 2 * D, F.G, (int)blockIdx.x); EpiKV E{(bf16_t*)(F.ws + WS_KB), (bf16_t*)(F.ws + WS_VT)};
            pg8::gemm_phase<EpiKV, pg8::StaticOrder, true, true>(F.lds + RING_OFF, g, S, E);
            meta_gemm<false>(HB + (size_t)MREAL * D, D, Wkv, D, 2 * D, (int)blockIdx.x, F.G, F.wave, F.lane, F.lds + RING_OFF, E);
            GRID_BAR();
        }
    }
}

extern "C" void kernel_launch(void* const* d_in, const int* in_sizes, int n_in, void* d_out, int out_size, void* d_ws, size_t ws_size, hipStream_t stream) {
    static int grid = 0;
    if (grid == 0) {
        if (n_in != 13 || in_sizes[0] != MREAL * D || out_size != MREAL * D || ws_size < WS_END) { fprintf(stderr, "kernel_launch: unexpected shapes (n_in %d, in0 %d, out %d, ws %zu)\n", n_in, n_in > 0 ? in_sizes[0] : -1, out_size, ws_size); grid = -1; return; }
        int dev = 0, cus = 0;
        if (hipGetDevice(&dev) != hipSuccess || hipDeviceGetAttribute(&cus, hipDeviceAttributeMultiprocessorCount, dev) != hipSuccess) { grid = -1; return; }
        if (hipFuncSetAttribute((const void*)yoco_fwd, hipFuncAttributeMaxDynamicSharedMemorySize, LDS_BYTES) != hipSuccess) { fprintf(stderr, "kernel_launch: hipFuncSetAttribute failed\n"); grid = -1; return; }
        int per_cu = 0;
        if (hipOccupancyMaxActiveBlocksPerMultiprocessor(&per_cu, (const void*)yoco_fwd, NWAVES * 64, LDS_BYTES) != hipSuccess || per_cu < 1) fprintf(stderr, "kernel_launch: occupancy query says %d\n", per_cu);
        (void)hipGetLastError();
        grid = cus;
    }
    if (grid < 0) return;
    if (hipMemsetAsync((char*)d_ws + WS_CTL, 0, CTL_ZERO_BYTES, stream) != hipSuccess) return;
    Args a{};
    for (int i = 0; i < 13; ++i) a.in[i] = (const float*)d_in[i];
    a.out = (float*)d_out; a.ws = (unsigned char*)d_ws;
    hipLaunchKernelGGL(yoco_fwd, dim3(grid), dim3(NWAVES * 64), LDS_BYTES, stream, a);
}
```

```cpp
#include <hip/hip_runtime.h>
#include <cstdio>
#include <cstdint>

constexpr int D = 2048, NB = 8, SEQ = 2048, NMETA = 16, NH = 16, HD = 128, FF = 5632, FF2 = 11264, DEPTH = 4, NCONV = 2;
constexpr int MREAL = NB * SEQ;
constexpr int MROWS = MREAL + NMETA;
constexpr int MCAP = 16640;
constexpr int TS = 2080;
constexpr float ALPHA = 1.6817928305074290f, LN_EPS = 1e-5f, QSCALE = 0.08838834764831845f;

constexpr size_t MiB = 1u << 20;
constexpr size_t WS_CTL = 0, CTL_ZERO_BYTES = 5 * MiB;
constexpr size_t WS_STATS = 1 * MiB, STATS_BYTES = 160 * 1024;
constexpr size_t WS_CG = 3 * MiB + 256 * 1024;
constexpr int NCGCB = 8 * 11264 + 2 * 6144 + 2 * 2048 + 4096;
constexpr size_t WS_CB = WS_CG + (size_t)NCGCB * 4;
constexpr size_t WS_ZEROS = WS_CB + (size_t)NCGCB * 4;
static_assert(WS_ZEROS + 8192 <= CTL_ZERO_BYTES && WS_STATS + 13 * STATS_BYTES <= WS_CG, "zeroed region map");
constexpr size_t WS_ONES = 5 * MiB;
constexpr size_t WS_W1T = 6 * MiB, W1T_BYTES = 44 * MiB;
constexpr size_t WS_W2T = WS_W1T + 8 * W1T_BYTES, W2T_BYTES = 22 * MiB;
constexpr size_t WS_WCIN = WS_W2T + 8 * W2T_BYTES, WCIN_BYTES = 24 * MiB;
constexpr size_t SQ_BYTES = 8 * MiB;
constexpr size_t WS_WCOUT = WS_WCIN + 2 * WCIN_BYTES;
constexpr size_t WS_WQ = WS_WCOUT + 2 * SQ_BYTES;
constexpr size_t WS_WO = WS_WQ + 2 * SQ_BYTES;
constexpr size_t WS_WKV = WS_WO + 2 * SQ_BYTES;
constexpr size_t WS_HB = WS_WKV + 16 * MiB;
constexpr size_t WS_X32 = WS_HB + 65 * MiB;
constexpr size_t WS_ACT = WS_X32 + 130 * MiB;
constexpr size_t ACT_SUB = 65 * MiB;
constexpr size_t WS_KB = WS_ACT + 195 * MiB;
constexpr size_t WS_VT = WS_KB + 65 * MiB;
constexpr size_t WS_END = WS_VT + 65 * MiB;
constexpr int CW_BAR = 4096;

constexpr int RING_OFF = 0, RING_BYTES = 131072;
constexpr int LDSCTL_OFF = RING_BYTES, MISC_OFF = LDSCTL_OFF + 320;
constexpr int LDS_BYTES = 147456;
constexpr int NWAVES = 8;

#define GAS __attribute__((address_space(1)))
#define LAS __attribute__((address_space(3)))
typedef unsigned short bf16_t;
typedef short bf16x8 __attribute__((ext_vector_type(8)));
typedef short s16x4 __attribute__((ext_vector_type(4)));
typedef float f32x4 __attribute__((ext_vector_type(4)));
typedef float f32x16 __attribute__((ext_vector_type(16)));
typedef unsigned u32x4 __attribute__((ext_vector_type(4)));
typedef unsigned u32x2 __attribute__((ext_vector_type(2)));
typedef __bf16 bf2_t __attribute__((ext_vector_type(2)));
typedef float f2_t __attribute__((ext_vector_type(2)));
__device__ __forceinline__ unsigned pk2(float lo, float hi) { f2_t v = {lo, hi}; bf2_t r = __builtin_convertvector(v, bf2_t); return __builtin_bit_cast(unsigned, r); }
__device__ __forceinline__ float bf_lo(unsigned w) { return __uint_as_float(w << 16); }
__device__ __forceinline__ float bf_hi(unsigned w) { return __uint_as_float(w & 0xffff0000u); }

namespace pg8 {
#define PG8_LAS __attribute__((address_space(3)))
constexpr int BM = 256, BK = 64, HALF = 128, HTB = HALF * BK * 2, STAGE_BYTES = 8 * HTB, NXCD = 8, WGM = 8;
__host__ __device__ __forceinline__ int lds_byte(int r, int c) { const int st = (r >> 4) * 2 + (c >> 5), rr = r & 15, cc = c & 31, ob = rr * 64 + cc * 2; return st * 1024 + (ob ^ (((ob >> 9) & 1) << 5)); }
__host__ __device__ __forceinline__ void stage_rc(int b, int& R, int& C) { const int st = b / 1024, sb = b % 1024, swz = sb ^ (((sb >> 9) & 1) << 5); R = (st >> 1) * 16 + swz / 64; C = (st & 1) * 32 + (swz % 64) / 2; }
__host__ __device__ __forceinline__ int perm32(int rho) { const int n = rho >> 4, i = rho & 15; return 8 * (i >> 2) + 4 * n + (i & 3); }
struct Unit { int pm, pn; };
struct Gemm { const bf16_t* A; const bf16_t* Bt; int M, N, K; };
struct StaticOrder {
    int nM, nN, nwg, G, c;
    __host__ __device__ void init(int M, int N, int G_, int c_) { nM = M / BM; nN = N / BM; nwg = nM * nN; G = G_; c = c_; }
    __host__ __device__ bool next(int i, Unit& u) const {
        const long L = (long)i * G + c; if (L >= nwg) return false;
        int wgid = (int)L; { const int q = nwg / NXCD, r = nwg % NXCD, xcd = wgid % NXCD, off = wgid / NXCD; wgid = (xcd < r ? xcd * (q + 1) : r * (q + 1) + (xcd - r) * q) + off; }
        const int nig = WGM * nN, gid = wgid / nig, fm = gid * WGM, gsz = (nM - fm) < WGM ? (nM - fm) : WGM;
        u.pm = fm + ((wgid % nig) % gsz); u.pn = (wgid % nig) / gsz; return true;
    }
    __device__ __forceinline__ void a_ready(const Unit&) const {}
    __device__ __forceinline__ void done(const Unit&) const {}
};

template <class Epi, class Sched, bool ALIGN_EPI = false, bool SP2 = false>
__device__ __forceinline__ void gemm_phase(PG8_LAS unsigned char* lds, const Gemm g, const Sched& S, const Epi& E) {
    int tid_ = threadIdx.x; asm volatile("" : "+v"(tid_));
    const int tid = tid_, wid = __builtin_amdgcn_readfirstlane(tid >> 6), lane = tid & 63, wr = wid >> 2, wc = wid & 3, fr = lane & 15, fq = lane >> 4;
    const int K = g.K, nt = K / BK;
    unsigned voffA[2], voffB[2];
#pragma unroll
    for (int i = 0; i < 2; ++i) { int R, C; stage_rc(tid * 16 + i * 8192, R, C); const int Rb = Epi::PERM ? ((R & ~31) + perm32(R & 31)) : R;
        voffA[i] = (unsigned)(R * K + C) * 2u; voffB[i] = (unsigned)(Rb * K + C) * 2u; }
    const size_t kstep = (size_t)(BK * 2);
    const size_t hstep = (size_t)HALF * K * 2;
    const size_t tstep = 2 * hstep;
    const unsigned ldsw = (unsigned)wid * 1024u;
    const int aoff = lds_byte(wr * 64 + fr, fq * 8), boff = lds_byte(wc * 32 + fr, fq * 8);
#define PG8_SA(b, h) (((b) * 2 + (h)) * HTB)
#define PG8_SB(b, h) ((4 + (b) * 2 + (h)) * HTB)
#define PG8_STAGE(bufoff, gbase, voff) do { _Pragma("unroll") for (int _i = 0; _i < 2; ++_i) \
        __builtin_amdgcn_global_load_lds((const unsigned*)((const char*)(gbase) + (voff)[_i]), (PG8_LAS unsigned*)(lds + (bufoff) + ldsw + _i * 8192), 16, 0, 0); } while (0)
#define PG8_LDA(dst, b, h) do { _Pragma("unroll") for (int m = 0; m < 4; ++m) _Pragma("unroll") for (int k = 0; k < 2; ++k) dst[m][k] = *(const PG8_LAS bf16x8*)(lds + PG8_SA(b, h) + aoff + m * 2048 + k * 1024); } while (0)
#define PG8_LDB(dst, b, h) do { _Pragma("unroll") for (int n = 0; n < 2; ++n) _Pragma("unroll") for (int k = 0; k < 2; ++k) dst[n][k] = *(const PG8_LAS bf16x8*)(lds + PG8_SB(b, h) + boff + n * 2048 + k * 1024); } while (0)
#define PG8_MMA(ai, bj, At, Bt) do { __builtin_amdgcn_s_setprio(1); _Pragma("unroll") for (int m = 0; m < 4; ++m) _Pragma("unroll") for (int n = 0; n < 2; ++n) _Pragma("unroll") for (int k = 0; k < 2; ++k) \
        acc[ai][bj][m][n] = __builtin_amdgcn_mfma_f32_16x16x32_bf16(Bt[n][k], At[m][k], acc[ai][bj][m][n], 0, 0, 0); __builtin_amdgcn_s_setprio(0); } while (0)
#define PG8_WAIT_V(n) asm volatile("s_waitcnt vmcnt(" #n ")" ::: "memory")
#define PG8_WAIT_L(n) asm volatile("s_waitcnt lgkmcnt(" #n ")" ::: "memory")
#define PG8_BAR __builtin_amdgcn_s_barrier()
#define PG8_SCHED __builtin_amdgcn_sched_barrier(0)
    Unit cur, nxt; int ui = 0;
    if (!S.next(0, cur)) return;
    f32x4 acc[2][2][4][2];
#pragma unroll
    for (int a = 0; a < 2; ++a)
#pragma unroll
        for (int b = 0; b < 2; ++b)
#pragma unroll
            for (int m = 0; m < 4; ++m)
#pragma unroll
                for (int n = 0; n < 2; ++n) acc[a][b][m][n] = (f32x4){0.f, 0.f, 0.f, 0.f};
    bf16x8 At[4][2], B0[2][2], B1[2][2];
    const char* cA = (const char*)g.A + (size_t)cur.pm * tstep; const char* cB = (const char*)g.Bt + (size_t)cur.pn * tstep;
    S.a_ready(cur);
    if constexpr (SP2) {
        PG8_STAGE(PG8_SB(0, 0), cB, voffB); PG8_STAGE(PG8_SB(0, 1), cB + hstep, voffB); PG8_STAGE(PG8_SA(0, 0), cA, voffA); PG8_STAGE(PG8_SA(0, 1), cA + hstep, voffA);
        if (wr == 1) PG8_BAR;
        PG8_WAIT_V(2); PG8_BAR;
        PG8_STAGE(PG8_SB(1, 0), cB + kstep, voffB); PG8_STAGE(PG8_SA(1, 0), cA + kstep, voffA); PG8_STAGE(PG8_SB(1, 1), cB + hstep + kstep, voffB);
        PG8_WAIT_V(6); PG8_BAR;
    } else {
        PG8_STAGE(PG8_SB(0, 0), cB, voffB); PG8_STAGE(PG8_SA(0, 0), cA, voffA); PG8_STAGE(PG8_SB(0, 1), cB + hstep, voffB); PG8_STAGE(PG8_SA(0, 1), cA + hstep, voffA);
        if (wr == 1) PG8_BAR;
        PG8_WAIT_V(4); PG8_BAR;
        PG8_STAGE(PG8_SB(1, 0), cB + kstep, voffB); PG8_STAGE(PG8_SA(1, 0), cA + kstep, voffA); PG8_STAGE(PG8_SB(1, 1), cB + hstep + kstep, voffB);
        PG8_WAIT_V(6); PG8_BAR;
    }
    for (;;) {
        const bool has_next = S.next(ui + 1, nxt);
        const char* nA = has_next ? (const char*)g.A + (size_t)nxt.pm * tstep : cA; const char* nB = has_next ? (const char*)g.Bt + (size_t)nxt.pn * tstep : cB;
        for (int t = 0; t < nt; t += 2) {
            const bool last = (t == nt - 2);
            const char* a1 = cA + (size_t)(t + 1) * kstep;
            const char* a2 = last ? nA : cA + (size_t)(t + 2) * kstep; const char* b2 = last ? nB : cB + (size_t)(t + 2) * kstep;
            const char* a3 = a2 + kstep; const char* b3 = b2 + kstep;
            if (last && has_next) S.a_ready(nxt);
            if constexpr (SP2) {
            PG8_LDB(B0, 0, 0); PG8_LDB(B1, 0, 1); PG8_SCHED; PG8_LDA(At, 0, 0); PG8_STAGE(PG8_SA(1, 1), a1 + hstep, voffA);
            PG8_WAIT_V(8); PG8_WAIT_L(0); PG8_BAR; PG8_MMA(0, 0, At, B0); PG8_MMA(0, 1, At, B1); PG8_BAR; PG8_SCHED;
            PG8_LDA(At, 0, 1); PG8_STAGE(PG8_SB(0, 0), b2, voffB); PG8_STAGE(PG8_SB(0, 1), b2 + hstep, voffB); PG8_STAGE(PG8_SA(0, 0), a2, voffA);
            PG8_WAIT_V(8); PG8_WAIT_L(0); PG8_BAR; PG8_MMA(1, 0, At, B0); PG8_MMA(1, 1, At, B1); PG8_BAR; PG8_SCHED;
            PG8_LDB(B0, 1, 0); PG8_LDB(B1, 1, 1); PG8_SCHED; PG8_LDA(At, 1, 0); PG8_STAGE(PG8_SA(0, 1), a2 + hstep, voffA);
            PG8_WAIT_V(8); PG8_WAIT_L(0); PG8_BAR; PG8_MMA(0, 0, At, B0); PG8_MMA(0, 1, At, B1); PG8_BAR; PG8_SCHED;
            PG8_LDA(At, 1, 1); PG8_STAGE(PG8_SB(1, 0), b3, voffB); PG8_STAGE(PG8_SB(1, 1), b3 + hstep, voffB); PG8_STAGE(PG8_SA(1, 0), a3, voffA);
            PG8_WAIT_V(8); PG8_WAIT_L(0); PG8_BAR; PG8_MMA(1, 0, At, B0); PG8_MMA(1, 1, At, B1); PG8_BAR; PG8_SCHED;
            } else {
            PG8_LDB(B0, 0, 0); PG8_SCHED; PG8_LDA(At, 0, 0); PG8_STAGE(PG8_SA(1, 1), a1 + hstep, voffA);
            PG8_WAIT_L(8); PG8_BAR; PG8_WAIT_L(0); PG8_MMA(0, 0, At, B0); PG8_BAR; PG8_SCHED;
            PG8_LDB(B1, 0, 1); PG8_STAGE(PG8_SB(0, 0), b2, voffB);
            PG8_BAR; PG8_WAIT_L(0); PG8_MMA(0, 1, At, B1); PG8_BAR;
            PG8_LDA(At, 0, 1); PG8_STAGE(PG8_SA(0, 0), a2, voffA);
            PG8_BAR; PG8_WAIT_L(0); PG8_MMA(1, 0, At, B0); PG8_BAR; PG8_SCHED;
            PG8_STAGE(PG8_SB(0, 1), b2 + hstep, voffB);
            PG8_WAIT_V(6); PG8_BAR; PG8_MMA(1, 1, At, B1); PG8_BAR;
            PG8_LDB(B0, 1, 0); PG8_SCHED; PG8_LDA(At, 1, 0); PG8_STAGE(PG8_SA(0, 1), a2 + hstep, voffA);
            PG8_WAIT_L(8); PG8_BAR; PG8_WAIT_L(0); PG8_MMA(0, 0, At, B0); PG8_BAR; PG8_SCHED;
            PG8_LDB(B1, 1, 1); PG8_STAGE(PG8_SB(1, 0), b3, voffB);
            PG8_BAR; PG8_WAIT_L(0); PG8_MMA(0, 1, At, B1); PG8_BAR;
            PG8_LDA(At, 1, 1); PG8_STAGE(PG8_SA(1, 0), a3, voffA);
            PG8_BAR; PG8_WAIT_L(0); PG8_MMA(1, 0, At, B0); PG8_BAR; PG8_SCHED;
            PG8_STAGE(PG8_SB(1, 1), b3 + hstep, voffB);
            PG8_WAIT_V(6); PG8_BAR; PG8_MMA(1, 1, At, B1); PG8_BAR;
            }
        }
        if constexpr (ALIGN_EPI) { if (wr == 0) PG8_BAR; }
        E(acc, cur, wr, wc, fr, fq);
        if (!has_next) break;
#pragma unroll
        for (int a = 0; a < 2; ++a)
#pragma unroll
            for (int b = 0; b < 2; ++b)
#pragma unroll
                for (int m = 0; m < 4; ++m)
#pragma unroll
                    for (int n = 0; n < 2; ++n) acc[a][b][m][n] = (f32x4){0.f, 0.f, 0.f, 0.f};
        cur = nxt; cA = nA; cB = nB; ++ui;
        if constexpr (ALIGN_EPI) { if (wr == 1) PG8_BAR; }
    }
    PG8_WAIT_V(0);
    if constexpr (!ALIGN_EPI) { if (wr == 0) PG8_BAR; }
    PG8_BAR;
#undef PG8_SA
#undef PG8_SB
#undef PG8_STAGE
#undef PG8_LDA
#undef PG8_LDB
#undef PG8_MMA
#undef PG8_WAIT_V
#undef PG8_WAIT_L
#undef PG8_BAR
#undef PG8_SCHED
}
}

__device__ __forceinline__ float silu_mul(float g, float u) { return g * u * __builtin_amdgcn_rcpf(1.0f + __builtin_amdgcn_exp2f(-1.4426950408889634f * g)); }
__device__ __forceinline__ f32x4 silu_mul4(f32x4 g, f32x4 u) { return (f32x4){silu_mul(g[0], u[0]), silu_mul(g[1], u[1]), silu_mul(g[2], u[2]), silu_mul(g[3], u[3])}; }
__device__ __forceinline__ u32x2 pk4(f32x4 v) { u32x2 w; w.x = pk2(v[0], v[1]); w.y = pk2(v[2], v[3]); return w; }
struct LnFold { const float* stats; const float* cg; const float* cb; };
__device__ __forceinline__ void row_norm(const float* stats, int row, float& rstd, float& t) {
    const f2_t sq = *(const f2_t*)(stats + 2 * (size_t)row); const float mu = sq.x * (1.f / D), var = sq.y * (1.f / D) - mu * mu;
    rstd = __builtin_amdgcn_rsqf(var + LN_EPS); t = -mu * rstd;
}
__device__ __forceinline__ f32x4 lnfix(f32x4 acc, float rstd, float t, f32x4 cg, f32x4 cb) { return acc * rstd + (cg * t + cb); }
__device__ __forceinline__ void stats_add(float* st, int row, float s, float q, int fq) {
    s += __shfl_xor(s, 16); s += __shfl_xor(s, 32); q += __shfl_xor(q, 16); q += __shfl_xor(q, 32);
    if (fq < 2) __hip_atomic_fetch_add(st + 2 * (size_t)row + fq, fq == 0 ? s : q, __ATOMIC_RELAXED, __HIP_MEMORY_SCOPE_AGENT);
}

struct EpiSwiglu {
    static constexpr bool PERM = true;
    bf16_t* O; LnFold L;
    __device__ __forceinline__ void operator()(const f32x4 (&acc)[2][2][4][2], const pg8::Unit& u, int wr, int wc, int fr, int fq) const {
        const int row0 = u.pm * 256 + wr * 64 + fr, col0 = u.pn * 128 + wc * 32 + 8 * fq, tc0 = u.pn * 256 + wc * 32 + 8 * fq;
        f32x4 cg[2][2], cb[2][2];
#pragma unroll
        for (int bj = 0; bj < 2; ++bj)
#pragma unroll
            for (int n = 0; n < 2; ++n) { cg[bj][n] = *(const f32x4*)(L.cg + tc0 + 128 * bj + 4 * n); cb[bj][n] = *(const f32x4*)(L.cb + tc0 + 128 * bj + 4 * n); }
#pragma unroll
        for (int ai = 0; ai < 2; ++ai)
#pragma unroll
            for (int m = 0; m < 4; ++m) { const int row = row0 + ai * 128 + m * 16; float rstd, t; row_norm(L.stats, row, rstd, t);
                const u32x2 a = pk4(silu_mul4(lnfix(acc[ai][0][m][0], rstd, t, cg[0][0], cb[0][0]), lnfix(acc[ai][1][m][0], rstd, t, cg[1][0], cb[1][0])));
                const u32x2 b = pk4(silu_mul4(lnfix(acc[ai][0][m][1], rstd, t, cg[0][1], cb[0][1]), lnfix(acc[ai][1][m][1], rstd, t, cg[1][1], cb[1][1])));
                *(u32x4*)(O + (size_t)row * FF + col0) = (u32x4){a.x, a.y, b.x, b.y}; }
    }
    __device__ __forceinline__ void meta(int r, int col, f32x4 g, f32x4 up) const {
        const int row = MREAL + r, tc = 256 * (col >> 7) + (col & 127); float rstd, t; row_norm(L.stats, row, rstd, t);
        g = lnfix(g, rstd, t, *(const f32x4*)(L.cg + tc), *(const f32x4*)(L.cb + tc)); up = lnfix(up, rstd, t, *(const f32x4*)(L.cg + tc + 128), *(const f32x4*)(L.cb + tc + 128));
        *(u32x2*)(O + (size_t)row * FF + col) = pk4(silu_mul4(g, up)); }
};
struct EpiResidLN {
    static constexpr bool PERM = false;
    const float* Rin; const float* RinMeta; float* Rout; bf16_t* Hb; const float* st_prev; const float* g; const float* b; float* st_new; float coef;
    __device__ __forceinline__ void operator()(const f32x4 (&acc)[2][2][4][2], const pg8::Unit& u, int wr, int wc, int fr, int fq) const {
        const int row0 = u.pm * 256 + wr * 64 + fr, col0 = u.pn * 256 + wc * 32 + 4 * fq;
        f32x4 gv[2][2], bv[2][2];
#pragma unroll
        for (int bj = 0; bj < 2; ++bj)
#pragma unroll
            for (int n = 0; n < 2; ++n) { gv[bj][n] = *(const f32x4*)(g + col0 + bj * 128 + n * 16); bv[bj][n] = *(const f32x4*)(b + col0 + bj * 128 + n * 16); }
#pragma unroll
        for (int am = 0; am < 4; ++am) { const int ai = am >> 1, mb = (am & 1) * 2;
            f32x4 h[2][2][2];
#pragma unroll
            for (int mm = 0; mm < 2; ++mm) { const float* p = Rin + (size_t)(row0 + ai * 128 + (mb + mm) * 16) * D + col0;
#pragma unroll
                for (int bj = 0; bj < 2; ++bj)
#pragma unroll
                    for (int n = 0; n < 2; ++n) h[mm][bj][n] = *(const f32x4*)(p + bj * 128 + n * 16); }
#pragma unroll
            for (int mm = 0; mm < 2; ++mm) { const int m = mb + mm; const int row = row0 + ai * 128 + m * 16; float rstd, t; row_norm(st_prev, row, rstd, t);
                float* p = Rout + (size_t)row * D + col0; bf16_t* hp = Hb + (size_t)row * D + col0; float s = 0.f, q = 0.f;
#pragma unroll
                for (int bj = 0; bj < 2; ++bj)
#pragma unroll
                    for (int n = 0; n < 2; ++n) { const f32x4 hh = (h[mm][bj][n] * rstd + t) * gv[bj][n] + bv[bj][n]; const f32x4 r = hh * ALPHA + acc[ai][bj][m][n] * coef;
                        *(f32x4*)(p + bj * 128 + n * 16) = r; *(u32x2*)(hp + bj * 128 + n * 16) = pk4(r);
                        s += (r[0] + r[1]) + (r[2] + r[3]); q += (r[0] * r[0] + r[1] * r[1]) + (r[2] * r[2] + r[3] * r[3]); }
                stats_add(st_new, row, s, q, fq); }
            asm volatile("" ::: "memory"); }
    }
    __device__ __forceinline__ void meta(int r, int col, f32x4 a, f32x4) const {
        const int row = MREAL + r; float rstd, t; row_norm(st_prev, row, rstd, t);
        const f32x4 h = *(const f32x4*)(RinMeta + (size_t)r * D + col), hh = (h * rstd + t) * *(const f32x4*)(g + col) + *(const f32x4*)(b + col), rr = hh * ALPHA + a * coef;
        *(f32x4*)(Rout + (size_t)row * D + col) = rr; *(u32x2*)(Hb + (size_t)row * D + col) = pk4(rr);
        stats_add(st_new, row, (rr[0] + rr[1]) + (rr[2] + rr[3]), (rr[0] * rr[0] + rr[1] * rr[1]) + (rr[2] * rr[2] + rr[3] * rr[3]), col >> 2 & 3); }
};
struct EpiConvIn {
    static constexpr bool PERM = true;
    bf16_t* V; bf16_t* BG; LnFold L;
    __device__ __forceinline__ void operator()(const f32x4 (&acc)[2][2][4][2], const pg8::Unit& u, int wr, int wc, int fr, int fq) const {
        const int row0 = u.pm * 256 + wr * 64 + fr, tc0 = u.pn * 256 + wc * 32 + 8 * fq;
        f32x4 cg[2][2], cb[2][2];
#pragma unroll
        for (int bj = 0; bj < 2; ++bj)
#pragma unroll
            for (int n = 0; n < 2; ++n) { cg[bj][n] = *(const f32x4*)(L.cg + tc0 + 128 * bj + 4 * n); cb[bj][n] = *(const f32x4*)(L.cb + tc0 + 128 * bj + 4 * n); }
        if (u.pn < 16) {
            const int col0 = u.pn * 128 + wc * 32 + 8 * fq;
#pragma unroll
            for (int ai = 0; ai < 2; ++ai)
#pragma unroll
                for (int m = 0; m < 4; ++m) { const int row = row0 + ai * 128 + m * 16; float rstd, t; row_norm(L.stats, row, rstd, t);
                    const u32x2 a = pk4(lnfix(acc[ai][0][m][0], rstd, t, cg[0][0], cb[0][0]) * lnfix(acc[ai][1][m][0], rstd, t, cg[1][0], cb[1][0]));
                    const u32x2 b = pk4(lnfix(acc[ai][0][m][1], rstd, t, cg[0][1], cb[0][1]) * lnfix(acc[ai][1][m][1], rstd, t, cg[1][1], cb[1][1]));
                    *(u32x4*)(V + (size_t)row * D + col0) = (u32x4){a.x, a.y, b.x, b.y}; }
        } else {
            const int col0 = (u.pn - 16) * 256 + wc * 32 + 8 * fq;
#pragma unroll
            for (int ai = 0; ai < 2; ++ai)
#pragma unroll
                for (int m = 0; m < 4; ++m) { const int row = row0 + ai * 128 + m * 16; float rstd, t; row_norm(L.stats, row, rstd, t); bf16_t* p = BG + (size_t)row * D + col0;
#pragma unroll
                    for (int bj = 0; bj < 2; ++bj) { const u32x2 a = pk4(lnfix(acc[ai][bj][m][0], rstd, t, cg[bj][0], cb[bj][0])), b = pk4(lnfix(acc[ai][bj][m][1], rstd, t, cg[bj][1], cb[bj][1]));
                        *(u32x4*)(p + bj * 128) = (u32x4){a.x, a.y, b.x, b.y}; } }
        }
    }
};
struct MetaConvV { bf16_t* V; LnFold L;
    __device__ __forceinline__ void meta(int r, int col, f32x4 c, f32x4 uu) const {
        const int row = MREAL + r, tc = 256 * (col >> 7) + (col & 127); float rstd, t; row_norm(L.stats, row, rstd, t);
        c = lnfix(c, rstd, t, *(const f32x4*)(L.cg + tc), *(const f32x4*)(L.cb + tc)); uu = lnfix(uu, rstd, t, *(const f32x4*)(L.cg + tc + 128), *(const f32x4*)(L.cb + tc + 128));
        *(u32x2*)(V + (size_t)row * D + col) = pk4(c * uu); } };
struct EpiBf16S {
    static constexpr bool PERM = true;
    bf16_t* O; float scale; LnFold L;
    __device__ __forceinline__ void operator()(const f32x4 (&acc)[2][2][4][2], const pg8::Unit& u, int wr, int wc, int fr, int fq) const {
        const int row0 = u.pm * 256 + wr * 64 + fr, col0 = u.pn * 256 + wc * 32 + 8 * fq;
        f32x4 cg[2][2], cb[2][2];
#pragma unroll
        for (int bj = 0; bj < 2; ++bj)
#pragma unroll
            for (int n = 0; n < 2; ++n) { cg[bj][n] = *(const f32x4*)(L.cg + col0 + 128 * bj + 4 * n); cb[bj][n] = *(const f32x4*)(L.cb + col0 + 128 * bj + 4 * n); }
#pragma unroll
        for (int ai = 0; ai < 2; ++ai)
#pragma unroll
            for (int m = 0; m < 4; ++m) { const int row = row0 + ai * 128 + m * 16; float rstd, t; row_norm(L.stats, row, rstd, t); bf16_t* p = O + (size_t)row * D + col0;
#pragma unroll
                for (int bj = 0; bj < 2; ++bj) { const u32x2 a = pk4(lnfix(acc[ai][bj][m][0], rstd, t, cg[bj][0], cb[bj][0]) * scale), b = pk4(lnfix(acc[ai][bj][m][1], rstd, t, cg[bj][1], cb[bj][1]) * scale);
                    *(u32x4*)(p + bj * 128) = (u32x4){a.x, a.y, b.x, b.y}; } }
    }
    __device__ __forceinline__ void meta(int r, int col, f32x4 a, f32x4) const { const int row = MREAL + r; float rstd, t; row_norm(L.stats, row, rstd, t);
        *(u32x2*)(O + (size_t)row * D + col) = pk4(lnfix(a, rstd, t, *(const f32x4*)(L.cg + col), *(const f32x4*)(L.cb + col)) * scale); }
};
struct EpiKV {
    static constexpr bool PERM = true;
    bf16_t* KB; bf16_t* VT; LnFold L;
    __device__ __forceinline__ void operator()(const f32x4 (&acc)[2][2][4][2], const pg8::Unit& u, int wr, int wc, int fr, int fq) const {
        const int row0 = u.pm * 256 + wr * 64 + fr, d0 = wc * 32 + 8 * fq, tc0 = u.pn * 256 + wc * 32 + 8 * fq;
        f32x4 cg[2][2], cb[2][2];
#pragma unroll
        for (int bj = 0; bj < 2; ++bj)
#pragma unroll
            for (int n = 0; n < 2; ++n) { cg[bj][n] = *(const f32x4*)(L.cg + tc0 + 128 * bj + 4 * n); cb[bj][n] = *(const f32x4*)(L.cb + tc0 + 128 * bj + 4 * n); }
        if (u.pn < 8) {
#pragma unroll
            for (int ai = 0; ai < 2; ++ai)
#pragma unroll
                for (int m = 0; m < 4; ++m) { const int row = row0 + ai * 128 + m * 16, b = row >> 11, ts = 32 + (row & 2047); float rstd, t; row_norm(L.stats, row, rstd, t);
#pragma unroll
                    for (int bj = 0; bj < 2; ++bj) { const int h = 2 * u.pn + bj; bf16_t* p = KB + ((size_t)(b * NH + h) * TS + ts) * HD + d0;
                        const u32x2 a = pk4(lnfix(acc[ai][bj][m][0], rstd, t, cg[bj][0], cb[bj][0])), bq = pk4(lnfix(acc[ai][bj][m][1], rstd, t, cg[bj][1], cb[bj][1])); *(u32x4*)p = (u32x4){a.x, a.y, bq.x, bq.y}; } }
        } else {
#pragma unroll
            for (int ai = 0; ai < 2; ++ai)
#pragma unroll
                for (int m = 0; m < 4; ++m) { const int row = row0 + ai * 128 + m * 16, b = row >> 11, ts = 32 + (row & 2047); float rstd, t; row_norm(L.stats, row, rstd, t);
#pragma unroll
                    for (int bj = 0; bj < 2; ++bj) { const int h = 2 * (u.pn - 8) + bj; bf16_t* p = VT + ((size_t)(b * NH + h) * HD + d0) * TS + ts;
#pragma unroll
                        for (int n = 0; n < 2; ++n) { const u32x2 w = pk4(lnfix(acc[ai][bj][m][n], rstd, t, cg[bj][n], cb[bj][n]));
                            p[(size_t)(4 * n + 0) * TS] = (bf16_t)(w.x & 0xffffu); p[(size_t)(4 * n + 1) * TS] = (bf16_t)(w.x >> 16);
                            p[(size_t)(4 * n + 2) * TS] = (bf16_t)(w.y & 0xffffu); p[(size_t)(4 * n + 3) * TS] = (bf16_t)(w.y >> 16); } } }
        }
    }
    __device__ __forceinline__ void meta(int r, int col, f32x4 a, f32x4) const {
        const int row = MREAL + r; float rstd, t; row_norm(L.stats, row, rstd, t);
        const u32x2 w = pk4(lnfix(a, rstd, t, *(const f32x4*)(L.cg + col), *(const f32x4*)(L.cb + col))); const int ts = 16 + r;
        if (col < D) { const int h = col >> 7, d = col & 127;
            for (int b = 0; b < NB; ++b) *(u32x2*)(KB + ((size_t)(b * NH + h) * TS + ts) * HD + d) = w;
        } else { const int c2 = col - D, h = c2 >> 7, d = c2 & 127;
            for (int b = 0; b < NB; ++b) { bf16_t* p = VT + ((size_t)(b * NH + h) * HD + d) * TS + ts;
                p[0] = (bf16_t)(w.x & 0xffffu); p[(size_t)TS] = (bf16_t)(w.x >> 16); p[(size_t)2 * TS] = (bf16_t)(w.y & 0xffffu); p[(size_t)3 * TS] = (bf16_t)(w.y >> 16); } }
    }
};

template <bool PAIR, class F>
__device__ __forceinline__ void meta_gemm(const bf16_t* A, int lda, const bf16_t* Bt, int K, int ncols, int wg, int nwg, int wave, int lane, LAS unsigned char* lds, const F& f) {
    const int fr = lane & 15, fq = lane >> 4, nunits = ncols >> 4, kper = K >> 3, kbeg = wave * kper;
    LAS f32x4* red = (LAS f32x4*)lds;
    for (int u = wg; u < nunits; u += nwg) {
        int br0 = 16 * u, br1 = 0;
        if (PAIR) { const int j0 = 16 * u; br0 = 256 * (j0 >> 7) + (j0 & 127); br1 = br0 + 128; }
        const bf16_t* ap = A + (size_t)fr * lda + 8 * fq + kbeg;
        const bf16_t* bp0 = Bt + (size_t)(br0 + fr) * K + 8 * fq + kbeg;
        const bf16_t* bp1 = Bt + (size_t)(br1 + fr) * K + 8 * fq + kbeg;
        f32x4 acc0 = {0.f, 0.f, 0.f, 0.f}, acc1 = {0.f, 0.f, 0.f, 0.f};
#pragma unroll 2
        for (int k0 = 0; k0 < kper; k0 += 32) {
            const bf16x8 a = *(const bf16x8*)(ap + k0), b0 = *(const bf16x8*)(bp0 + k0);
            acc0 = __builtin_amdgcn_mfma_f32_16x16x32_bf16(b0, a, acc0, 0, 0, 0);
            if (PAIR) { const bf16x8 b1 = *(const bf16x8*)(bp1 + k0); acc1 = __builtin_amdgcn_mfma_f32_16x16x32_bf16(b1, a, acc1, 0, 0, 0); }
        }
        red[(wave * 2 + 0) * 64 + lane] = acc0; if (PAIR) red[(wave * 2 + 1) * 64 + lane] = acc1;
        __syncthreads();
        if (wave == 0) {
#pragma unroll
            for (int w = 1; w < 8; ++w) { acc0 = acc0 + red[(w * 2 + 0) * 64 + lane]; if (PAIR) acc1 = acc1 + red[(w * 2 + 1) * 64 + lane]; }
            f.meta(fr, 16 * u + 4 * fq, acc0, acc1);
        }
        __syncthreads();
    }
}

#define XB_TMO      128
#define XB_XCNT(j)  (256  + 64 * (j))
#define XB_XSUB(j)  (1280 + 64 * (j))
#define XB_XGEN(j)  (2304 + 64 * (j))
#define XB_TOP      3328
#define XB_TOPGEN   3392
#define XCD_BAR_WORDS 3456
#define XB_SPIN_CAP (1u << 18)
__device__ __forceinline__ unsigned xb_ld(unsigned* p)              { return __hip_atomic_load(p, __ATOMIC_RELAXED, __HIP_MEMORY_SCOPE_AGENT); }
__device__ __forceinline__ unsigned xb_add(unsigned* p, unsigned v) { return __hip_atomic_fetch_add(p, v, __ATOMIC_RELAXED, __HIP_MEMORY_SCOPE_AGENT); }
__device__ __forceinline__ unsigned xb_xcc_id() { return (unsigned)__builtin_amdgcn_s_getreg((3 << 11) | 20) & 0xFu; }
#define XB_SPIN(cond, bar) do { unsigned _sp = 0; while (cond) { __builtin_amdgcn_s_sleep(1); \
    if ((++_sp & 255u) == 0u) { if (xb_ld(&(bar)[XB_TMO])) break; if (_sp > XB_SPIN_CAP) { atomicAdd(&(bar)[XB_TMO], 1u); break; } } } } while (0)
struct XcdBarrier { unsigned* bar; unsigned x; volatile LAS unsigned* st; };
__device__ __forceinline__ XcdBarrier xcd_barrier_post(unsigned* bar, volatile LAS unsigned* st) {
    XcdBarrier b; b.bar = bar; b.x = xb_xcc_id(); b.st = st;
    if (threadIdx.x == 0) (void)xb_add(&bar[XB_XCNT(b.x)], 1u);
    return b;
}
__device__ __forceinline__ void xcd_barrier_complete(unsigned* bar, unsigned x, unsigned& nloc, unsigned& nx) {
    const unsigned G = gridDim.x * gridDim.y * gridDim.z;
    unsigned sum, cnt, mine, sp = 0u;
    for (;;) {
        sum = 0u; cnt = 0u; mine = 0u;
#pragma unroll
        for (unsigned j = 0; j < 16; ++j) { const unsigned c = xb_ld(&bar[XB_XCNT(j)]); sum += c; cnt += (c > 0u) ? 1u : 0u; mine = (j == x) ? c : mine; }
        if (sum == G) break;
        __builtin_amdgcn_s_sleep(1);
        if ((++sp & 255u) == 0u) { if (xb_ld(&bar[XB_TMO])) break; if (sp > XB_SPIN_CAP) { atomicAdd(&bar[XB_TMO], 1u); break; } }
    }
    nloc = mine > 0u ? mine : 1u; nx = cnt > 0u ? cnt : 1u;
}
__device__ __forceinline__ void xcd_barrier(const XcdBarrier& b) {
    asm volatile("s_waitcnt vmcnt(0)" ::: "memory");
    __syncthreads();
    if (threadIdx.x == 0) {
        unsigned* bar = b.bar;
        __builtin_amdgcn_s_waitcnt(0);
        unsigned nloc = b.st[0], nx = b.st[1];
        if (nloc == 0u) { xcd_barrier_complete(bar, b.x, nloc, nx); b.st[0] = nloc; b.st[1] = nx; }
        const unsigned old = xb_add(&bar[XB_XSUB(b.x)], 1u);
        const unsigned gen = old / nloc;
        if (old + 1u == (gen + 1u) * nloc) {
            __builtin_amdgcn_fence(__ATOMIC_RELEASE, "agent");
            asm volatile("s_waitcnt vmcnt(0)" ::: "memory");
            const unsigned og = xb_add(&bar[XB_TOP], 1u);
            const unsigned tg = og / nx;
            if (og + 1u == (tg + 1u) * nx) xb_add(&bar[XB_TOPGEN], 1u);
            else XB_SPIN(xb_ld(&bar[XB_TOPGEN]) == tg, bar);
            __builtin_amdgcn_fence(__ATOMIC_ACQUIRE, "agent");
            xb_add(&bar[XB_XGEN(b.x)], 1u);
            asm volatile("s_waitcnt vmcnt(0)" ::: "memory");
        } else {
            XB_SPIN(xb_ld(&bar[XB_XGEN(b.x)]) == gen, bar);
            __builtin_amdgcn_fence(__ATOMIC_ACQUIRE, "agent");
            asm volatile("s_waitcnt vmcnt(0)" ::: "memory");
        }
    }
    __syncthreads();
}

struct Frame {
    LAS unsigned char* lds;
    int tid, lane, wave, vcu, G, gw, ngw;
    unsigned char* ws;
};
#define LDS_WAIT() asm volatile("s_waitcnt lgkmcnt(0)" ::: "memory")
__device__ __forceinline__ float wave_sum(float v) {
#pragma unroll
    for (int o = 1; o < 64; o <<= 1) v += __shfl_xor(v, o);
    return v;
}

__device__ __forceinline__ void transpose_item(const float* W, int K, int Nsrc, int srccol0, bf16_t* WT, int dstrow0, int k0, LAS float* scr, int lane, const float* gk, const float* bk, float* cg, float* cb) {
    f32x4 v[8];
    const float* src = W + (size_t)(k0 + (lane >> 3)) * Nsrc + srccol0 + 4 * (lane & 7);
#pragma unroll
    for (int i = 0; i < 8; ++i) v[i] = *(const f32x4*)(src + (size_t)(8 * i) * Nsrc);
#pragma unroll
    for (int i = 0; i < 8; ++i) { LAS float* d = scr + (8 * i + (lane >> 3)) * 33 + 4 * (lane & 7); d[0] = v[i][0]; d[1] = v[i][1]; d[2] = v[i][2]; d[3] = v[i][3]; }
    LDS_WAIT(); asm volatile("" ::: "memory");
    const int c = lane & 7;
    if (gk) {
        const f32x4 g0 = *(const f32x4*)(gk + k0 + 8 * c), g1 = *(const f32x4*)(gk + k0 + 8 * c + 4), b0 = *(const f32x4*)(bk + k0 + 8 * c), b1 = *(const f32x4*)(bk + k0 + 8 * c + 4);
        float sg[4], sb[4];
#pragma unroll
        for (int j = 0; j < 4; ++j) { const int n = (lane >> 3) + 8 * j; const LAS float* s = scr + (8 * c) * 33 + n;
            const float w0 = s[0 * 33], w1 = s[1 * 33], w2 = s[2 * 33], w3 = s[3 * 33], w4 = s[4 * 33], w5 = s[5 * 33], w6 = s[6 * 33], w7 = s[7 * 33];
            u32x4 o; o.x = pk2(w0 * g0[0], w1 * g0[1]); o.y = pk2(w2 * g0[2], w3 * g0[3]); o.z = pk2(w4 * g1[0], w5 * g1[1]); o.w = pk2(w6 * g1[2], w7 * g1[3]);
            *(u32x4*)(WT + (size_t)(dstrow0 + n) * K + k0 + 8 * c) = o;
            float a = ((bf_lo(o.x) + bf_hi(o.x)) + (bf_lo(o.y) + bf_hi(o.y))) + ((bf_lo(o.z) + bf_hi(o.z)) + (bf_lo(o.w) + bf_hi(o.w)));
            float bsum = ((w0 * b0[0] + w1 * b0[1]) + (w2 * b0[2] + w3 * b0[3])) + ((w4 * b1[0] + w5 * b1[1]) + (w6 * b1[2] + w7 * b1[3]));
            a += __shfl_xor(a, 1); a += __shfl_xor(a, 2); a += __shfl_xor(a, 4); bsum += __shfl_xor(bsum, 1); bsum += __shfl_xor(bsum, 2); bsum += __shfl_xor(bsum, 4);
            sg[j] = a; sb[j] = bsum; }
        const int srcl = 8 * (lane & 7); float ag = 0.f, ab = 0.f;
#pragma unroll
        for (int j = 0; j < 4; ++j) { const float tg = __shfl(sg[j], srcl), tb = __shfl(sb[j], srcl); if ((lane >> 3) == j) { ag = tg; ab = tb; } }
        if (lane < 32) { __hip_atomic_fetch_add(cg + dstrow0 + lane, ag, __ATOMIC_RELAXED, __HIP_MEMORY_SCOPE_AGENT); __hip_atomic_fetch_add(cb + dstrow0 + lane, ab, __ATOMIC_RELAXED, __HIP_MEMORY_SCOPE_AGENT); }
    } else {
#pragma unroll
        for (int j = 0; j < 4; ++j) { const int n = (lane >> 3) + 8 * j; const LAS float* s = scr + (8 * c) * 33 + n;
            u32x4 o; o.x = pk2(s[0 * 33], s[1 * 33]); o.y = pk2(s[2 * 33], s[3 * 33]); o.z = pk2(s[4 * 33], s[5 * 33]); o.w = pk2(s[6 * 33], s[7 * 33]);
            *(u32x4*)(WT + (size_t)(dstrow0 + n) * K + k0 + 8 * c) = o; }
    }
    LDS_WAIT(); asm volatile("" ::: "memory");
}
constexpr int IT_W1 = (D / 64) * (FF2 / 32), IT_W2 = (FF / 64) * (D / 32), IT_CIN = (D / 64) * (3 * D / 32), IT_SQ = (D / 64) * (D / 32), IT_KV = (D / 64) * (2 * D / 32);
constexpr int IT_END_W1 = 8 * IT_W1, IT_END_W2 = IT_END_W1 + 8 * IT_W2, IT_END_CIN = IT_END_W2 + 2 * IT_CIN, IT_END_COUT = IT_END_CIN + 2 * IT_SQ, IT_END_WQ = IT_END_COUT + 2 * IT_SQ,
              IT_END_WO = IT_END_WQ + 2 * IT_SQ, IT_TOTAL = IT_END_WO + IT_KV;
constexpr int CGO_W1 = 0, CGO_CIN = 8 * FF2, CGO_WQ = CGO_CIN + 2 * 3 * D, CGO_KV = CGO_WQ + 2 * D;
static_assert(CGO_KV + 2 * D == NCGCB, "cg/cb map");
__device__ __forceinline__ void prologue_item(Frame& F, const float* ln_g, const float* ln_b, const float* w_in, const float* w_out, const float* cw_in, const float* cw_out, const float* wq, const float* wo, const float* wkv, int it, LAS float* scr) {
    const float* W; bf16_t* WT; int K, Nsrc, nb, kb, srccol0, dstrow0; int lnq = -1, cgo = 0;
    if (it < IT_END_W1) { const int j = it / IT_W1, r = it % IT_W1; K = D; Nsrc = FF2; W = w_in + (size_t)j * D * FF2; WT = (bf16_t*)(F.ws + WS_W1T + (size_t)j * W1T_BYTES);
        nb = r / (D / 64); kb = r % (D / 64); dstrow0 = 32 * nb; const int pn = dstrow0 >> 8, c = dstrow0 & 255; srccol0 = (c < 128) ? (128 * pn + c) : (FF + 128 * pn + (c - 128));
        const int l = j >> 1; lnq = (j & 1) ? (3 * l + 1) : (3 * l - 1); cgo = CGO_W1 + j * FF2; }
    else if (it < IT_END_W2) { const int q = it - IT_END_W1, j = q / IT_W2, r = q % IT_W2; K = FF; Nsrc = D; W = w_out + (size_t)j * FF * D; WT = (bf16_t*)(F.ws + WS_W2T + (size_t)j * W2T_BYTES);
        nb = r / (FF / 64); kb = r % (FF / 64); dstrow0 = 32 * nb; srccol0 = dstrow0; }
    else if (it < IT_END_CIN) { const int q = it - IT_END_W2, j = q / IT_CIN, r = q % IT_CIN; K = D; Nsrc = 3 * D; W = cw_in + (size_t)j * D * 3 * D; WT = (bf16_t*)(F.ws + WS_WCIN + (size_t)j * WCIN_BYTES);
        nb = r / (D / 64); kb = r % (D / 64); dstrow0 = 32 * nb; const int pn = dstrow0 >> 8, c = dstrow0 & 255;
        srccol0 = (pn < 16) ? ((c < 128) ? (D + 128 * pn + c) : (2 * D + 128 * pn + (c - 128))) : (256 * (pn - 16) + c); lnq = 3 * j; cgo = CGO_CIN + j * 3 * D; }
    else if (it < IT_END_WO) { const int q = it - IT_END_CIN, j = q / IT_SQ, r = q % IT_SQ; K = D; Nsrc = D;
        const float* src = (j < 2) ? cw_out : (j < 4) ? wq : wo; const size_t wsoff = (j < 2) ? WS_WCOUT : (j < 4) ? WS_WQ : WS_WO; const int l = j & 1;
        W = src + (size_t)l * D * D; WT = (bf16_t*)(F.ws + wsoff + (size_t)l * SQ_BYTES);
        nb = r / (D / 64); kb = r % (D / 64); dstrow0 = 32 * nb; srccol0 = dstrow0; if (j == 2 || j == 3) { lnq = 3 * (NCONV + l); cgo = CGO_WQ + l * D; } }
    else { const int r = it - IT_END_WO; K = D; Nsrc = 2 * D; W = wkv; WT = (bf16_t*)(F.ws + WS_WKV); nb = r / (D / 64); kb = r % (D / 64); dstrow0 = 32 * nb; srccol0 = dstrow0; lnq = 3 * (NCONV - 1) + 2; cgo = CGO_KV; }
    const float* gk = (lnq >= 0) ? ln_g + (size_t)lnq * D : nullptr; const float* bk = (lnq >= 0) ? ln_b + (size_t)lnq * D : nullptr;
    transpose_item(W, K, Nsrc, srccol0, WT, dstrow0, 64 * kb, scr, F.lane, gk, bk, (float*)(F.ws + WS_CG) + cgo, (float*)(F.ws + WS_CB) + cgo);
}
__device__ __forceinline__ void p0_prologue(Frame& F, const float* x, const float* meta, const float* ln_g, const float* ln_b, const float* w_in, const float* w_out, const float* cw_in, const float* cw_out, const float* wq, const float* wo, const float* wkv) {
    LAS float* scr = (LAS float*)(F.lds + RING_OFF + F.wave * 16384);
    for (int it = F.gw; it < IT_TOTAL; it += F.ngw) prologue_item(F, ln_g, ln_b, w_in, w_out, cw_in, cw_out, wq, wo, wkv, it, scr);
    bf16_t* HBp = (bf16_t*)(F.ws + WS_HB);
    for (int row = F.gw; row < MROWS; row += F.ngw) {
        const float* src = (row < MREAL) ? x + (size_t)row * D : meta + (size_t)(row - MREAL) * D;
#pragma unroll
        for (int j = 0; j < 8; ++j) { const f32x4 v = *(const f32x4*)(src + 4 * F.lane + 256 * j); *(u32x2*)(HBp + (size_t)row * D + 4 * F.lane + 256 * j) = pk4(v); }
    }
    { float* st0 = (float*)(F.ws + WS_STATS); float* ones = (float*)(F.ws + WS_ONES);
      for (int i = F.gw * 64 + F.lane; i < MROWS; i += F.ngw * 64) { st0[2 * i] = 0.f; st0[2 * i + 1] = (float)D * (1.0f - LN_EPS); }
      for (int i = F.gw * 64 + F.lane; i < D; i += F.ngw * 64) ones[i] = 1.0f; }
    bf16_t* KB = (bf16_t*)(F.ws + WS_KB); bf16_t* VT = (bf16_t*)(F.ws + WS_VT);
    for (int bh = F.gw; bh < NB * NH; bh += F.ngw) {
        for (int i = F.lane; i < 16 * HD / 8; i += 64) *(u32x4*)(KB + (size_t)bh * TS * HD + 8 * i) = (u32x4){0u, 0u, 0u, 0u};
        for (int i = F.lane; i < HD * 2; i += 64) *(u32x4*)(VT + ((size_t)bh * HD + (i >> 1)) * TS + 8 * (i & 1)) = (u32x4){0u, 0u, 0u, 0u};
    }
}

__device__ __forceinline__ void final_ln_phase(Frame& F, const float* stats, const float* gain, const float* bias, float* out) {
    const float* X = (const float*)(F.ws + WS_X32);
    f32x4 g[8], bb[8];
#pragma unroll
    for (int j = 0; j < 8; ++j) { g[j] = *(const f32x4*)(gain + 4 * F.lane + 256 * j); bb[j] = *(const f32x4*)(bias + 4 * F.lane + 256 * j); }
    for (int row = F.gw; row < MREAL; row += F.ngw) {
        float rstd, t; row_norm(stats, row, rstd, t);
        const float* xr = X + (size_t)row * D + 4 * F.lane; float* o = out + (size_t)row * D + 4 * F.lane;
#pragma unroll
        for (int j = 0; j < 8; ++j) { const f32x4 v = *(const f32x4*)(xr + 256 * j); *(f32x4*)(o + 256 * j) = (v * rstd + t) * g[j] + bb[j]; }
    }
}

__device__ __forceinline__ void unpack8(u32x4 w, float (&f)[8]) { f[0] = bf_lo(w.x); f[1] = bf_hi(w.x); f[2] = bf_lo(w.y); f[3] = bf_hi(w.y); f[4] = bf_lo(w.z); f[5] = bf_hi(w.z); f[6] = bf_lo(w.w); f[7] = bf_hi(w.w); }
__device__ __forceinline__ void conv_phase(Frame& F, const float* cw, const float* cb) {
    const bf16_t* V = (const bf16_t*)(F.ws + WS_ACT); const bf16_t* BG = (const bf16_t*)(F.ws + WS_ACT + ACT_SUB); bf16_t* GG = (bf16_t*)(F.ws + WS_ACT + 2 * ACT_SUB);
    for (int row = F.gw; row < MROWS; row += F.ngw) {
        const bf16_t* cur = V + (size_t)row * D; const bf16_t* p1 = cur; const bf16_t* p2 = cur; float m1 = 1.f, m2 = 1.f;
        if (row < MREAL) { const int t = row & (SEQ - 1);
            if (t >= 2) { p1 = cur - D; p2 = cur - 2 * D; }
            else if (t == 1) { p1 = cur - D; p2 = V + (size_t)(MREAL + 15) * D; }
            else { p1 = V + (size_t)(MREAL + 15) * D; p2 = V + (size_t)(MREAL + 14) * D; }
        } else { const int i = row - MREAL; if (i >= 1) p1 = cur - D; else m1 = 0.f; if (i >= 2) p2 = cur - 2 * D; else m2 = 0.f; }
#pragma unroll
        for (int j = 0; j < 4; ++j) { const int c0 = 8 * (F.lane + 64 * j);
            float a[8], b1[8], b2[8], bg[8];
            unpack8(*(const u32x4*)(cur + c0), a); unpack8(*(const u32x4*)(p1 + c0), b1); unpack8(*(const u32x4*)(p2 + c0), b2); unpack8(*(const u32x4*)(BG + (size_t)row * D + c0), bg);
            float o[8];
#pragma unroll
            for (int h = 0; h < 2; ++h) { const f32x4 w0 = *(const f32x4*)(cw + c0 + 4 * h), w1 = *(const f32x4*)(cw + D + c0 + 4 * h), w2 = *(const f32x4*)(cw + 2 * D + c0 + 4 * h), bbv = *(const f32x4*)(cb + c0 + 4 * h);
#pragma unroll
                for (int e = 0; e < 4; ++e) o[4 * h + e] = bg[4 * h + e] * (w0[e] * (b2[4 * h + e] * m2) + w1[e] * (b1[4 * h + e] * m1) + w2[e] * a[4 * h + e] + bbv[e]); }
            *(u32x4*)(GG + (size_t)row * D + c0) = (u32x4){pk2(o[0], o[1]), pk2(o[2], o[3]), pk2(o[4], o[5]), pk2(o[6], o[7])};
        }
    }
}

#ifndef ATTN_EARLY_EXIT
#define ATTN_EARLY_EXIT 1
#endif
__device__ __forceinline__ void attn_unit(Frame& F, const bf16_t* Qb, bf16_t* Ob, const bf16_t* KB, const bf16_t* VT, int b, int h, int qi) {
    const int lane = F.lane, ql = lane & 31, hh = lane >> 5;
    const bool qvalid = (qi > 0) || (ql >= 16);
    const int qrow = (qi > 0) ? (b * SEQ + 32 * (qi - 1) + ql) : (MREAL + (qvalid ? ql - 16 : 0));
    const bf16_t* qp = Qb + (size_t)qrow * D + h * HD + 8 * hh;
    bf16x8 qf[8];
#pragma unroll
    for (int s = 0; s < 8; ++s) qf[s] = *(const bf16x8*)(qp + 16 * s);
    const bf16_t* kbase = KB + (size_t)(b * NH + h) * TS * HD + (size_t)ql * HD + 8 * hh;
    const bf16_t* vbase = VT + ((size_t)(b * NH + h) * HD + ql) * TS + 4 * hh;
    f32x16 oacc[4];
#pragma unroll
    for (int i = 0; i < 4; ++i)
#pragma unroll
        for (int r = 0; r < 16; ++r) oacc[i][r] = 0.f;
    float C = qvalid ? 0.f : -1e30f;
    const int qs = 32 * qi + ql;
    for (int kt = qi; kt >= 0; --kt) {
        const bf16_t* kp = kbase + (size_t)(32 * kt) * HD;
        bf16x8 kf[8];
#pragma unroll
        for (int s = 0; s < 8; ++s) kf[s] = *(const bf16x8*)(kp + 16 * s);
        f32x16 z;
#pragma unroll
        for (int r = 0; r < 16; ++r) z[r] = 0.f;
#pragma unroll
        for (int s = 0; s < 8; ++s) z = __builtin_amdgcn_mfma_f32_32x32x16_bf16(kf[s], qf[s], z, 0, 0, 0);
        float lk[16], lb[16]; bool vld[16];
#pragma unroll
        for (int r = 0; r < 16; ++r) { const int ks = 32 * kt + (r & 3) + 8 * (r >> 2) + 4 * hh; vld[r] = (ks < qs) && (ks >= 16);
            const float zz = z[r], e = __expf(-fabsf(zz)), sp = fmaxf(zz, 0.f) + __logf(1.f + e); lb[r] = zz - sp; lk[r] = vld[r] ? -sp : 0.f; }
        float G[4], PG[4];
#pragma unroll
        for (int g = 0; g < 4; ++g) { G[g] = (lk[4 * g] + lk[4 * g + 1]) + (lk[4 * g + 2] + lk[4 * g + 3]); PG[g] = __shfl_xor(G[g], 32); }
        float suf[4]; suf[3] = 0.f; suf[2] = G[3] + PG[3]; suf[1] = suf[2] + (G[2] + PG[2]); suf[0] = suf[1] + (G[1] + PG[1]);
        const float TT = suf[0] + (G[0] + PG[0]);
        float a[16];
#pragma unroll
        for (int g = 0; g < 4; ++g) { const float base = C + suf[g] + (hh == 0 ? PG[g] : 0.f);
            const float s3 = 0.f, s2 = lk[4 * g + 3], s1 = s2 + lk[4 * g + 2], s0 = s1 + lk[4 * g + 1];
            a[4 * g + 0] = vld[4 * g + 0] ? __expf(lb[4 * g + 0] + base + s0) : 0.f; a[4 * g + 1] = vld[4 * g + 1] ? __expf(lb[4 * g + 1] + base + s1) : 0.f;
            a[4 * g + 2] = vld[4 * g + 2] ? __expf(lb[4 * g + 2] + base + s2) : 0.f; a[4 * g + 3] = vld[4 * g + 3] ? __expf(lb[4 * g + 3] + base + s3) : 0.f; }
        C += TT;
        bf16x8 pf[2];
#pragma unroll
        for (int s2 = 0; s2 < 2; ++s2) { const u32x4 w = {pk2(a[8 * s2], a[8 * s2 + 1]), pk2(a[8 * s2 + 2], a[8 * s2 + 3]), pk2(a[8 * s2 + 4], a[8 * s2 + 5]), pk2(a[8 * s2 + 6], a[8 * s2 + 7])}; pf[s2] = __builtin_bit_cast(bf16x8, w); }
        const bf16_t* vp = vbase + 32 * kt;
#pragma unroll
        for (int blk = 0; blk < 4; ++blk)
#pragma unroll
            for (int s2 = 0; s2 < 2; ++s2) { const bf16_t* p = vp + (size_t)(32 * blk) * TS + 16 * s2;
                const u32x2 lo = *(const u32x2*)p, hi = *(const u32x2*)(p + 8); const u32x4 w = {lo.x, lo.y, hi.x, hi.y};
                oacc[blk] = __builtin_amdgcn_mfma_f32_32x32x16_bf16(__builtin_bit_cast(bf16x8, w), pf[s2], oacc[blk], 0, 0, 0); }
#if ATTN_EARLY_EXIT
        if (__all(C < -104.0f)) break;
#endif
    }
    if (qvalid) { bf16_t* op = Ob + (size_t)qrow * D + h * HD + 4 * hh;
#pragma unroll
        for (int blk = 0; blk < 4; ++blk)
#pragma unroll
            for (int g = 0; g < 4; ++g) *(u32x2*)(op + 32 * blk + 8 * g) = pk4((f32x4){oacc[blk][4 * g], oacc[blk][4 * g + 1], oacc[blk][4 * g + 2], oacc[blk][4 * g + 3]}); }
}
__device__ __forceinline__ void attn_phase(Frame& F) {
    const bf16_t* Qb = (const bf16_t*)(F.ws + WS_ACT); bf16_t* Ob = (bf16_t*)(F.ws + WS_ACT + ACT_SUB);
    const bf16_t* KB = (const bf16_t*)(F.ws + WS_KB); const bf16_t* VT = (const bf16_t*)(F.ws + WS_VT);
    int k = 0;
    for (int u = F.gw; u < NB * NH * 64 + NH; u += F.ngw, ++k) {
        if (u < NB * NH * 64) { const int bh = u >> 6, q0 = u & 63, qi = (k & 1) ? (64 - q0) : (1 + q0); attn_unit(F, Qb, Ob, KB, VT, bh >> 4, bh & 15, qi); }
        else attn_unit(F, Qb, Ob, KB, VT, 0, u - NB * NH * 64, 0);
    }
}

struct Args { const float* in[13]; float* out; unsigned char* ws; };
__global__ void __launch_bounds__(NWAVES * 64, 2) yoco_fwd(Args args) {
    extern __shared__ __attribute__((aligned(16))) unsigned char lds[];
    Frame F;
    F.lds = (LAS unsigned char*)lds;
    F.tid = threadIdx.x; F.lane = F.tid & 63; F.wave = __builtin_amdgcn_readfirstlane(F.tid >> 6);
    F.G = gridDim.x; { const int bx = blockIdx.x; F.vcu = (F.G % 8 == 0) ? (bx % 8) * (F.G / 8) + bx / 8 : bx; }
    F.gw = F.vcu * NWAVES + F.wave; F.ngw = F.G * NWAVES;
    F.ws = args.ws;
    for (int u = F.tid; u < (LDS_BYTES - LDSCTL_OFF) / 4; u += NWAVES * 64) ((LAS unsigned*)(F.lds + LDSCTL_OFF))[u] = 0u;
    __syncthreads();
    unsigned* ctl = (unsigned*)(F.ws + WS_CTL);
    XcdBarrier bar = xcd_barrier_post(ctl + CW_BAR, (volatile LAS unsigned*)(F.lds + MISC_OFF) + 8);
#define GRID_BAR() do { xcd_barrier(bar); PHASE_BEGIN(); } while (0)
#define PHASE_BEGIN() do { int t_ = threadIdx.x; asm volatile("" : "+v"(t_)); F.tid = t_; F.lane = t_ & 63; F.wave = __builtin_amdgcn_readfirstlane(t_ >> 6); F.gw = F.vcu * NWAVES + F.wave; \
        unsigned long long w_ = (unsigned long long)args.ws; asm volatile("" : "+s"(w_)); F.ws = (unsigned char*)(GAS unsigned char*)w_; } while (0)
#define HB ((bf16_t*)(F.ws + WS_HB))
#define X32 ((float*)(F.ws + WS_X32))
#define ACT ((bf16_t*)(F.ws + WS_ACT))

#define STATS(q) ((float*)(F.ws + WS_STATS + (size_t)(q) * STATS_BYTES))
#define CGV(o) ((const float*)(F.ws + WS_CG) + (o))
#define CBV(o) ((const float*)(F.ws + WS_CB) + (o))
    PHASE_BEGIN();
    p0_prologue(F, args.in[0], args.in[1], args.in[2], args.in[3], args.in[4], args.in[5], args.in[6], args.in[9], args.in[10], args.in[12], args.in[11]);
    GRID_BAR();

    for (int l = 0; l < DEPTH; ++l) {
        for (int s = 0; s < 2; ++s) {
            const int qin = (s == 1) ? (1 + 3 * l + 1) : (l == 0 ? 0 : 1 + 3 * (l - 1) + 2), qout = 1 + 3 * l + (s == 0 ? 0 : 2);
            { const bf16_t* W1 = (const bf16_t*)(F.ws + WS_W1T + (size_t)(2 * l + s) * W1T_BYTES);
              pg8::Gemm g{HB, W1, MREAL, FF2, D}; pg8::StaticOrder S; S.init(MREAL, FF2, F.G, (int)blockIdx.x);
              EpiSwiglu E{ACT, LnFold{STATS(qin), CGV(CGO_W1 + (2 * l + s) * FF2), CBV(CGO_W1 + (2 * l + s) * FF2)}};
              pg8::gemm_phase<EpiSwiglu, pg8::StaticOrder, true, true>(F.lds + RING_OFF, g, S, E);
              meta_gemm<true>(HB + (size_t)MREAL * D, D, W1, D, FF, (int)blockIdx.x, F.G, F.wave, F.lane, F.lds + RING_OFF, E); }
            GRID_BAR();
            { const bf16_t* W2 = (const bf16_t*)(F.ws + WS_W2T + (size_t)(2 * l + s) * W2T_BYTES);
              pg8::Gemm g{ACT, W2, MREAL, D, FF}; pg8::StaticOrder S; S.init(MREAL, D, F.G, (int)blockIdx.x);
              const bool first = (qin == 0);
              const float* gp = first ? (const float*)(F.ws + WS_ONES) : args.in[2] + (size_t)(qin - 1) * D; const float* bp = first ? (const float*)(F.ws + WS_ZEROS) : args.in[3] + (size_t)(qin - 1) * D;
              EpiResidLN E{first ? args.in[0] : X32, first ? args.in[1] : X32 + (size_t)MREAL * D, X32, HB, STATS(qin), gp, bp, STATS(qout), 0.5f};
              pg8::gemm_phase<EpiResidLN, pg8::StaticOrder, true, true>(F.lds + RING_OFF, g, S, E);
              meta_gemm<false>(ACT + (size_t)MREAL * FF, FF, W2, FF, D, (int)blockIdx.x, F.G, F.wave, F.lane, F.lds + RING_OFF, E); }
            GRID_BAR();
            if (s == 0) {
                const int q0 = 1 + 3 * l, q1 = q0 + 1;
                const float* gp = args.in[2] + (size_t)(q0 - 1) * D; const float* bp = args.in[3] + (size_t)(q0 - 1) * D;
                if (l < NCONV) {
                    { const bf16_t* Wc = (const bf16_t*)(F.ws + WS_WCIN + (size_t)l * WCIN_BYTES);
                      pg8::Gemm g{HB, Wc, MREAL, 3 * D, D}; pg8::StaticOrder S; S.init(MREAL, 3 * D, F.G, (int)blockIdx.x);
                      const LnFold L{STATS(q0), CGV(CGO_CIN + l * 3 * D), CBV(CGO_CIN + l * 3 * D)};
                      EpiConvIn E{ACT, (bf16_t*)(F.ws + WS_ACT + ACT_SUB), L};
                      pg8::gemm_phase<EpiConvIn, pg8::StaticOrder, true, true>(F.lds + RING_OFF, g, S, E);
                      MetaConvV EV{ACT, L}; meta_gemm<true>(HB + (size_t)MREAL * D, D, Wc, D, D, (int)blockIdx.x, F.G, F.wave, F.lane, F.lds + RING_OFF, EV);
                      EpiBf16S EB{(bf16_t*)(F.ws + WS_ACT + ACT_SUB), 1.0f, LnFold{STATS(q0), CGV(CGO_CIN + l * 3 * D + 2 * D), CBV(CGO_CIN + l * 3 * D + 2 * D)}};
                      meta_gemm<false>(HB + (size_t)MREAL * D, D, Wc + (size_t)(2 * D) * D, D, D, (int)blockIdx.x, F.G, F.wave, F.lane, F.lds + RING_OFF, EB); }
                    GRID_BAR();
                    conv_phase(F, args.in[7] + (size_t)l * 3 * D, args.in[8] + (size_t)l * D);
                    GRID_BAR();
                    { const bf16_t* Wo = (const bf16_t*)(F.ws + WS_WCOUT + (size_t)l * SQ_BYTES); const bf16_t* GG = (const bf16_t*)(F.ws + WS_ACT + 2 * ACT_SUB);
                      pg8::Gemm g{GG, Wo, MREAL, D, D}; pg8::StaticOrder S; S.init(MREAL, D, F.G, (int)blockIdx.x);
                      EpiResidLN E{X32, X32 + (size_t)MREAL * D, X32, HB, STATS(q0), gp, bp, STATS(q1), 1.0f};
                      pg8::gemm_phase<EpiResidLN, pg8::StaticOrder, true, true>(F.lds + RING_OFF, g, S, E);
                      meta_gemm<false>(GG + (size_t)MREAL * D, D, Wo, D, D, (int)blockIdx.x, F.G, F.wave, F.lane, F.lds + RING_OFF, E); }
                } else {
                    const int j = l - NCONV;
                    { const bf16_t* Wq = (const bf16_t*)(F.ws + WS_WQ + (size_t)j * SQ_BYTES);
                      pg8::Gemm g{HB, Wq, MREAL, D, D}; pg8::StaticOrder S; S.init(MREAL, D, F.G, (int)blockIdx.x);
                      EpiBf16S E{ACT, QSCALE, LnFold{STATS(q0), CGV(CGO_WQ + j * D), CBV(CGO_WQ + j * D)}};
                      pg8::gemm_phase<EpiBf16S, pg8::StaticOrder, true, true>(F.lds + RING_OFF, g, S, E);
                      meta_gemm<false>(HB + (size_t)MREAL * D, D, Wq, D, D, (int)blockIdx.x, F.G, F.wave, F.lane, F.lds + RING_OFF, E); }
                    GRID_BAR();
                    attn_phase(F);
                    GRID_BAR();
                    { const bf16_t* Wo = (const bf16_t*)(F.ws + WS_WO + (size_t)j * SQ_BYTES); const bf16_t* Ob = (const bf16_t*)(F.ws + WS_ACT + ACT_SUB);
                      pg8::Gemm g{Ob, Wo, MREAL, D, D}; pg8::StaticOrder S; S.init(MREAL, D, F.G, (int)blockIdx.x);
                      EpiResidLN E{X32, X32 + (size_t)MREAL * D, X32, HB, STATS(q0), gp, bp, STATS(q1), 1.0f};
                      pg8::gemm_phase<EpiResidLN, pg8::StaticOrder, true, true>(F.lds + RING_OFF, g, S, E);
                      meta_gemm<false>(Ob + (size_t)MREAL * D, D, Wo, D, D, (int)blockIdx.x, F.G, F.wave, F.lane, F.lds + RING_OFF, E); }
                }
                GRID_BAR();
            }
        }
        if (l == NCONV - 1) {
            const bf16_t* Wkv = (const bf16_t*)(F.ws + WS_WKV); const int q = 1 + 3 * l + 2;
            pg8::Gemm g{HB, Wkv, MREAL, 2 * D, D}; pg8::StaticOrder S; S.init(MREAL, 2 * D, F.G, (int)blockIdx.x);
            EpiKV E{(bf16_t*)(F.ws + WS_KB), (bf16_t*)(F.ws + WS_VT), LnFold{STATS(q), CGV(CGO_KV), CBV(CGO_KV)}};
            pg8::gemm_phase<EpiKV, pg8::StaticOrder, true, true>(F.lds + RING_OFF, g, S, E);
            meta_gemm<false>(HB + (size_t)MREAL * D, D, Wkv, D, 2 * D, (int)blockIdx.x, F.G, F.wave, F.lane, F.lds + RING_OFF, E);
            GRID_BAR();
        }
    }
    final_ln_phase(F, STATS(1 + 3 * (DEPTH - 1) + 2), args.in[2] + (size_t)(3 * (DEPTH - 1) + 2) * D, args.in[3] + (size_t)(3 * (DEPTH - 1) + 2) * D, args.out);
}

extern "C" void kernel_launch(void* const* d_in, const int* in_sizes, int n_in, void* d_out, int out_size, void* d_ws, size_t ws_size, hipStream_t stream) {
    static int grid = 0;
    if (grid == 0) {
        if (n_in != 13 || in_sizes[0] != MREAL * D || out_size != MREAL * D || ws_size < WS_END) { fprintf(stderr, "kernel_launch: unexpected shapes (n_in %d, in0 %d, out %d, ws %zu)\n", n_in, n_in > 0 ? in_sizes[0] : -1, out_size, ws_size); grid = -1; return; }
        int dev = 0, cus = 0;
        if (hipGetDevice(&dev) != hipSuccess || hipDeviceGetAttribute(&cus, hipDeviceAttributeMultiprocessorCount, dev) != hipSuccess) { grid = -1; return; }
        if (hipFuncSetAttribute((const void*)yoco_fwd, hipFuncAttributeMaxDynamicSharedMemorySize, LDS_BYTES) != hipSuccess) { fprintf(stderr, "kernel_launch: hipFuncSetAttribute failed\n"); grid = -1; return; }
        int per_cu = 0;
        if (hipOccupancyMaxActiveBlocksPerMultiprocessor(&per_cu, (const void*)yoco_fwd, NWAVES * 64, LDS_BYTES) != hipSuccess || per_cu < 1) fprintf(stderr, "kernel_launch: occupancy query says %d\n", per_cu);
        (void)hipGetLastError();
        grid = cus;
    }
    if (grid < 0) return;
    if (hipMemsetAsync((char*)d_ws + WS_CTL, 0, CTL_ZERO_BYTES, stream) != hipSuccess) return;
    Args a{};
    for (int i = 0; i < 13; ++i) a.in[i] = (const float*)d_in[i];
    a.out = (float*)d_out; a.ws = (unsigned char*)d_ws;
    hipLaunchKernelGGL(yoco_fwd, dim3(grid), dim3(NWAVES * 64), LDS_BYTES, stream, a);
}
```

```cpp
#include <hip/hip_runtime.h>
#include <cstdio>
#include <cstdint>
#ifndef PROBE
#define PROBE 0
#endif
#define PROBE_A 0
#define PROBE_B 1
#ifndef XCD_COL_ROT
#define XCD_COL_ROT 1
#endif
#ifndef K_SERPENTINE
#define K_SERPENTINE 1
#endif
#ifndef EXP_UP_TWICE
#define EXP_UP_TWICE 0
#endif
#ifndef PRIO_MODE
#define PRIO_MODE 1
#endif
#ifndef GEMM_SP
#define GEMM_SP 1
#endif
#ifndef EXP_KIND
#define EXP_KIND 0
#endif
#ifndef EXP_EPI_TWICE
#define EXP_EPI_TWICE 0
#endif

constexpr int D = 2048, NB = 8, SEQ = 2048, NMETA = 16, NH = 16, HD = 128, FF = 5632, FF2 = 11264, DEPTH = 4, NCONV = 2;
constexpr int MREAL = NB * SEQ;
constexpr int MROWS = MREAL + NMETA;
constexpr int MCAP = 16640;
constexpr int TS = 2080;
constexpr float ALPHA = 1.6817928305074290f, LN_EPS = 1e-5f, QSCALE = 0.08838834764831845f * 1.4426950408889634f;

constexpr size_t MiB = 1u << 20;
constexpr size_t WS_CTL = 0, CTL_ZERO_BYTES = 5 * MiB;
constexpr size_t WS_STATS = 1 * MiB, STATS_BYTES = 160 * 1024;
constexpr size_t WS_CG = 3 * MiB + 256 * 1024;
constexpr int NCGCB = 8 * 11264 + 2 * 6144 + 2 * 2048 + 4096;
constexpr size_t WS_CB = WS_CG + (size_t)NCGCB * 4;
static_assert(WS_CB + (size_t)NCGCB * 4 <= CTL_ZERO_BYTES && WS_STATS + 13 * STATS_BYTES <= WS_CG, "zeroed region map");
constexpr size_t WS_LNG = 5 * MiB, WS_LNB = 5 * MiB + 512 * 1024;
constexpr size_t WS_W1T = 6 * MiB, W1T_BYTES = 44 * MiB;
constexpr size_t WS_W2T = WS_W1T + 8 * W1T_BYTES, W2T_BYTES = 22 * MiB;
constexpr size_t WS_WCIN = WS_W2T + 8 * W2T_BYTES, WCIN_BYTES = 24 * MiB;
constexpr size_t SQ_BYTES = 8 * MiB;
constexpr size_t WS_WCOUT = WS_WCIN + 2 * WCIN_BYTES;
constexpr size_t WS_WQ = WS_WCOUT + 2 * SQ_BYTES;
constexpr size_t WS_WO = WS_WQ + 2 * SQ_BYTES;
constexpr size_t WS_WKV = WS_WO + 2 * SQ_BYTES;
constexpr size_t WS_HB = WS_WKV + 16 * MiB;
constexpr size_t WS_X32 = WS_HB + 65 * MiB;
constexpr size_t WS_ACT = WS_X32 + 130 * MiB;
constexpr size_t ACT_SUB = 65 * MiB;
constexpr size_t WS_KB = WS_ACT + 195 * MiB;
constexpr size_t WS_VT = WS_KB + 65 * MiB;
constexpr size_t WS_END = WS_VT + 65 * MiB;
constexpr int CW_BAR = 4096;

constexpr int RING_OFF = 0, RING_BYTES = 131072;
constexpr int LDSCTL_OFF = RING_BYTES, MISC_OFF = LDSCTL_OFF + 320;
constexpr int LDS_BYTES = 147456;
constexpr int NWAVES = 8;

#define GAS __attribute__((address_space(1)))
#define LAS __attribute__((address_space(3)))
typedef unsigned short bf16_t;
typedef short bf16x8 __attribute__((ext_vector_type(8)));
typedef short s16x4 __attribute__((ext_vector_type(4)));
typedef float f32x4 __attribute__((ext_vector_type(4)));
typedef float f32x16 __attribute__((ext_vector_type(16)));
typedef unsigned u32x4 __attribute__((ext_vector_type(4)));
typedef unsigned u32x2 __attribute__((ext_vector_type(2)));
typedef _Float16 h2_t __attribute__((ext_vector_type(2)));
typedef _Float16 h8_t __attribute__((ext_vector_type(8)));
typedef float f2_t __attribute__((ext_vector_type(2)));
__device__ __forceinline__ unsigned pk2(float lo, float hi) { f2_t v = {lo, hi}; h2_t r = __builtin_convertvector(v, h2_t); return __builtin_bit_cast(unsigned, r); }
__device__ __forceinline__ int lane_id() { int r; asm volatile("v_mbcnt_lo_u32_b32 %0, -1, 0\n\tv_mbcnt_hi_u32_b32 %0, -1, %0" : "=v"(r)); return r; }
__device__ __forceinline__ float bf_lo(unsigned w) { return (float)__builtin_bit_cast(h2_t, w)[0]; }
__device__ __forceinline__ float bf_hi(unsigned w) { return (float)__builtin_bit_cast(h2_t, w)[1]; }

namespace pg8 {
#define PG8_LAS __attribute__((address_space(3)))
constexpr int BM = 256, BK = 64, HALF = 128, HTB = HALF * BK * 2, STAGE_BYTES = 8 * HTB, NXCD = 8, WGM = 8;
__host__ __device__ __forceinline__ int lds_byte(int r, int c) { const int st = (r >> 4) * 2 + (c >> 5), rr = r & 15, cc = c & 31, ob = rr * 64 + cc * 2; return st * 1024 + (ob ^ (((ob >> 9) & 1) << 5)); }
__host__ __device__ __forceinline__ void stage_rc(int b, int& R, int& C) { const int st = b / 1024, sb = b % 1024, swz = sb ^ (((sb >> 9) & 1) << 5); R = (st >> 1) * 16 + swz / 64; C = (st & 1) * 32 + (swz % 64) / 2; }
__host__ __device__ __forceinline__ int perm32(int rho) { const int n = rho >> 4, i = rho & 15; return 8 * (i >> 2) + 4 * n + (i & 3); }
struct Unit { int pm, pn; };
struct Gemm { const bf16_t* A; const bf16_t* Bt; int M, N, K; };
struct StaticOrder {
    int nM, nN, nwg, G, c;
    __host__ __device__ void init(int M, int N, int G_, int c_) { nM = M / BM; nN = N / BM; nwg = nM * nN; G = G_; c = c_; }
    __host__ __device__ bool next(int i, Unit& u) const {
        const long L = (long)i * G + c; if (L >= nwg) return false;
        int wgid = (int)L; { const int q = nwg / NXCD, r = nwg % NXCD, xcd = wgid % NXCD, off = wgid / NXCD; wgid = (xcd < r ? xcd * (q + 1) : r * (q + 1) + (xcd - r) * q) + off; }
        const int nig = WGM * nN, gid = wgid / nig, fm = gid * WGM, gsz = (nM - fm) < WGM ? (nM - fm) : WGM;
        u.pm = fm + ((wgid % nig) % gsz); u.pn = (wgid % nig) / gsz;
#if XCD_COL_ROT
        { const int x = (int)(L % NXCD), ng = nN / 4, g = u.pn >> 2, k = (ng % 3 == 0) ? 1 : 3; u.pn = 4 * ((g * k + x) % ng) + (u.pn & 3); }
#endif
        return true;
    }
    __device__ __forceinline__ void a_ready(const Unit&) const {}
    __device__ __forceinline__ void done(const Unit&) const {}
};

template <class Epi, class Sched, bool ALIGN_EPI = false, int SP2 = 0, bool PROF = false, bool REP_EPI = false, int ABL = 0>
__device__ __forceinline__ void gemm_phase(PG8_LAS unsigned char* lds, const Gemm g, const Sched& S, const Epi& E, unsigned long long* prof = nullptr) {
    int tid_ = threadIdx.x; asm volatile("" : "+v"(tid_));
    const int tid = tid_, wid = __builtin_amdgcn_readfirstlane(tid >> 6), lane = tid & 63, wr = wid >> 2, wc = wid & 3, fr = lane & 15, fq = lane >> 4;
    const int K = g.K, nt = K / BK;
    unsigned voffA[2], voffB[2];
#pragma unroll
    for (int i = 0; i < 2; ++i) { int R, C; stage_rc(tid * 16 + i * 8192, R, C); const int Rb = Epi::PERM ? ((R & ~31) + perm32(R & 31)) : R;
        voffA[i] = (unsigned)(R * K + C) * 2u; voffB[i] = (unsigned)(Rb * K + C) * 2u; }
    const unsigned kstep = (unsigned)(BK * 2);
    const unsigned hstep = (unsigned)HALF * (unsigned)K * 2u;
    const unsigned tstep = 2u * hstep;
    const __amdgpu_buffer_rsrc_t rsA = __builtin_amdgcn_make_buffer_rsrc((void*)g.A, (short)0, 0x7ffffff0, 0x00020000);
    const __amdgpu_buffer_rsrc_t rsB = __builtin_amdgcn_make_buffer_rsrc((void*)g.Bt, (short)0, 0x7ffffff0, 0x00020000);
    const unsigned ldsw = (unsigned)wid * 1024u;
    const int aoff = lds_byte(wr * 64 + fr, fq * 8), boff = lds_byte(wc * 32 + fr, fq * 8);
#define PG8_SA(b, h) (((b) * 2 + (h)) * HTB)
#define PG8_SB(b, h) ((4 + (b) * 2 + (h)) * HTB)
#define PG8_STAGE(bufoff, rs, soff, voff) do { if constexpr (ABL != 2) _Pragma("unroll") for (int _i = 0; _i < 2; ++_i) \
        __builtin_amdgcn_raw_ptr_buffer_load_lds(rs, (PG8_LAS unsigned*)(lds + (bufoff) + ldsw + _i * 8192), 16, (voff)[_i], (soff), 0, 0); } while (0)
#define PG8_LDA(dst, b, h) do { if constexpr (ABL != 3) _Pragma("unroll") for (int m = 0; m < 4; ++m) _Pragma("unroll") for (int k = 0; k < 2; ++k) dst[m][k] = *(const PG8_LAS bf16x8*)(lds + PG8_SA(b, h) + aoff + m * 2048 + k * 1024); } while (0)
#define PG8_LDB(dst, b, h) do { if constexpr (ABL != 3) _Pragma("unroll") for (int n = 0; n < 2; ++n) _Pragma("unroll") for (int k = 0; k < 2; ++k) dst[n][k] = *(const PG8_LAS bf16x8*)(lds + PG8_SB(b, h) + boff + n * 2048 + k * 1024); } while (0)
#define PG8_MMA(ai, bj, At, Bt) do { if (PRIO_MODE == 1) __builtin_amdgcn_s_setprio(1); else if (PRIO_MODE == 2) __builtin_amdgcn_s_setprio(0); \
        if constexpr (ABL == 4) { _Pragma("unroll") for (int m = 0; m < 4; ++m) _Pragma("unroll") for (int k = 0; k < 2; ++k) \
            acc32[ai][bj][m & 1] = __builtin_amdgcn_mfma_f32_32x32x16_f16(__builtin_bit_cast(h8_t, Bt[m & 1][k]), __builtin_bit_cast(h8_t, At[m][k]), acc32[ai][bj][m & 1], 0, 0, 0); } else \
        if constexpr (ABL != 1) _Pragma("unroll") for (int m = 0; m < 4; ++m) _Pragma("unroll") for (int n = 0; n < 2; ++n) _Pragma("unroll") for (int k = 0; k < 2; ++k) \
        acc[ai][bj][m][n] = __builtin_amdgcn_mfma_f32_16x16x32_f16(__builtin_bit_cast(h8_t, Bt[n][k]), __builtin_bit_cast(h8_t, At[m][k]), acc[ai][bj][m][n], 0, 0, 0); if (PRIO_MODE == 1) __builtin_amdgcn_s_setprio(0); else if (PRIO_MODE == 2) __builtin_amdgcn_s_setprio(1); } while (0)
#define PG8_WAIT_V(n) asm volatile("s_waitcnt vmcnt(" #n ")" ::: "memory")
#define PG8_WAIT_L(n) asm volatile("s_waitcnt lgkmcnt(" #n ")" ::: "memory")
#define PG8_BAR __builtin_amdgcn_s_barrier()
#define PG8_SCHED __builtin_amdgcn_sched_barrier(0)
    Unit cur, nxt; int ui = 0;
    if (!S.next(0, cur)) return;
    if (PROF && blockIdx.x == 0 && tid == 0) prof[6] = __builtin_amdgcn_s_memrealtime();
    f32x4 acc[2][2][4][2];
#pragma unroll
    for (int a = 0; a < 2; ++a)
#pragma unroll
        for (int b = 0; b < 2; ++b)
#pragma unroll
            for (int m = 0; m < 4; ++m)
#pragma unroll
                for (int n = 0; n < 2; ++n) acc[a][b][m][n] = (f32x4){0.f, 0.f, 0.f, 0.f};
    bf16x8 At[4][2], B0[2][2], B1[2][2];
    f32x16 acc32[2][2][2];
    if constexpr (ABL == 4) { _Pragma("unroll") for (int a = 0; a < 2; ++a) _Pragma("unroll") for (int b = 0; b < 2; ++b) _Pragma("unroll") for (int c = 0; c < 2; ++c) _Pragma("unroll") for (int r = 0; r < 16; ++r) acc32[a][b][c][r] = 0.f; }
    if constexpr (ABL == 3) { _Pragma("unroll") for (int m = 0; m < 4; ++m) _Pragma("unroll") for (int k = 0; k < 2; ++k) At[m][k] = (bf16x8){0, 0, 0, 0, 0, 0, 0, 0}; _Pragma("unroll") for (int n = 0; n < 2; ++n) _Pragma("unroll") for (int k = 0; k < 2; ++k) { B0[n][k] = (bf16x8){0, 0, 0, 0, 0, 0, 0, 0}; B1[n][k] = B0[n][k]; } }
    unsigned cA = (unsigned)cur.pm * tstep, cB = (unsigned)cur.pn * tstep;
    unsigned kb = 0u, ki = kstep;
#if !K_SERPENTINE
#define PG8_FLIP(kb_, ki_) do { } while (0)
#else
#define PG8_FLIP(kb_, ki_) do { ki_ = 0u - ki_; kb_ = (kb_ == 0u) ? (unsigned)(nt - 1) * kstep : 0u; } while (0)
#endif
    if constexpr (Epi::LDSPRE) { if (E.lds_ok) E.pre_phase(lds, cur, tid, wid, lane); }
    S.a_ready(cur);
    if constexpr (SP2 == 2) {
        PG8_STAGE(PG8_SB(0, 0), rsB, cB, voffB); PG8_STAGE(PG8_SB(0, 1), rsB, cB + hstep, voffB); PG8_STAGE(PG8_SA(0, 0), rsA, cA, voffA); PG8_STAGE(PG8_SA(0, 1), rsA, cA + hstep, voffA);
        if (wr == 1) PG8_BAR;
        PG8_WAIT_V(2); PG8_BAR;
        PG8_STAGE(PG8_SB(1, 0), rsB, cB + kstep, voffB); PG8_STAGE(PG8_SB(1, 1), rsB, cB + hstep + kstep, voffB);
        PG8_WAIT_V(6); PG8_BAR;
    } else if constexpr (SP2 == 1) {
        PG8_STAGE(PG8_SB(0, 0), rsB, cB, voffB); PG8_STAGE(PG8_SB(0, 1), rsB, cB + hstep, voffB); PG8_STAGE(PG8_SA(0, 0), rsA, cA, voffA); PG8_STAGE(PG8_SA(0, 1), rsA, cA + hstep, voffA);
        if (wr == 1) PG8_BAR;
        PG8_WAIT_V(2); PG8_BAR;
        PG8_STAGE(PG8_SB(1, 0), rsB, cB + kstep, voffB); PG8_STAGE(PG8_SA(1, 0), rsA, cA + kstep, voffA); PG8_STAGE(PG8_SB(1, 1), rsB, cB + hstep + kstep, voffB);
        PG8_WAIT_V(6); PG8_BAR;
    } else {
        PG8_STAGE(PG8_SB(0, 0), rsB, cB, voffB); PG8_STAGE(PG8_SA(0, 0), rsA, cA, voffA); PG8_STAGE(PG8_SB(0, 1), rsB, cB + hstep, voffB); PG8_STAGE(PG8_SA(0, 1), rsA, cA + hstep, voffA);
        if (wr == 1) PG8_BAR;
        PG8_WAIT_V(4); PG8_BAR;
        PG8_STAGE(PG8_SB(1, 0), rsB, cB + kstep, voffB); PG8_STAGE(PG8_SA(1, 0), rsA, cA + kstep, voffA); PG8_STAGE(PG8_SB(1, 1), rsB, cB + hstep + kstep, voffB);
        PG8_WAIT_V(6); PG8_BAR;
    }
    for (;;) {
        const bool has_next = S.next(ui + 1, nxt);
        const unsigned nA = has_next ? (unsigned)nxt.pm * tstep : cA, nB = has_next ? (unsigned)nxt.pn * tstep : cB;
        unsigned nkb = kb, nki = ki; PG8_FLIP(nkb, nki);
        for (int t = 0; t < nt; t += 2) {
            const bool last = (t == nt - 2);
            const unsigned a1 = cA + kb + (unsigned)(t + 1) * ki;
            const unsigned a2 = last ? nA + nkb : cA + kb + (unsigned)(t + 2) * ki, b2 = last ? nB + nkb : cB + kb + (unsigned)(t + 2) * ki;
            const unsigned a3 = a2 + (last ? nki : ki), b3 = b2 + (last ? nki : ki);
            if (last && has_next) S.a_ready(nxt);
            if constexpr (SP2 == 2) {
            PG8_LDB(B0, 0, 0); PG8_LDB(B1, 0, 1); PG8_SCHED; PG8_LDA(At, 0, 0); PG8_STAGE(PG8_SA(1, 0), rsA, a1, voffA); PG8_STAGE(PG8_SA(1, 1), rsA, a1 + hstep, voffA);
            PG8_WAIT_V(8); PG8_WAIT_L(0); PG8_BAR; PG8_MMA(0, 0, At, B0); PG8_MMA(0, 1, At, B1); PG8_BAR; PG8_SCHED;
            PG8_LDA(At, 0, 1); PG8_STAGE(PG8_SB(0, 0), rsB, b2, voffB); PG8_STAGE(PG8_SB(0, 1), rsB, b2 + hstep, voffB);
            PG8_WAIT_V(6); PG8_WAIT_L(0); PG8_BAR; PG8_MMA(1, 0, At, B0); PG8_MMA(1, 1, At, B1); PG8_BAR; PG8_SCHED;
            PG8_LDB(B0, 1, 0); PG8_LDB(B1, 1, 1); PG8_SCHED; PG8_LDA(At, 1, 0); PG8_STAGE(PG8_SA(0, 0), rsA, a2, voffA); PG8_STAGE(PG8_SA(0, 1), rsA, a2 + hstep, voffA);
            PG8_WAIT_V(8); PG8_WAIT_L(0); PG8_BAR; PG8_MMA(0, 0, At, B0); PG8_MMA(0, 1, At, B1); PG8_BAR; PG8_SCHED;
            PG8_LDA(At, 1, 1); PG8_STAGE(PG8_SB(1, 0), rsB, b3, voffB); PG8_STAGE(PG8_SB(1, 1), rsB, b3 + hstep, voffB);
            PG8_WAIT_V(6); PG8_WAIT_L(0); PG8_BAR; PG8_MMA(1, 0, At, B0); PG8_MMA(1, 1, At, B1); PG8_BAR; PG8_SCHED;
            } else if constexpr (SP2 == 1) {
            PG8_LDB(B0, 0, 0); PG8_LDB(B1, 0, 1); PG8_SCHED; PG8_LDA(At, 0, 0); PG8_STAGE(PG8_SA(1, 1), rsA, a1 + hstep, voffA);
            PG8_WAIT_V(8); PG8_WAIT_L(0); PG8_BAR; PG8_MMA(0, 0, At, B0); PG8_MMA(0, 1, At, B1); PG8_BAR; PG8_SCHED;
            PG8_LDA(At, 0, 1); PG8_STAGE(PG8_SB(0, 0), rsB, b2, voffB); PG8_STAGE(PG8_SB(0, 1), rsB, b2 + hstep, voffB); PG8_STAGE(PG8_SA(0, 0), rsA, a2, voffA);
            PG8_WAIT_V(8); PG8_WAIT_L(0); PG8_BAR; PG8_MMA(1, 0, At, B0); PG8_MMA(1, 1, At, B1); PG8_BAR; PG8_SCHED;
            PG8_LDB(B0, 1, 0); PG8_LDB(B1, 1, 1); PG8_SCHED; PG8_LDA(At, 1, 0); PG8_STAGE(PG8_SA(0, 1), rsA, a2 + hstep, voffA);
            PG8_WAIT_V(8); PG8_WAIT_L(0); PG8_BAR; PG8_MMA(0, 0, At, B0); PG8_MMA(0, 1, At, B1); PG8_BAR; PG8_SCHED;
            PG8_LDA(At, 1, 1); PG8_STAGE(PG8_SB(1, 0), rsB, b3, voffB); PG8_STAGE(PG8_SB(1, 1), rsB, b3 + hstep, voffB); PG8_STAGE(PG8_SA(1, 0), rsA, a3, voffA);
            PG8_WAIT_V(8); PG8_WAIT_L(0); PG8_BAR; PG8_MMA(1, 0, At, B0); PG8_MMA(1, 1, At, B1); PG8_BAR; PG8_SCHED;
            } else {
            PG8_LDB(B0, 0, 0); PG8_SCHED; PG8_LDA(At, 0, 0); PG8_STAGE(PG8_SA(1, 1), rsA, a1 + hstep, voffA);
            PG8_WAIT_L(8); PG8_BAR; PG8_WAIT_L(0); PG8_MMA(0, 0, At, B0); PG8_BAR; PG8_SCHED;
            PG8_LDB(B1, 0, 1); PG8_STAGE(PG8_SB(0, 0), rsB, b2, voffB);
            PG8_BAR; PG8_WAIT_L(0); PG8_MMA(0, 1, At, B1); PG8_BAR;
            PG8_LDA(At, 0, 1); PG8_STAGE(PG8_SA(0, 0), rsA, a2, voffA);
            PG8_BAR; PG8_WAIT_L(0); PG8_MMA(1, 0, At, B0); PG8_BAR; PG8_SCHED;
            PG8_STAGE(PG8_SB(0, 1), rsB, b2 + hstep, voffB);
            PG8_WAIT_V(6); PG8_BAR; PG8_MMA(1, 1, At, B1); PG8_BAR;
            PG8_LDB(B0, 1, 0); PG8_SCHED; PG8_LDA(At, 1, 0); PG8_STAGE(PG8_SA(0, 1), rsA, a2 + hstep, voffA);
            PG8_WAIT_L(8); PG8_BAR; PG8_WAIT_L(0); PG8_MMA(0, 0, At, B0); PG8_BAR; PG8_SCHED;
            PG8_LDB(B1, 1, 1); PG8_STAGE(PG8_SB(1, 0), rsB, b3, voffB);
            PG8_BAR; PG8_WAIT_L(0); PG8_MMA(0, 1, At, B1); PG8_BAR;
            PG8_LDA(At, 1, 1); PG8_STAGE(PG8_SA(1, 0), rsA, a3, voffA);
            PG8_BAR; PG8_WAIT_L(0); PG8_MMA(1, 0, At, B0); PG8_BAR; PG8_SCHED;
            PG8_STAGE(PG8_SB(1, 1), rsB, b3 + hstep, voffB);
            PG8_WAIT_V(6); PG8_BAR; PG8_MMA(1, 1, At, B1); PG8_BAR;
            }
        }
        if (PROF && blockIdx.x == 0 && tid == 0) { const unsigned long long n_ = __builtin_amdgcn_s_memrealtime(); prof[0] += n_ - prof[6]; prof[6] = n_; }
        if constexpr (ALIGN_EPI) { if (wr == 0) PG8_BAR; }
        if constexpr (Epi::LDSPRE) { if (E.lds_ok) { if (has_next) E.pre_unit(lds, nxt, (ui + 1) & 1, wid, lane); E.run_lds(lds, acc, cur, ui & 1, wr, wc, fr, fq); } else E(acc, cur, wr, wc, fr, fq); } else
        E(acc, cur, wr, wc, fr, fq);
        if constexpr (ABL == 4) { _Pragma("unroll") for (int a = 0; a < 2; ++a) _Pragma("unroll") for (int b = 0; b < 2; ++b) _Pragma("unroll") for (int c = 0; c < 2; ++c) asm volatile("" :: "v"(acc32[a][b][c])); }
        if constexpr (REP_EPI) { asm volatile("" ::: "memory"); E(acc, cur, wr, wc, fr, fq); }
        if (PROF && blockIdx.x == 0 && tid == 0) { asm volatile("s_waitcnt vmcnt(0)" ::: "memory"); const unsigned long long n_ = __builtin_amdgcn_s_memrealtime(); prof[1] += n_ - prof[6]; prof[6] = n_; }
        if (!has_next) break;
#pragma unroll
        for (int a = 0; a < 2; ++a)
#pragma unroll
            for (int b = 0; b < 2; ++b)
#pragma unroll
                for (int m = 0; m < 4; ++m)
#pragma unroll
                    for (int n = 0; n < 2; ++n) acc[a][b][m][n] = (f32x4){0.f, 0.f, 0.f, 0.f};
        cur = nxt; cA = nA; cB = nB; kb = nkb; ki = nki; ++ui;
        if constexpr (ALIGN_EPI) { if (wr == 1) PG8_BAR; }
    }
    PG8_WAIT_V(0);
    if constexpr (!ALIGN_EPI) { if (wr == 0) PG8_BAR; }
    PG8_BAR;
#undef PG8_FLIP
#undef PG8_SA
#undef PG8_SB
#undef PG8_STAGE
#undef PG8_LDA
#undef PG8_LDB
#undef PG8_MMA
#undef PG8_WAIT_V
#undef PG8_WAIT_L
#undef PG8_BAR
#undef PG8_SCHED
}
}

__device__ __forceinline__ float silu_mul(float g, float u) { return g * u * __builtin_amdgcn_rcpf(1.0f + __builtin_amdgcn_exp2f(-1.4426950408889634f * g)); }
__device__ __forceinline__ f32x4 silu_mul4(f32x4 g, f32x4 u) { return (f32x4){silu_mul(g[0], u[0]), silu_mul(g[1], u[1]), silu_mul(g[2], u[2]), silu_mul(g[3], u[3])}; }
__device__ __forceinline__ u32x2 pk4(f32x4 v) { u32x2 w; w.x = pk2(v[0], v[1]); w.y = pk2(v[2], v[3]); return w; }
__device__ __forceinline__ int uni(int v) { return __builtin_amdgcn_readfirstlane(v); }
__device__ __forceinline__ unsigned char* opaque_ws(unsigned char* ws) { const unsigned long long w0 = (unsigned long long)ws; unsigned lo = (unsigned)uni((int)(unsigned)w0), hi = (unsigned)uni((int)(unsigned)(w0 >> 32)); asm volatile("" : "+s"(lo), "+s"(hi));
    return (unsigned char*)(GAS unsigned char*)(((unsigned long long)hi << 32) | lo); }
struct LnFold { int q, cgo;
    __device__ __forceinline__ void get(unsigned char* ws, const float*& stats, const float*& cg, const float*& cb) const {
        int q_ = uni(q), o_ = uni(cgo); asm volatile("" : "+s"(q_), "+s"(o_));
        stats = (const float*)(ws + WS_STATS + (size_t)q_ * STATS_BYTES); cg = (const float*)(ws + WS_CG) + o_; cb = (const float*)(ws + WS_CB) + o_; }
};
__device__ __forceinline__ void row_norm(const float* stats, int row, float& rstd, float& t) {
    const f2_t sq = *(const f2_t*)(stats + 2 * (size_t)row); const float mu = sq.x * (1.f / D), var = sq.y * (1.f / D) - mu * mu;
    rstd = __builtin_amdgcn_rsqf(var + LN_EPS); t = -mu * rstd;
}
__device__ __forceinline__ f32x4 lnfix(f32x4 acc, float rstd, float t, f32x4 cg, f32x4 cb) { return acc * rstd + (cg * t + cb); }
__device__ __forceinline__ void stats_add(float* st, int row, float s, float q, int fq) {
    s += __shfl_xor(s, 16); s += __shfl_xor(s, 32); q += __shfl_xor(q, 16); q += __shfl_xor(q, 32);
    if (fq < 2) __hip_atomic_fetch_add(st + 2 * (size_t)row + fq, fq == 0 ? s : q, __ATOMIC_RELAXED, __HIP_MEMORY_SCOPE_AGENT);
}
#define LOAD_CGCB(cgp, cbp, tc0) f32x4 cg[2][2], cb[2][2]; _Pragma("unroll") for (int bj = 0; bj < 2; ++bj) _Pragma("unroll") for (int n = 0; n < 2; ++n) { \
        cg[bj][n] = *(const f32x4*)((cgp) + (tc0) + 128 * bj + 4 * n); cb[bj][n] = *(const f32x4*)((cbp) + (tc0) + 128 * bj + 4 * n); }

constexpr int LF_RT_OFF = RING_BYTES + 4096, LF_CGCB_OFF = LF_RT_OFF + 2048;
__device__ __forceinline__ void lf_pre_unit(unsigned char* ws0, const LnFold& L, PG8_LAS unsigned char* lds, const pg8::Unit& u, int slot, int wid, int lane) {
    if (wid < 2) { unsigned char* ws = opaque_ws(ws0); int o_ = uni(L.cgo); asm volatile("" : "+s"(o_));
        const __amdgpu_buffer_rsrc_t rs = __builtin_amdgcn_make_buffer_rsrc((void*)(ws + WS_CG), (short)0, 0x7ffffff0, 0x00020000);
        __builtin_amdgcn_raw_ptr_buffer_load_lds(rs, (PG8_LAS unsigned*)(lds + LF_CGCB_OFF + slot * 2048 + wid * 1024), 16, (unsigned)lane_id() * 16u, (unsigned)(o_ + u.pn * 256) * 4u + (unsigned)wid * (unsigned)(NCGCB * 4), 0, 0); }
}
__device__ __forceinline__ void lf_pre_phase(unsigned char* ws0, const LnFold& L, PG8_LAS unsigned char* lds, const pg8::Unit& u, int tid, int wid, int lane) {
    lf_pre_unit(ws0, L, lds, u, 0, wid, lane);
    if (tid < 256) { unsigned char* ws = opaque_ws(ws0); const float *stats, *cgp, *cbp; L.get(ws, stats, cgp, cbp); float rstd, t; row_norm(stats, u.pm * 256 + tid, rstd, t);
        *(PG8_LAS f2_t*)(lds + LF_RT_OFF + tid * 8) = (f2_t){rstd, t}; }
    __syncthreads();
}
#define LF_RT(LDS_, i_) ((LDS_) ? *(const PG8_LAS f2_t*)(rtl + (((i_) >> 2) * 128 + ((i_) & 3) * 16) * 8) : rtv[i_])
#define LF_OPERANDS(LDS_, tc0_) f32x4 cg[2][2], cb[2][2]; f2_t rtv[8]; const PG8_LAS unsigned char* rtl = nullptr; \
    if constexpr (LDS_) { int fq_ = fq, fr_ = fr; asm volatile("" : "+v"(fq_), "+v"(fr_));     \
        const PG8_LAS unsigned char* cgl_ = lds + LF_CGCB_OFF + slot * 2048 + (wc * 32 + 8 * fq_) * 4; const PG8_LAS unsigned char* rtl_ = lds + LF_RT_OFF + (wr * 64 + fr_) * 8; \
        _Pragma("unroll") for (int bj = 0; bj < 2; ++bj) _Pragma("unroll") for (int n = 0; n < 2; ++n) { cg[bj][n] = *(const PG8_LAS f32x4*)(cgl_ + (128 * bj + 4 * n) * 4); cb[bj][n] = *(const PG8_LAS f32x4*)(cgl_ + 1024 + (128 * bj + 4 * n) * 4); } \
        rtl = rtl_; \
    } else { const float *stats, *cgp, *cbp; L.get(ws, stats, cgp, cbp); \
        _Pragma("unroll") for (int bj = 0; bj < 2; ++bj) _Pragma("unroll") for (int n = 0; n < 2; ++n) { cg[bj][n] = *(const f32x4*)(cgp + (tc0_) + 128 * bj + 4 * n); cb[bj][n] = *(const f32x4*)(cbp + (tc0_) + 128 * bj + 4 * n); } \
        _Pragma("unroll") for (int i = 0; i < 8; ++i) { float rstd_, t_; row_norm(stats, row0 + (i >> 2) * 128 + (i & 3) * 16, rstd_, t_); rtv[i] = (f2_t){rstd_, t_}; } }
#define LF_MEMBERS bool lds_ok = false; \
    __device__ __forceinline__ void pre_unit(PG8_LAS unsigned char* lds, const pg8::Unit& u, int slot, int wid, int lane) const { lf_pre_unit(ws0, L, lds, u, slot, wid, lane); } \
    __device__ __forceinline__ void pre_phase(PG8_LAS unsigned char* lds, const pg8::Unit& u, int tid, int wid, int lane) const { lf_pre_phase(ws0, L, lds, u, tid, wid, lane); } \
    __device__ __forceinline__ void operator()(const f32x4 (&acc)[2][2][4][2], const pg8::Unit& u, int wr, int wc, int fr, int fq) const { body<false>(nullptr, 0, acc, u, wr, wc, fr, fq); } \
    __device__ __forceinline__ void run_lds(PG8_LAS unsigned char* lds, const f32x4 (&acc)[2][2][4][2], const pg8::Unit& u, int slot, int wr, int wc, int fr, int fq) const { body<true>(lds, slot, acc, u, wr, wc, fr, fq); }
struct EpiSwiglu {
    static constexpr bool PERM = true; static constexpr bool LDSPRE = true;
    unsigned char* ws0; LnFold L; bool lds_ok = false;
    static constexpr int RT_OFF = RING_BYTES + 4096, CGCB_OFF = RT_OFF + 2048;
    __device__ __forceinline__ void pre_unit(PG8_LAS unsigned char* lds, const pg8::Unit& u, int slot, int wid, int lane) const {
        if (wid < 2) { unsigned char* ws = opaque_ws(ws0); int o_ = uni(L.cgo); asm volatile("" : "+s"(o_));
            const __amdgpu_buffer_rsrc_t rs = __builtin_amdgcn_make_buffer_rsrc((void*)(ws + WS_CG), (short)0, 0x7ffffff0, 0x00020000);
            __builtin_amdgcn_raw_ptr_buffer_load_lds(rs, (PG8_LAS unsigned*)(lds + CGCB_OFF + slot * 2048 + wid * 1024), 16, (unsigned)lane * 16u, (unsigned)(o_ + u.pn * 256) * 4u + (unsigned)wid * (unsigned)(NCGCB * 4), 0, 0); }
    }
    __device__ __forceinline__ void pre_phase(PG8_LAS unsigned char* lds, const pg8::Unit& u, int tid, int wid, int lane) const {
        pre_unit(lds, u, 0, wid, lane);
        if (tid < 256) { unsigned char* ws = opaque_ws(ws0); const float *stats, *cgp, *cbp; L.get(ws, stats, cgp, cbp); float rstd, t; row_norm(stats, u.pm * 256 + tid, rstd, t);
            *(PG8_LAS f2_t*)(lds + RT_OFF + tid * 8) = (f2_t){rstd, t}; }
        __syncthreads();
    }
    __device__ __forceinline__ void run_lds(PG8_LAS unsigned char* lds, const f32x4 (&acc)[2][2][4][2], const pg8::Unit& u, int slot, int wr, int wc, int fr, int fq) const {
        unsigned char* ws = opaque_ws(ws0); bf16_t* O = (bf16_t*)(ws + WS_ACT);
        const int row0 = u.pm * 256 + wr * 64 + fr, col0 = u.pn * 128 + wc * 32 + 8 * fq;
        const PG8_LAS unsigned char* cgl = lds + CGCB_OFF + slot * 2048 + (wc * 32 + 8 * fq) * 4; const PG8_LAS unsigned char* rtl = lds + RT_OFF + (wr * 64 + fr) * 8;
        f32x4 cg[2][2], cb[2][2];
#pragma unroll
        for (int bj = 0; bj < 2; ++bj)
#pragma unroll
            for (int n = 0; n < 2; ++n) { cg[bj][n] = *(const PG8_LAS f32x4*)(cgl + (128 * bj + 4 * n) * 4); cb[bj][n] = *(const PG8_LAS f32x4*)(cgl + 1024 + (128 * bj + 4 * n) * 4); }
#pragma unroll
        for (int ai = 0; ai < 2; ++ai)
#pragma unroll
            for (int m = 0; m < 4; ++m) { const int row = row0 + ai * 128 + m * 16; const f2_t rt = *(const PG8_LAS f2_t*)(rtl + (ai * 128 + m * 16) * 8); const float rstd = rt.x, t = rt.y;
                const u32x2 a = pk4(silu_mul4(lnfix(acc[ai][0][m][0], rstd, t, cg[0][0], cb[0][0]), lnfix(acc[ai][1][m][0], rstd, t, cg[1][0], cb[1][0])));
                const u32x2 b = pk4(silu_mul4(lnfix(acc[ai][0][m][1], rstd, t, cg[0][1], cb[0][1]), lnfix(acc[ai][1][m][1], rstd, t, cg[1][1], cb[1][1])));
                *(u32x4*)(O + (size_t)row * FF + col0) = (u32x4){a.x, a.y, b.x, b.y}; }
    }
    __device__ __forceinline__ void operator()(const f32x4 (&acc)[2][2][4][2], const pg8::Unit& u, int wr, int wc, int fr, int fq) const {
        unsigned char* ws = opaque_ws(ws0); bf16_t* O = (bf16_t*)(ws + WS_ACT); const float *stats, *cgp, *cbp; L.get(ws, stats, cgp, cbp);
        const int row0 = u.pm * 256 + wr * 64 + fr, col0 = u.pn * 128 + wc * 32 + 8 * fq, tc0 = u.pn * 256 + wc * 32 + 8 * fq;
        LOAD_CGCB(cgp, cbp, tc0)
#pragma unroll
        for (int ai = 0; ai < 2; ++ai)
#pragma unroll
            for (int m = 0; m < 4; ++m) { const int row = row0 + ai * 128 + m * 16; float rstd, t; row_norm(stats, row, rstd, t);
                const u32x2 a = pk4(silu_mul4(lnfix(acc[ai][0][m][0], rstd, t, cg[0][0], cb[0][0]), lnfix(acc[ai][1][m][0], rstd, t, cg[1][0], cb[1][0])));
                const u32x2 b = pk4(silu_mul4(lnfix(acc[ai][0][m][1], rstd, t, cg[0][1], cb[0][1]), lnfix(acc[ai][1][m][1], rstd, t, cg[1][1], cb[1][1])));
                *(u32x4*)(O + (size_t)row * FF + col0) = (u32x4){a.x, a.y, b.x, b.y}; }
    }
    __device__ __forceinline__ void meta(int r, int col, f32x4 g, f32x4 up) const {
        unsigned char* ws = opaque_ws(ws0); bf16_t* O = (bf16_t*)(ws + WS_ACT); const float *stats, *cgp, *cbp; L.get(ws, stats, cgp, cbp);
        const int row = MREAL + r, tc = 256 * (col >> 7) + (col & 127); float rstd, t; row_norm(stats, row, rstd, t);
        g = lnfix(g, rstd, t, *(const f32x4*)(cgp + tc), *(const f32x4*)(cbp + tc)); up = lnfix(up, rstd, t, *(const f32x4*)(cgp + tc + 128), *(const f32x4*)(cbp + tc + 128));
        *(u32x2*)(O + (size_t)row * FF + col) = pk4(silu_mul4(g, up)); }
};
struct EpiNull { static constexpr bool PERM = true; static constexpr bool LDSPRE = false;
    __device__ __forceinline__ void operator()(const f32x4 (&acc)[2][2][4][2], const pg8::Unit&, int, int, int, int) const {
#pragma unroll
        for (int a = 0; a < 2; ++a)
#pragma unroll
            for (int b = 0; b < 2; ++b)
#pragma unroll
                for (int m = 0; m < 4; ++m)
#pragma unroll
                    for (int n = 0; n < 2; ++n) asm volatile("" :: "v"(acc[a][b][m][n])); } };
struct RangeOrder : pg8::StaticOrder { int r0, r1;
    __device__ bool next(int i, pg8::Unit& u) const { return (i + r0 < r1) && pg8::StaticOrder::next(i + r0, u); } };
struct FakeOrder : pg8::StaticOrder { int nun;
    __device__ bool next(int i, pg8::Unit& u) const { u.pm = 0; u.pn = 0; return i < nun; } };
struct EpiResidLN {
    static constexpr bool PERM = true; static constexpr bool LDSPRE = false; static constexpr bool dry = false; static constexpr int XM = 0;
    unsigned char* ws0; int qprev, qnew; float coef;
    __device__ __forceinline__ void operator()(const f32x4 (&acc)[2][2][4][2], const pg8::Unit& u, int wr, int wc, int fr, int fq) const {
        unsigned char* ws = opaque_ws(ws0); int qp = uni(qprev), qn = uni(qnew); asm volatile("" : "+s"(qp), "+s"(qn));
        typedef __amdgpu_buffer_rsrc_t rsrc_t;
#define MKRS(p_) __builtin_amdgcn_make_buffer_rsrc((void*)(p_), (short)0, 0x7ffffff0, 0x00020000)
        const rsrc_t rsH = MKRS(ws + WS_HB), rsO = MKRS(dry ? ws + WS_X32 : ws + WS_HB), rsS = MKRS(ws + WS_STATS + (size_t)qp * STATS_BYTES), rsN = MKRS(ws + WS_STATS + (size_t)qn * STATS_BYTES);
        const rsrc_t rsG = MKRS(ws + WS_LNG + (size_t)qp * D * 4), rsB = MKRS(ws + WS_LNB + (size_t)qp * D * 4);
#undef MKRS
        const int row0 = u.pm * 256 + wr * 64 + fr, ccol = u.pn * 256 + wc * 32 + 8 * fq;
        const unsigned hvo = (unsigned)(row0 * D + ccol) * 2u, svo = (unsigned)row0 * 8u, gvo = (unsigned)ccol * 4u;
        f32x4 gv[2][2], bv[2][2];
#pragma unroll
        for (int bj = 0; bj < 2; ++bj)
#pragma unroll
            for (int n = 0; n < 2; ++n) { gv[bj][n] = __builtin_bit_cast(f32x4, __builtin_amdgcn_raw_buffer_load_b128(rsG, (int)(gvo + 512u * bj + 16u * n), 0, 0)); bv[bj][n] = __builtin_bit_cast(f32x4, __builtin_amdgcn_raw_buffer_load_b128(rsB, (int)(gvo + 512u * bj + 16u * n), 0, 0)); }
        float S[8], Q[8];
        u32x4 hw[2][4][2]; u32x2 sw[2][4];
#define RL_LOAD(ai_) _Pragma("unroll") for (int m = 0; m < 4; ++m) { sw[ai_][m] = __builtin_amdgcn_raw_buffer_load_b64(rsS, (int)(svo + (unsigned)(128 * (ai_) + 16 * m) * 8u), 0, 0); \
            _Pragma("unroll") for (int bj = 0; bj < 2; ++bj) hw[ai_][m][bj] = (XM == 3) ? (u32x4){0x3c003c00u, 0x3c003c00u, 0x3c003c00u, 0x3c003c00u} : __builtin_amdgcn_raw_buffer_load_b128(rsH, (int)(hvo + 256u * bj), (128 * (ai_) + 16 * m) * (D * 2), 0); }
#define RL_STATS(i0_) do { const bool b0_ = (fq & 1) != 0, b1_ = (fq & 2) != 0; \
            const float y0_ = (b0_ ? Q[i0_] : S[i0_]) + __shfl_xor(b0_ ? S[i0_] : Q[i0_], 16), y1_ = (b0_ ? Q[(i0_) + 1] : S[(i0_) + 1]) + __shfl_xor(b0_ ? S[(i0_) + 1] : Q[(i0_) + 1], 16); \
            const float tot_ = (b1_ ? y1_ : y0_) + __shfl_xor(b1_ ? y0_ : y1_, 32); \
            if (XM != 2) __builtin_amdgcn_raw_ptr_buffer_atomic_fadd_f32(tot_, rsN, (int)(svo + 4u * (fq & 1) + (unsigned)(128 * ((i0_) >> 2) + 16 * ((i0_) & 3) + (b1_ ? 16 : 0)) * 8u), 0, 0); } while (0)
        RL_LOAD(0);
        __builtin_amdgcn_sched_barrier(0);
#pragma unroll
        for (int ai = 0; ai < 2; ++ai) {
#pragma unroll
            for (int m = 0; m < 4; ++m) { float s = 0.f, q = 0.f;
                if (ai == 0 && m == 2) { RL_LOAD(1); __builtin_amdgcn_sched_barrier(0); }
                const float mu = __uint_as_float(sw[ai][m].x) * (1.f / D), var = __uint_as_float(sw[ai][m].y) * (1.f / D) - mu * mu, rstd = __builtin_amdgcn_rsqf(var + LN_EPS), t = -mu * rstd;
#pragma unroll
                for (int bj = 0; bj < 2; ++bj) { const u32x4 w = hw[ai][m][bj];
                    const f32x4 h0 = {bf_lo(w.x), bf_hi(w.x), bf_lo(w.y), bf_hi(w.y)}, h1 = {bf_lo(w.z), bf_hi(w.z), bf_lo(w.w), bf_hi(w.w)};
                    const f32x4 r0 = ((h0 * rstd + t) * gv[bj][0] + bv[bj][0]) * ALPHA + acc[ai][bj][m][0] * coef, r1 = ((h1 * rstd + t) * gv[bj][1] + bv[bj][1]) * ALPHA + acc[ai][bj][m][1] * coef;
                    const u32x2 a = pk4(r0), c = pk4(r1); if (XM != 4) *(u32x4*)(ws + (dry ? WS_X32 : WS_HB) + (size_t)((128 * ai + 16 * m) * (D * 2) + 256 * bj) + (size_t)hvo) = (u32x4){a.x, a.y, c.x, c.y};
                    s += ((r0[0] + r0[1]) + (r0[2] + r0[3])) + ((r1[0] + r1[1]) + (r1[2] + r1[3]));
                    q += ((r0[0] * r0[0] + r0[1] * r0[1]) + (r0[2] * r0[2] + r0[3] * r0[3])) + ((r1[0] * r1[0] + r1[1] * r1[1]) + (r1[2] * r1[2] + r1[3] * r1[3])); }
                S[ai * 4 + m] = s; Q[ai * 4 + m] = q; __builtin_amdgcn_sched_barrier(0);
                if (m == 1) RL_STATS(ai * 4); if (m == 3) RL_STATS(ai * 4 + 2); } }
#undef RL_LOAD
#undef RL_STATS
    }
    __device__ __forceinline__ void meta(int r, int col, f32x4 a, f32x4) const {
        unsigned char* ws = opaque_ws(ws0); int qp = uni(qprev), qn = uni(qnew); asm volatile("" : "+s"(qp), "+s"(qn));
        bf16_t* Hb = (bf16_t*)(ws + WS_HB);
        const float* st_prev = (const float*)(ws + WS_STATS + (size_t)qp * STATS_BYTES); float* st_new = (float*)(ws + WS_STATS + (size_t)qn * STATS_BYTES);
        const float* g = (const float*)(ws + WS_LNG) + (size_t)qp * D; const float* b = (const float*)(ws + WS_LNB) + (size_t)qp * D;
        const int row = MREAL + r; float rstd, t; row_norm(st_prev, row, rstd, t);
        const u32x2 w = *(const u32x2*)(Hb + (size_t)row * D + col); const f32x4 h = {bf_lo(w.x), bf_hi(w.x), bf_lo(w.y), bf_hi(w.y)};
        const f32x4 rr = ((h * rstd + t) * *(const f32x4*)(g + col) + *(const f32x4*)(b + col)) * ALPHA + a * coef;
        *(u32x2*)(Hb + (size_t)row * D + col) = pk4(rr);
        stats_add(st_new, row, (rr[0] + rr[1]) + (rr[2] + rr[3]), (rr[0] * rr[0] + rr[1] * rr[1]) + (rr[2] * rr[2] + rr[3] * rr[3]), col >> 2 & 3); }
};
struct EpiConvIn {
    static constexpr bool PERM = true; static constexpr bool LDSPRE = true;
    unsigned char* ws0; LnFold L; LF_MEMBERS
    template <bool LDS> __device__ __forceinline__ void body(PG8_LAS unsigned char* lds, int slot, const f32x4 (&acc)[2][2][4][2], const pg8::Unit& u, int wr, int wc, int fr, int fq) const {
        unsigned char* ws = opaque_ws(ws0); bf16_t* V = (bf16_t*)(ws + WS_ACT); bf16_t* BG = (bf16_t*)(ws + WS_ACT + ACT_SUB);
        const int row0 = u.pm * 256 + wr * 64 + fr, tc0 = u.pn * 256 + wc * 32 + 8 * fq;
        LF_OPERANDS(LDS, tc0)
        if (u.pn < 16) {
            const int col0 = u.pn * 128 + wc * 32 + 8 * fq;
#pragma unroll
            for (int ai = 0; ai < 2; ++ai)
#pragma unroll
                for (int m = 0; m < 4; ++m) { const int row = row0 + ai * 128 + m * 16; const f2_t rt_ = LF_RT(LDS, ai * 4 + m); const float rstd = rt_.x, t = rt_.y;
                    const u32x2 a = pk4(lnfix(acc[ai][0][m][0], rstd, t, cg[0][0], cb[0][0]) * lnfix(acc[ai][1][m][0], rstd, t, cg[1][0], cb[1][0]));
                    const u32x2 b = pk4(lnfix(acc[ai][0][m][1], rstd, t, cg[0][1], cb[0][1]) * lnfix(acc[ai][1][m][1], rstd, t, cg[1][1], cb[1][1]));
                    *(u32x4*)(V + (size_t)row * D + col0) = (u32x4){a.x, a.y, b.x, b.y}; }
        } else {
            const int col0 = (u.pn - 16) * 256 + wc * 32 + 8 * fq;
#pragma unroll
            for (int ai = 0; ai < 2; ++ai)
#pragma unroll
                for (int m = 0; m < 4; ++m) { const int row = row0 + ai * 128 + m * 16; const f2_t rt_ = LF_RT(LDS, ai * 4 + m); const float rstd = rt_.x, t = rt_.y; bf16_t* p = BG + (size_t)row * D + col0;
#pragma unroll
                    for (int bj = 0; bj < 2; ++bj) { const u32x2 a = pk4(lnfix(acc[ai][bj][m][0], rstd, t, cg[bj][0], cb[bj][0])), b = pk4(lnfix(acc[ai][bj][m][1], rstd, t, cg[bj][1], cb[bj][1]));
                        *(u32x4*)(p + bj * 128) = (u32x4){a.x, a.y, b.x, b.y}; } }
        }
    }
};
struct MetaConvV { unsigned char* ws0; LnFold L;
    __device__ __forceinline__ void meta(int r, int col, f32x4 c, f32x4 uu) const {
        unsigned char* ws = opaque_ws(ws0); bf16_t* V = (bf16_t*)(ws + WS_ACT); const float *stats, *cgp, *cbp; L.get(ws, stats, cgp, cbp);
        const int row = MREAL + r, tc = 256 * (col >> 7) + (col & 127); float rstd, t; row_norm(stats, row, rstd, t);
        c = lnfix(c, rstd, t, *(const f32x4*)(cgp + tc), *(const f32x4*)(cbp + tc)); uu = lnfix(uu, rstd, t, *(const f32x4*)(cgp + tc + 128), *(const f32x4*)(cbp + tc + 128));
        *(u32x2*)(V + (size_t)row * D + col) = pk4(c * uu); } };
struct EpiBf16S {
    static constexpr bool PERM = true; static constexpr bool LDSPRE = true;
    unsigned char* ws0; size_t ooff; float scale; LnFold L; LF_MEMBERS
    template <bool LDS> __device__ __forceinline__ void body(PG8_LAS unsigned char* lds, int slot, const f32x4 (&acc)[2][2][4][2], const pg8::Unit& u, int wr, int wc, int fr, int fq) const {
        unsigned char* ws = opaque_ws(ws0); bf16_t* O = (bf16_t*)(ws + ooff);
        const int row0 = u.pm * 256 + wr * 64 + fr, col0 = u.pn * 256 + wc * 32 + 8 * fq;
        LF_OPERANDS(LDS, col0)
#pragma unroll
        for (int ai = 0; ai < 2; ++ai)
#pragma unroll
            for (int m = 0; m < 4; ++m) { const int row = row0 + ai * 128 + m * 16; const f2_t rt_ = LF_RT(LDS, ai * 4 + m); const float rstd = rt_.x, t = rt_.y; bf16_t* p = O + (size_t)row * D + col0;
#pragma unroll
                for (int bj = 0; bj < 2; ++bj) { const u32x2 a = pk4(lnfix(acc[ai][bj][m][0], rstd, t, cg[bj][0], cb[bj][0]) * scale), b = pk4(lnfix(acc[ai][bj][m][1], rstd, t, cg[bj][1], cb[bj][1]) * scale);
                    *(u32x4*)(p + bj * 128) = (u32x4){a.x, a.y, b.x, b.y}; } }
    }
    __device__ __forceinline__ void meta(int r, int col, f32x4 a, f32x4) const {
        unsigned char* ws = opaque_ws(ws0); bf16_t* O = (bf16_t*)(ws + ooff); const float *stats, *cgp, *cbp; L.get(ws, stats, cgp, cbp);
        const int row = MREAL + r; float rstd, t; row_norm(stats, row, rstd, t);
        *(u32x2*)(O + (size_t)row * D + col) = pk4(lnfix(a, rstd, t, *(const f32x4*)(cgp + col), *(const f32x4*)(cbp + col)) * scale); }
};
__device__ __forceinline__ int vperm(int ts) { return (ts & ~12) | ((ts & 4) << 1) | ((ts & 8) >> 1); }
struct EpiKV {
    static constexpr bool PERM = true; static constexpr bool LDSPRE = false;
    unsigned char* ws0; LnFold L;
    __device__ __forceinline__ void operator()(const f32x4 (&acc)[2][2][4][2], const pg8::Unit& u, int wr, int wc, int fr, int fq) const {
        unsigned char* ws = opaque_ws(ws0); bf16_t* KB = (bf16_t*)(ws + WS_KB); bf16_t* VT = (bf16_t*)(ws + WS_VT); const float *stats, *cgp, *cbp; L.get(ws, stats, cgp, cbp);
        const int row0 = u.pm * 256 + wr * 64 + fr, d0 = wc * 32 + 8 * fq, tc0 = u.pn * 256 + wc * 32 + 8 * fq;
        LOAD_CGCB(cgp, cbp, tc0)
        if (u.pn < 8) {
#pragma unroll
            for (int ai = 0; ai < 2; ++ai)
#pragma unroll
                for (int m = 0; m < 4; ++m) { const int row = row0 + ai * 128 + m * 16, b = row >> 11, ts = 32 + (row & 2047); float rstd, t; row_norm(stats, row, rstd, t);
#pragma unroll
                    for (int bj = 0; bj < 2; ++bj) { const int h = 2 * u.pn + bj; bf16_t* p = KB + ((size_t)(b * NH + h) * TS + ts) * HD + d0;
                        const u32x2 a = pk4(lnfix(acc[ai][bj][m][0], rstd, t, cg[bj][0], cb[bj][0])), bq = pk4(lnfix(acc[ai][bj][m][1], rstd, t, cg[bj][1], cb[bj][1])); *(u32x4*)p = (u32x4){a.x, a.y, bq.x, bq.y}; } }
        } else {
#pragma unroll
            for (int ai = 0; ai < 2; ++ai)
#pragma unroll
                for (int m = 0; m < 4; ++m) { const int row = row0 + ai * 128 + m * 16, b = row >> 11, ts = 32 + (row & 2047); float rstd, t; row_norm(stats, row, rstd, t);
#pragma unroll
                    for (int bj = 0; bj < 2; ++bj) { const int h = 2 * (u.pn - 8) + bj; bf16_t* p = VT + ((size_t)(b * NH + h) * HD + d0) * TS + vperm(ts);
#pragma unroll
                        for (int n = 0; n < 2; ++n) { const u32x2 w = pk4(lnfix(acc[ai][bj][m][n], rstd, t, cg[bj][n], cb[bj][n]));
                            p[(size_t)(4 * n + 0) * TS] = (bf16_t)(w.x & 0xffffu); p[(size_t)(4 * n + 1) * TS] = (bf16_t)(w.x >> 16);
                            p[(size_t)(4 * n + 2) * TS] = (bf16_t)(w.y & 0xffffu); p[(size_t)(4 * n + 3) * TS] = (bf16_t)(w.y >> 16); } } }
        }
    }
    __device__ __forceinline__ void meta(int r, int col, f32x4 a, f32x4) const {
        unsigned char* ws = opaque_ws(ws0); bf16_t* KB = (bf16_t*)(ws + WS_KB); bf16_t* VT = (bf16_t*)(ws + WS_VT); const float *stats, *cgp, *cbp; L.get(ws, stats, cgp, cbp);
        const int row = MREAL + r; float rstd, t; row_norm(stats, row, rstd, t);
        const u32x2 w = pk4(lnfix(a, rstd, t, *(const f32x4*)(cgp + col), *(const f32x4*)(cbp + col))); const int ts = 16 + r;
        if (col < D) { const int h = col >> 7, d = col & 127;
            for (int b = 0; b < NB; ++b) *(u32x2*)(KB + ((size_t)(b * NH + h) * TS + ts) * HD + d) = w;
        } else { const int c2 = col - D, h = c2 >> 7, d = c2 & 127;
            for (int b = 0; b < NB; ++b) { bf16_t* p = VT + ((size_t)(b * NH + h) * HD + d) * TS + vperm(ts);
                p[0] = (bf16_t)(w.x & 0xffffu); p[(size_t)TS] = (bf16_t)(w.x >> 16); p[(size_t)2 * TS] = (bf16_t)(w.y & 0xffffu); p[(size_t)3 * TS] = (bf16_t)(w.y >> 16); } }
    }
};

template <bool PAIR, int KS, class F>
__device__ __forceinline__ void meta_gemm(const bf16_t* A, int lda, const bf16_t* Bt, int K, int ncols, int wg, int nwg, int wave, int lane, LAS unsigned char* lds, const F& f) {
    constexpr int UPW = 8 / KS;
    const int fr = lane & 15, fq = lane >> 4, nunits = ncols >> 4, kper = K / KS, slot = wave / KS, kbeg = (wave % KS) * kper;
    LAS f32x4* red = (LAS f32x4*)lds;
    for (int u0 = wg * UPW; u0 < nunits; u0 += nwg * UPW) {
        const int u = u0 + slot; const bool live = u < nunits;
        f32x4 acc0 = {0.f, 0.f, 0.f, 0.f}, acc1 = {0.f, 0.f, 0.f, 0.f};
        if (live) {
            int br0 = 16 * u, br1 = 0;
            if (PAIR) { const int j0 = 16 * u; br0 = 256 * (j0 >> 7) + (j0 & 127); br1 = br0 + 128; }
            const bf16_t* ap = A + (size_t)fr * lda + 8 * fq + kbeg;
            const bf16_t* bp0 = Bt + (size_t)(br0 + fr) * K + 8 * fq + kbeg;
            const bf16_t* bp1 = Bt + (size_t)(br1 + fr) * K + 8 * fq + kbeg;
#pragma unroll 8
            for (int k0 = 0; k0 < kper; k0 += 32) {
                const bf16x8 a = *(const bf16x8*)(ap + k0), b0 = *(const bf16x8*)(bp0 + k0);
                acc0 = __builtin_amdgcn_mfma_f32_16x16x32_f16(__builtin_bit_cast(h8_t, b0), __builtin_bit_cast(h8_t, a), acc0, 0, 0, 0);
                if (PAIR) { const bf16x8 b1 = *(const bf16x8*)(bp1 + k0); acc1 = __builtin_amdgcn_mfma_f32_16x16x32_f16(__builtin_bit_cast(h8_t, b1), __builtin_bit_cast(h8_t, a), acc1, 0, 0, 0); }
            }
        }
        red[(wave * 2 + 0) * 64 + lane] = acc0; if (PAIR) red[(wave * 2 + 1) * 64 + lane] = acc1;
        __syncthreads();
        if (live && (wave % KS) == 0) {
#pragma unroll
            for (int w = 1; w < KS; ++w) { acc0 = acc0 + red[((wave + w) * 2 + 0) * 64 + lane]; if (PAIR) acc1 = acc1 + red[((wave + w) * 2 + 1) * 64 + lane]; }
            f.meta(fr, 16 * u + 4 * fq, acc0, acc1);
        }
        __syncthreads();
    }
}

#define XB_TMO      128
#define XB_XCNT(j)  (256  + 64 * (j))
#define XB_XSUB(j)  (1280 + 64 * (j))
#define XB_XGEN(j)  (2304 + 64 * (j))
#define XB_TOP      3328
#define XB_TOPGEN   3392
#define XCD_BAR_WORDS 3456
#define XB_SPIN_CAP (1u << 18)
__device__ __forceinline__ unsigned xb_ld(unsigned* p)              { return __hip_atomic_load(p, __ATOMIC_RELAXED, __HIP_MEMORY_SCOPE_AGENT); }
__device__ __forceinline__ unsigned xb_add(unsigned* p, unsigned v) { return __hip_atomic_fetch_add(p, v, __ATOMIC_RELAXED, __HIP_MEMORY_SCOPE_AGENT); }
__device__ __forceinline__ unsigned xb_xcc_id() { return (unsigned)__builtin_amdgcn_s_getreg((3 << 11) | 20) & 0xFu; }
#define XB_SPIN(cond, bar) do { unsigned _sp = 0; while (cond) { __builtin_amdgcn_s_sleep(1); \
    if ((++_sp & 255u) == 0u) { if (xb_ld(&(bar)[XB_TMO])) break; if (_sp > XB_SPIN_CAP) { atomicAdd(&(bar)[XB_TMO], 1u); break; } } } } while (0)
struct XcdBarrier { unsigned* bar; unsigned x; volatile LAS unsigned* st; };
__device__ __forceinline__ XcdBarrier xcd_barrier_post(unsigned* bar, volatile LAS unsigned* st) {
    XcdBarrier b; b.bar = bar; b.x = xb_xcc_id(); b.st = st;
    if (threadIdx.x == 0) (void)xb_add(&bar[XB_XCNT(b.x)], 1u);
    return b;
}
__device__ __forceinline__ void xcd_barrier_complete(unsigned* bar, unsigned x, unsigned& nloc, unsigned& nx) {
    const unsigned G = gridDim.x * gridDim.y * gridDim.z;
    unsigned sum, cnt, mine, sp = 0u;
    for (;;) {
        sum = 0u; cnt = 0u; mine = 0u;
#pragma unroll
        for (unsigned j = 0; j < 16; ++j) { const unsigned c = xb_ld(&bar[XB_XCNT(j)]); sum += c; cnt += (c > 0u) ? 1u : 0u; mine = (j == x) ? c : mine; }
        if (sum == G) break;
        __builtin_amdgcn_s_sleep(1);
        if ((++sp & 255u) == 0u) { if (xb_ld(&bar[XB_TMO])) break; if (sp > XB_SPIN_CAP) { atomicAdd(&bar[XB_TMO], 1u); break; } }
    }
    nloc = mine > 0u ? mine : 1u; nx = cnt > 0u ? cnt : 1u;
}
__device__ __forceinline__ void xcd_barrier(const XcdBarrier& b, int wave) {
    asm volatile("s_waitcnt vmcnt(0)" ::: "memory");
    __syncthreads();
    if (wave == 0 && lane_id() == 0) {
        unsigned* bar = b.bar;
        unsigned bx = (unsigned)__builtin_amdgcn_readfirstlane((int)b.x); asm volatile("" : "+s"(bx));
        __builtin_amdgcn_s_waitcnt(0);
        unsigned nloc = b.st[0], nx = b.st[1];
        if (nloc == 0u) { xcd_barrier_complete(bar, bx, nloc, nx); b.st[0] = nloc; b.st[1] = nx; }
        const unsigned old = xb_add(&bar[XB_XSUB(bx)], 1u);
        const unsigned gen = old / nloc;
        if (old + 1u == (gen + 1u) * nloc) {
            __builtin_amdgcn_fence(__ATOMIC_RELEASE, "agent");
            asm volatile("s_waitcnt vmcnt(0)" ::: "memory");
            const unsigned og = xb_add(&bar[XB_TOP], 1u);
            const unsigned tg = og / nx;
            if (og + 1u == (tg + 1u) * nx) xb_add(&bar[XB_TOPGEN], 1u);
            else XB_SPIN(xb_ld(&bar[XB_TOPGEN]) == tg, bar);
            __builtin_amdgcn_fence(__ATOMIC_ACQUIRE, "agent");
            xb_add(&bar[XB_XGEN(bx)], 1u);
            asm volatile("s_waitcnt vmcnt(0)" ::: "memory");
        } else {
            XB_SPIN(xb_ld(&bar[XB_XGEN(bx)]) == gen, bar);
            __builtin_amdgcn_fence(__ATOMIC_ACQUIRE, "agent");
            asm volatile("s_waitcnt vmcnt(0)" ::: "memory");
        }
    }
    __syncthreads();
}

struct Frame {
    LAS unsigned char* lds;
    int tid, lane, wave, vcu, G, gw, ngw;
    unsigned char* ws;
};
#define LDS_WAIT() asm volatile("s_waitcnt lgkmcnt(0)" ::: "memory")
__device__ __forceinline__ float wave_sum(float v) {
#pragma unroll
    for (int o = 1; o < 64; o <<= 1) v += __shfl_xor(v, o);
    return v;
}

template <int MODE> __device__ __forceinline__ void transpose_item(f32x4 (&v)[12], const float* W, int K, int Nsrc, int srccol0, bf16_t* WT, int dstrow0, int k0, LAS float* scr, int lane, const float* gk, const float* bk, float* cg, float* cb, bool do_atomics = true) {
    if (MODE != 1) { const float* src = W + (size_t)(k0 + (lane >> 3)) * Nsrc + srccol0 + 4 * (lane & 7);
#pragma unroll
        for (int i = 0; i < 8; ++i) v[i] = *(const f32x4*)(src + (size_t)(8 * i) * Nsrc);
        if (gk) { const int c_ = lane & 7; v[8] = *(const f32x4*)(gk + k0 + 8 * c_); v[9] = *(const f32x4*)(gk + k0 + 8 * c_ + 4); v[10] = *(const f32x4*)(bk + k0 + 8 * c_); v[11] = *(const f32x4*)(bk + k0 + 8 * c_ + 4); } }
    if (MODE == 0) return;
#pragma unroll
    for (int i = 0; i < 8; ++i) { LAS float* d = scr + (8 * i + (lane >> 3)) * 33 + 4 * (lane & 7); d[0] = v[i][0]; d[1] = v[i][1]; d[2] = v[i][2]; d[3] = v[i][3]; }
    LDS_WAIT(); asm volatile("" ::: "memory");
    const int c = lane & 7;
    if (gk) {
        const f32x4 g0 = v[8], g1 = v[9], b0 = v[10], b1 = v[11];
        float sg[4], sb[4];
#pragma unroll
        for (int j = 0; j < 4; ++j) { const int n = (lane >> 3) + 8 * j; const LAS float* s = scr + (8 * c) * 33 + n;
            const float w0 = s[0 * 33], w1 = s[1 * 33], w2 = s[2 * 33], w3 = s[3 * 33], w4 = s[4 * 33], w5 = s[5 * 33], w6 = s[6 * 33], w7 = s[7 * 33];
            u32x4 o; o.x = pk2(w0 * g0[0], w1 * g0[1]); o.y = pk2(w2 * g0[2], w3 * g0[3]); o.z = pk2(w4 * g1[0], w5 * g1[1]); o.w = pk2(w6 * g1[2], w7 * g1[3]);
            *(u32x4*)(WT + (size_t)(dstrow0 + n) * K + k0 + 8 * c) = o;
            float a = ((bf_lo(o.x) + bf_hi(o.x)) + (bf_lo(o.y) + bf_hi(o.y))) + ((bf_lo(o.z) + bf_hi(o.z)) + (bf_lo(o.w) + bf_hi(o.w)));
            float bsum = ((w0 * b0[0] + w1 * b0[1]) + (w2 * b0[2] + w3 * b0[3])) + ((w4 * b1[0] + w5 * b1[1]) + (w6 * b1[2] + w7 * b1[3]));
            a += __shfl_xor(a, 1); a += __shfl_xor(a, 2); a += __shfl_xor(a, 4); bsum += __shfl_xor(bsum, 1); bsum += __shfl_xor(bsum, 2); bsum += __shfl_xor(bsum, 4);
            sg[j] = a; sb[j] = bsum; }
        const int srcl = 8 * (lane & 7); float ag = 0.f, ab = 0.f;
#pragma unroll
        for (int j = 0; j < 4; ++j) { const float tg = __shfl(sg[j], srcl), tb = __shfl(sb[j], srcl); if ((lane >> 3) == j) { ag = tg; ab = tb; } }
        if (lane < 32 && do_atomics) { __hip_atomic_fetch_add(cg + dstrow0 + lane, ag, __ATOMIC_RELAXED, __HIP_MEMORY_SCOPE_AGENT); __hip_atomic_fetch_add(cb + dstrow0 + lane, ab, __ATOMIC_RELAXED, __HIP_MEMORY_SCOPE_AGENT); }
    } else {
#pragma unroll
        for (int j = 0; j < 4; ++j) { const int n = (lane >> 3) + 8 * j; const LAS float* s = scr + (8 * c) * 33 + n;
            u32x4 o; o.x = pk2(s[0 * 33], s[1 * 33]); o.y = pk2(s[2 * 33], s[3 * 33]); o.z = pk2(s[4 * 33], s[5 * 33]); o.w = pk2(s[6 * 33], s[7 * 33]);
            *(u32x4*)(WT + (size_t)(dstrow0 + n) * K + k0 + 8 * c) = o; }
    }
    LDS_WAIT(); asm volatile("" ::: "memory");
}
constexpr int IT_W1 = (D / 64) * (FF2 / 32), IT_W2 = (FF / 64) * (D / 32), IT_CIN = (D / 64) * (3 * D / 32), IT_SQ = (D / 64) * (D / 32), IT_KV = (D / 64) * (2 * D / 32);
constexpr int IT_END_W1 = 8 * IT_W1, IT_END_W2 = IT_END_W1 + 8 * IT_W2, IT_END_CIN = IT_END_W2 + 2 * IT_CIN, IT_END_COUT = IT_END_CIN + 2 * IT_SQ, IT_END_WQ = IT_END_COUT + 2 * IT_SQ,
              IT_END_WO = IT_END_WQ + 2 * IT_SQ, IT_TOTAL = IT_END_WO + IT_KV;
constexpr int CGO_W1 = 0, CGO_CIN = 8 * FF2, CGO_WQ = CGO_CIN + 2 * 3 * D, CGO_KV = CGO_WQ + 2 * D;
static_assert(CGO_KV + 2 * D == NCGCB, "cg/cb map");
template <int MODE> __device__ __forceinline__ void prologue_item(f32x4 (&v)[12], Frame& F, const float* ln_g, const float* ln_b, const float* w_in, const float* w_out, const float* cw_in, const float* cw_out, const float* wq, const float* wo, const float* wkv, int it, LAS float* scr, bool do_atomics = true) {
    const float* W; bf16_t* WT; int K, Nsrc, nb, kb, srccol0, dstrow0; int lnq = -1, cgo = 0;
    if (it < IT_END_W1) { const int j = it / IT_W1, r = it % IT_W1; K = D; Nsrc = FF2; W = w_in + (size_t)j * D * FF2; WT = (bf16_t*)(F.ws + WS_W1T + (size_t)j * W1T_BYTES);
        nb = r / (D / 64); kb = r % (D / 64); dstrow0 = 32 * nb; const int pn = dstrow0 >> 8, c = dstrow0 & 255; srccol0 = (c < 128) ? (128 * pn + c) : (FF + 128 * pn + (c - 128));
        const int l = j >> 1; lnq = (j & 1) ? (3 * l + 1) : (3 * l - 1); cgo = CGO_W1 + j * FF2; }
    else if (it < IT_END_W2) { const int q = it - IT_END_W1, j = q / IT_W2, r = q % IT_W2; K = FF; Nsrc = D; W = w_out + (size_t)j * FF * D; WT = (bf16_t*)(F.ws + WS_W2T + (size_t)j * W2T_BYTES);
        nb = r / (FF / 64); kb = r % (FF / 64); dstrow0 = 32 * nb; srccol0 = dstrow0; }
    else if (it < IT_END_CIN) { const int q = it - IT_END_W2, j = q / IT_CIN, r = q % IT_CIN; K = D; Nsrc = 3 * D; W = cw_in + (size_t)j * D * 3 * D; WT = (bf16_t*)(F.ws + WS_WCIN + (size_t)j * WCIN_BYTES);
        nb = r / (D / 64); kb = r % (D / 64); dstrow0 = 32 * nb; const int pn = dstrow0 >> 8, c = dstrow0 & 255;
        srccol0 = (pn < 16) ? ((c < 128) ? (D + 128 * pn + c) : (2 * D + 128 * pn + (c - 128))) : (256 * (pn - 16) + c); lnq = 3 * j; cgo = CGO_CIN + j * 3 * D; }
    else if (it < IT_END_WO) { const int q = it - IT_END_CIN, j = q / IT_SQ, r = q % IT_SQ; K = D; Nsrc = D;
        const float* src = (j < 2) ? cw_out : (j < 4) ? wq : wo; const size_t wsoff = (j < 2) ? WS_WCOUT : (j < 4) ? WS_WQ : WS_WO; const int l = j & 1;
        W = src + (size_t)l * D * D; WT = (bf16_t*)(F.ws + wsoff + (size_t)l * SQ_BYTES);
        nb = r / (D / 64); kb = r % (D / 64); dstrow0 = 32 * nb; srccol0 = dstrow0; if (j == 2 || j == 3) { lnq = 3 * (NCONV + l); cgo = CGO_WQ + l * D; } }
    else { const int r = it - IT_END_WO; K = D; Nsrc = 2 * D; W = wkv; WT = (bf16_t*)(F.ws + WS_WKV); nb = r / (D / 64); kb = r % (D / 64); dstrow0 = 32 * nb; srccol0 = dstrow0; lnq = 3 * (NCONV - 1) + 2; cgo = CGO_KV; }
    const float* gk = (lnq >= 0) ? ln_g + (size_t)lnq * D : nullptr; const float* bk = (lnq >= 0) ? ln_b + (size_t)lnq * D : nullptr;
    transpose_item<MODE>(v, W, K, Nsrc, srccol0, WT, dstrow0, 64 * kb, scr, F.lane, gk, bk, (float*)(F.ws + WS_CG) + cgo, (float*)(F.ws + WS_CB) + cgo, do_atomics);
}
__device__ __forceinline__ void p0_prologue(Frame& F, const float* x, const float* meta, const float* ln_g, const float* ln_b, const float* w_in, const float* w_out, const float* cw_in, const float* cw_out, const float* wq, const float* wo, const float* wkv) {
    LAS float* scr = (LAS float*)(F.lds + RING_OFF + F.wave * 16384);
    {
        f32x4 va[12], vb[12]; const int st = F.ngw; int it = F.gw;
        if (it < IT_TOTAL) prologue_item<0>(va, F, ln_g, ln_b, w_in, w_out, cw_in, cw_out, wq, wo, wkv, it, scr);
        for (; it < IT_TOTAL; it += 2 * st) {
            const bool hb = it + st < IT_TOTAL;
            if (hb) prologue_item<0>(vb, F, ln_g, ln_b, w_in, w_out, cw_in, cw_out, wq, wo, wkv, it + st, scr);
            prologue_item<1>(va, F, ln_g, ln_b, w_in, w_out, cw_in, cw_out, wq, wo, wkv, it, scr);
            if (hb) { if (it + 2 * st < IT_TOTAL) prologue_item<0>(va, F, ln_g, ln_b, w_in, w_out, cw_in, cw_out, wq, wo, wkv, it + 2 * st, scr);
                      prologue_item<1>(vb, F, ln_g, ln_b, w_in, w_out, cw_in, cw_out, wq, wo, wkv, it + st, scr); }
        }
    }
#if EXP_KIND == 4
    { f32x4 vd[12]; for (int it = F.gw; it < IT_TOTAL; it += F.ngw) prologue_item<2>(vd, F, ln_g, ln_b, w_in, w_out, cw_in, cw_out, wq, wo, wkv, it, scr, false); }
#endif
    bf16_t* HBp = (bf16_t*)(F.ws + WS_HB);
    for (int row = F.gw; row < MROWS; row += 2 * F.ngw) {
        const int rowb = (row + F.ngw < MROWS) ? row + F.ngw : row; f32x4 v[2][8];
#pragma unroll
        for (int r = 0; r < 2; ++r) { const int rr = r ? rowb : row; const float* src = (rr < MREAL) ? x + (size_t)rr * D : meta + (size_t)(rr - MREAL) * D;
#pragma unroll
            for (int j = 0; j < 8; ++j) v[r][j] = *(const f32x4*)(src + 4 * F.lane + 256 * j); }
        asm volatile("" ::: "memory");
#pragma unroll
        for (int r = 0; r < 2; ++r) { const int rr = r ? rowb : row;
#pragma unroll
            for (int j = 0; j < 8; ++j) *(u32x2*)(HBp + (size_t)rr * D + 4 * F.lane + 256 * j) = pk4(v[r][j]); }
    }
    { float* st0 = (float*)(F.ws + WS_STATS); float* lng = (float*)(F.ws + WS_LNG); float* lnb = (float*)(F.ws + WS_LNB);
      for (int i = F.gw * 64 + F.lane; i < MROWS; i += F.ngw * 64) { st0[2 * i] = 0.f; st0[2 * i + 1] = (float)D * (1.0f - LN_EPS); }
      for (int i = F.gw * 64 + F.lane; i < 13 * D; i += F.ngw * 64) { lng[i] = (i < D) ? 1.0f : ln_g[i - D]; lnb[i] = (i < D) ? 0.0f : ln_b[i - D]; } }
    bf16_t* KB = (bf16_t*)(F.ws + WS_KB); bf16_t* VT = (bf16_t*)(F.ws + WS_VT);
    for (int bh = F.gw; bh < NB * NH; bh += F.ngw) {
        for (int i = F.lane; i < 16 * HD / 8; i += 64) *(u32x4*)(KB + (size_t)bh * TS * HD + 8 * i) = (u32x4){0u, 0u, 0u, 0u};
        for (int i = F.lane; i < HD * 2; i += 64) *(u32x4*)(VT + ((size_t)bh * HD + (i >> 1)) * TS + 8 * (i & 1)) = (u32x4){0u, 0u, 0u, 0u};
    }
}

__device__ __forceinline__ void final_ln_phase(Frame& F, const float* stats, const float* gain, const float* bias, float* out) {
    const bf16_t* Hb = (const bf16_t*)(F.ws + WS_HB);
    f32x4 g[4][2], bb[4][2];
#pragma unroll
    for (int j = 0; j < 4; ++j)
#pragma unroll
        for (int h = 0; h < 2; ++h) { g[j][h] = *(const f32x4*)(gain + 8 * F.lane + 512 * j + 4 * h); bb[j][h] = *(const f32x4*)(bias + 8 * F.lane + 512 * j + 4 * h); }
    for (int row = F.gw; row < MREAL; row += 2 * F.ngw) {
        const int rowb = (row + F.ngw < MREAL) ? row + F.ngw : row;
        float rs[2], ts[2]; u32x4 w[2][4];
#pragma unroll
        for (int r = 0; r < 2; ++r) { const int rr = r ? rowb : row; row_norm(stats, rr, rs[r], ts[r]); const bf16_t* xr = Hb + (size_t)rr * D + 8 * F.lane;
#pragma unroll
            for (int j = 0; j < 4; ++j) w[r][j] = *(const u32x4*)(xr + 512 * j); }
        asm volatile("" ::: "memory");
#pragma unroll
        for (int r = 0; r < 2; ++r) { const int rr = r ? rowb : row; float* o = out + (size_t)rr * D + 8 * F.lane; const float rstd = rs[r], t = ts[r];
#pragma unroll
            for (int j = 0; j < 4; ++j) { const u32x4 ww = w[r][j];
                const f32x4 v0 = {bf_lo(ww.x), bf_hi(ww.x), bf_lo(ww.y), bf_hi(ww.y)}, v1 = {bf_lo(ww.z), bf_hi(ww.z), bf_lo(ww.w), bf_hi(ww.w)};
                *(f32x4*)(o + 512 * j) = (v0 * rstd + t) * g[j][0] + bb[j][0]; *(f32x4*)(o + 512 * j + 4) = (v1 * rstd + t) * g[j][1] + bb[j][1]; } }
    }
}

__device__ __forceinline__ void unpack8(u32x4 w, float (&f)[8]) { f[0] = bf_lo(w.x); f[1] = bf_hi(w.x); f[2] = bf_lo(w.y); f[3] = bf_hi(w.y); f[4] = bf_lo(w.z); f[5] = bf_hi(w.z); f[6] = bf_lo(w.w); f[7] = bf_hi(w.w); }
__device__ __forceinline__ void conv_phase(Frame& F, const float* cw, const float* cb) {
    const bf16_t* V = (const bf16_t*)(F.ws + WS_ACT); const bf16_t* BG = (const bf16_t*)(F.ws + WS_ACT + ACT_SUB); bf16_t* GG = (bf16_t*)(F.ws + WS_ACT + 2 * ACT_SUB);
    for (int row = F.gw; row < MROWS; row += F.ngw) {
        const bf16_t* cur = V + (size_t)row * D; const bf16_t* p1 = cur; const bf16_t* p2 = cur; float m1 = 1.f, m2 = 1.f;
        if (row < MREAL) { const int t = row & (SEQ - 1);
            if (t >= 2) { p1 = cur - D; p2 = cur - 2 * D; }
            else if (t == 1) { p1 = cur - D; p2 = V + (size_t)(MREAL + 15) * D; }
            else { p1 = V + (size_t)(MREAL + 15) * D; p2 = V + (size_t)(MREAL + 14) * D; }
        } else { const int i = row - MREAL; if (i >= 1) p1 = cur - D; else m1 = 0.f; if (i >= 2) p2 = cur - 2 * D; else m2 = 0.f; }
#pragma unroll
        for (int j = 0; j < 4; ++j) { const int c0 = 8 * (F.lane + 64 * j);
            float a[8], b1[8], b2[8], bg[8];
            unpack8(*(const u32x4*)(cur + c0), a); unpack8(*(const u32x4*)(p1 + c0), b1); unpack8(*(const u32x4*)(p2 + c0), b2); unpack8(*(const u32x4*)(BG + (size_t)row * D + c0), bg);
            float o[8];
#pragma unroll
            for (int h = 0; h < 2; ++h) { const f32x4 w0 = *(const f32x4*)(cw + c0 + 4 * h), w1 = *(const f32x4*)(cw + D + c0 + 4 * h), w2 = *(const f32x4*)(cw + 2 * D + c0 + 4 * h), bbv = *(const f32x4*)(cb + c0 + 4 * h);
#pragma unroll
                for (int e = 0; e < 4; ++e) o[4 * h + e] = bg[4 * h + e] * (w0[e] * (b2[4 * h + e] * m2) + w1[e] * (b1[4 * h + e] * m1) + w2[e] * a[4 * h + e] + bbv[e]); }
            *(u32x4*)(GG + (size_t)row * D + c0) = (u32x4){pk2(o[0], o[1]), pk2(o[2], o[3]), pk2(o[4], o[5]), pk2(o[6], o[7])};
        }
    }
}

#ifndef ATTN_EARLY_EXIT
#define ATTN_EARLY_EXIT 1
#endif
__device__ __forceinline__ void attn_unit(Frame& F, const bf16_t* Qb, bf16_t* Ob, const bf16_t* KB, const bf16_t* VT, int b, int h, int qi) {
    const int lane = F.lane, ql = lane & 31, hh = lane >> 5;
    const bool qvalid = (qi > 0) || (ql >= 16);
    const int qrow = (qi > 0) ? (b * SEQ + 32 * (qi - 1) + ql) : (MREAL + (qvalid ? ql - 16 : 0));
    const bf16_t* qp = Qb + (size_t)qrow * D + h * HD + 8 * hh;
    bf16x8 qf[8];
#pragma unroll
    for (int s = 0; s < 8; ++s) qf[s] = *(const bf16x8*)(qp + 16 * s);
    const bf16_t* kbase = KB + (size_t)(b * NH + h) * TS * HD + (size_t)ql * HD + 8 * hh;
    const bf16_t* vbase = VT + ((size_t)(b * NH + h) * HD + ql) * TS + 8 * hh;
    f32x16 oacc[4];
#pragma unroll
    for (int i = 0; i < 4; ++i)
#pragma unroll
        for (int r = 0; r < 16; ++r) oacc[i][r] = 0.f;
    float C = qvalid ? 0.f : -1e30f;
    const int qs = 32 * qi + ql;
    bf16x8 kf[8]; u32x4 vf[4][2];
#define ATT_LOADK(kt_) do { const bf16_t* kp_ = kbase + (size_t)(32 * (kt_)) * HD; _Pragma("unroll") for (int s = 0; s < 8; ++s) kf[s] = *(const bf16x8*)(kp_ + 16 * s); } while (0)
#define ATT_LOADV(kt_) do { const bf16_t* vp_ = vbase + 32 * (kt_); _Pragma("unroll") for (int blk = 0; blk < 4; ++blk) _Pragma("unroll") for (int s2 = 0; s2 < 2; ++s2) { \
        vf[blk][s2] = *(const u32x4*)(vp_ + (size_t)(32 * blk) * TS + 16 * s2); } } while (0)
    ATT_LOADK(qi); ATT_LOADV(qi);
    for (int kt = qi; kt >= 0; --kt) {
        f32x16 z;
#pragma unroll
        for (int r = 0; r < 16; ++r) z[r] = 0.f;
#pragma unroll
        for (int s = 0; s < 8; ++s) z = __builtin_amdgcn_mfma_f32_32x32x16_f16(__builtin_bit_cast(h8_t, kf[s]), __builtin_bit_cast(h8_t, qf[s]), z, 0, 0, 0);
        if (kt > 0) ATT_LOADK(kt - 1);
        float lk[16]; float TT;
        const bool edge = (kt == qi) || (kt == 0);
#pragma unroll
        for (int r = 0; r < 16; ++r) { const float zz = z[r], sp = fmaxf(zz, 0.f) + __builtin_amdgcn_logf(1.f + __builtin_amdgcn_exp2f(-fabsf(zz))); z[r] = zz - sp; lk[r] = -sp; }
        if (edge) {
#pragma unroll
            for (int r = 0; r < 16; ++r) { const int ks = 32 * kt + (r & 3) + 8 * (r >> 2) + 4 * hh; const bool vld = (ks < qs) && (ks >= 16); lk[r] = vld ? lk[r] : 0.f; z[r] = vld ? z[r] : -1e30f; }
        }
        float G[4], PG[4];
#pragma unroll
        for (int g = 0; g < 4; ++g) { G[g] = (lk[4 * g] + lk[4 * g + 1]) + (lk[4 * g + 2] + lk[4 * g + 3]); PG[g] = __shfl_xor(G[g], 32); }
        float suf[4]; suf[3] = 0.f; suf[2] = G[3] + PG[3]; suf[1] = suf[2] + (G[2] + PG[2]); suf[0] = suf[1] + (G[1] + PG[1]);
        TT = suf[0] + (G[0] + PG[0]);
#pragma unroll
        for (int g = 0; g < 4; ++g) { const float base = C + suf[g] + (hh == 0 ? PG[g] : 0.f);
            const float s2 = lk[4 * g + 3], s1 = s2 + lk[4 * g + 2], s0 = s1 + lk[4 * g + 1];
            z[4 * g + 0] = __builtin_amdgcn_exp2f(z[4 * g + 0] + (base + s0)); z[4 * g + 1] = __builtin_amdgcn_exp2f(z[4 * g + 1] + (base + s1));
            z[4 * g + 2] = __builtin_amdgcn_exp2f(z[4 * g + 2] + (base + s2)); z[4 * g + 3] = __builtin_amdgcn_exp2f(z[4 * g + 3] + base); }
#define a z
        C += TT;
        bf16x8 pf[2];
#pragma unroll
        for (int s2 = 0; s2 < 2; ++s2) { const u32x4 w = {pk2(a[8 * s2], a[8 * s2 + 1]), pk2(a[8 * s2 + 2], a[8 * s2 + 3]), pk2(a[8 * s2 + 4], a[8 * s2 + 5]), pk2(a[8 * s2 + 6], a[8 * s2 + 7])}; pf[s2] = __builtin_bit_cast(bf16x8, w); }
#undef a
#pragma unroll
        for (int blk = 0; blk < 4; ++blk)
#pragma unroll
            for (int s2 = 0; s2 < 2; ++s2) oacc[blk] = __builtin_amdgcn_mfma_f32_32x32x16_f16(__builtin_bit_cast(h8_t, vf[blk][s2]), __builtin_bit_cast(h8_t, pf[s2]), oacc[blk], 0, 0, 0);
#if ATTN_EARLY_EXIT
        if (__all(C < -151.0f)) break;
#endif
        if (kt > 0) ATT_LOADV(kt - 1);
    }
#undef ATT_LOADK
#undef ATT_LOADV
    if (qvalid) { bf16_t* op = Ob + (size_t)qrow * D + h * HD + 4 * hh;
#pragma unroll
        for (int blk = 0; blk < 4; ++blk)
#pragma unroll
            for (int g = 0; g < 4; ++g) *(u32x2*)(op + 32 * blk + 8 * g) = pk4((f32x4){oacc[blk][4 * g], oacc[blk][4 * g + 1], oacc[blk][4 * g + 2], oacc[blk][4 * g + 3]}); }
}
__device__ __forceinline__ void attn_phase(Frame& F) {
    const bf16_t* Qb = (const bf16_t*)(F.ws + WS_ACT); bf16_t* Ob = (bf16_t*)(F.ws + WS_ACT + ACT_SUB);
    const bf16_t* KB = (const bf16_t*)(F.ws + WS_KB); const bf16_t* VT = (const bf16_t*)(F.ws + WS_VT);
    int k = 0;
    for (int u = F.gw; u < NB * NH * 64; u += F.ngw, ++k) {
        F.lane = lane_id();
        const int bh = u >> 6, q0 = u & 63, qi = (k & 1) ? (64 - q0) : (1 + q0); attn_unit(F, Qb, Ob, KB, VT, bh >> 4, bh & 15, qi);
    }
}

struct Args { const float* in[13]; float* out; unsigned char* ws; };
__global__ void __launch_bounds__(NWAVES * 64, 2) yoco_fwd(Args args) {
    extern __shared__ __attribute__((aligned(16))) unsigned char lds[];
    Frame F;
    F.lds = (LAS unsigned char*)lds;
    F.tid = threadIdx.x; F.lane = F.tid & 63; F.wave = __builtin_amdgcn_readfirstlane(F.tid >> 6);
    F.G = gridDim.x; { const int bx = blockIdx.x; F.vcu = (F.G % 8 == 0) ? (bx % 8) * (F.G / 8) + bx / 8 : bx; }
    F.gw = F.vcu * NWAVES + F.wave; F.ngw = F.G * NWAVES;
    F.ws = args.ws;
    for (int u = F.tid; u < (LDS_BYTES - LDSCTL_OFF) / 4; u += NWAVES * 64) ((LAS unsigned*)(F.lds + LDSCTL_OFF))[u] = 0u;
    __syncthreads();
    unsigned* ctl = (unsigned*)(F.ws + WS_CTL);
    XcdBarrier bar = xcd_barrier_post(ctl + CW_BAR, (volatile LAS unsigned*)(F.lds + MISC_OFF) + 8);
#if PROBE
#define prof ((unsigned long long*)(F.ws + WS_CTL + 65536))
    if (blockIdx.x == 0 && threadIdx.x == 0) prof[31] = __builtin_amdgcn_s_memrealtime();
#define PACC(slot) do { if (blockIdx.x == 0 && threadIdx.x == 0) { const unsigned long long n_ = __builtin_amdgcn_s_memrealtime(); prof[slot] += n_ - prof[31]; prof[31] = n_; } } while (0)
#else
#define PACC(slot) do { } while (0)
#endif
#if EXP_KIND == 7
#define GRID_BAR() do { xcd_barrier(bar, F.wave); xcd_barrier(bar, F.wave); PHASE_BEGIN(); PACC(3); } while (0)
#else
#define GRID_BAR() do { xcd_barrier(bar, F.wave); PHASE_BEGIN(); PACC(3); } while (0)
#endif
#define PHASE_BEGIN() do { const int l_ = lane_id(); F.lane = l_; F.tid = F.wave * 64 + l_; F.gw = F.vcu * NWAVES + F.wave; \
        unsigned long long w_ = (unsigned long long)args.ws; asm volatile("" : "+s"(w_)); F.ws = (unsigned char*)(GAS unsigned char*)w_; } while (0)
#define HB ((bf16_t*)(F.ws + WS_HB))
#define ACT ((bf16_t*)(F.ws + WS_ACT))

#define STATS(q) ((float*)(F.ws + WS_STATS + (size_t)(q) * STATS_BYTES))
#define CGV(o) ((const float*)(F.ws + WS_CG) + (o))
#define CBV(o) ((const float*)(F.ws + WS_CB) + (o))
    PHASE_BEGIN();
    p0_prologue(F, args.in[0], args.in[1], args.in[2], args.in[3], args.in[4], args.in[5], args.in[6], args.in[9], args.in[10], args.in[12], args.in[11]);
    PACC(2); GRID_BAR();

    for (int l = 0; l < DEPTH; ++l) {
        for (int s = 0; s < 2; ++s) {
            const int qin = (s == 1) ? (1 + 3 * l + 1) : (l == 0 ? 0 : 1 + 3 * (l - 1) + 2), qout = 1 + 3 * l + (s == 0 ? 0 : 2);
            { const bf16_t* W1 = (const bf16_t*)(F.ws + WS_W1T + (size_t)(2 * l + s) * W1T_BYTES);
              pg8::Gemm g{HB, W1, MREAL, FF2, D}; pg8::StaticOrder S; S.init(MREAL, FF2, F.G, (int)blockIdx.x);
              EpiSwiglu E{F.ws, LnFold{qin, CGO_W1 + (2 * l + s) * FF2}, F.G == 256};
#if PROBE && PROBE_A == 16
              pg8::gemm_phase<EpiSwiglu, pg8::StaticOrder, true, GEMM_SP, true>(F.lds + RING_OFF, g, S, E, (l == 0 && s == 0) ? prof + 16 : prof + 24);
#else
#if EXP_KIND == 12
              { RangeOrder R; R.init(MREAL, FF2, F.G, (int)blockIdx.x); int nrep = 2; asm volatile("" : "+s"(nrep));
                for (int rep = 0; rep < nrep; ++rep) { R.r0 = rep ? 5 : 0; R.r1 = rep ? 11 : 5; pg8::gemm_phase<EpiSwiglu, RangeOrder, true, GEMM_SP>(F.lds + RING_OFF, g, R, E); if (rep == 0) GRID_BAR(); } }
#else
#if EXP_UP_TWICE
              int nrep = 2; asm volatile("" : "+s"(nrep)); for (int rep = 0; rep < nrep; ++rep)
#endif
              pg8::gemm_phase<EpiSwiglu, pg8::StaticOrder, true, GEMM_SP, false, EXP_EPI_TWICE != 0>(F.lds + RING_OFF, g, S, E);
#endif
#endif
#if EXP_KIND == 1
              { EpiNull EN; pg8::gemm_phase<EpiNull, pg8::StaticOrder, true, GEMM_SP>(F.lds + RING_OFF, g, S, EN); }
#elif EXP_KIND == 25
              { EpiNull EN; pg8::Gemm gc{HB, (const bf16_t*)(F.ws + WS_W1T + (size_t)((2 * l + s + 4) & 7) * W1T_BYTES), MREAL, FF2, D}; pg8::gemm_phase<EpiNull, pg8::StaticOrder, true, GEMM_SP>(F.lds + RING_OFF, gc, S, EN); }
#elif EXP_KIND == 2
              { EpiNull EN; FakeOrder FO; FO.nun = 11; pg8::gemm_phase<EpiNull, FakeOrder, true, GEMM_SP>(F.lds + RING_OFF, g, FO, EN); }
#elif EXP_KIND == 21 || EXP_KIND == 22 || EXP_KIND == 23 || EXP_KIND == 24
              { EpiNull EN; FakeOrder FO; FO.nun = 11; pg8::gemm_phase<EpiNull, FakeOrder, true, GEMM_SP, false, false, EXP_KIND - 20>(F.lds + RING_OFF, g, FO, EN); }
#elif EXP_KIND == 3
              { EpiNull EN; pg8::gemm_phase<EpiNull, pg8::StaticOrder, true, 0>(F.lds + RING_OFF, g, S, EN); }
#endif
#if EXP_KIND == 14
              meta_gemm<true, 4>(HB + (size_t)MREAL * D, D, W1, D, FF, (int)blockIdx.x, F.G, F.wave, lane_id(), F.lds + RING_OFF, E);
#endif
              if (l < NCONV) meta_gemm<true, 4>(HB + (size_t)MREAL * D, D, W1, D, FF, (int)blockIdx.x, F.G, F.wave, lane_id(), F.lds + RING_OFF, E); }
            PACC(4); GRID_BAR();
            { const bf16_t* W2 = (const bf16_t*)(F.ws + WS_W2T + (size_t)(2 * l + s) * W2T_BYTES);
              pg8::Gemm g{ACT, W2, MREAL, D, FF}; pg8::StaticOrder S; S.init(MREAL, D, F.G, (int)blockIdx.x);
              EpiResidLN E{F.ws, qin, qout, 0.5f};
#if PROBE && PROBE_A == 18
              pg8::gemm_phase<EpiResidLN, pg8::StaticOrder, true, GEMM_SP, true>(F.lds + RING_OFF, g, S, E, (l == 0 && s == 0) ? prof + 18 : prof + 26);
#else
              pg8::gemm_phase<EpiResidLN, pg8::StaticOrder, true, GEMM_SP>(F.lds + RING_OFF, g, S, E);
#if EXP_KIND == 9
              { EpiNull EN; pg8::gemm_phase<EpiNull, pg8::StaticOrder, true, GEMM_SP>(F.lds + RING_OFF, g, S, EN); }
#elif EXP_KIND == 11
              { EpiResidLN ED{F.ws, qin, 13, 0.5f}; pg8::gemm_phase<EpiResidLN, pg8::StaticOrder, true, GEMM_SP>(F.lds + RING_OFF, g, S, ED); }
#endif
#endif
              if (l < NCONV) meta_gemm<false, 8>(ACT + (size_t)MREAL * FF, FF, W2, FF, D, (int)blockIdx.x, F.G, F.wave, lane_id(), F.lds + RING_OFF, E); }
            PACC(5); GRID_BAR();
            if (s == 0) {
                const int q0 = 1 + 3 * l, q1 = q0 + 1;
                if (l < NCONV) {
                    { const bf16_t* Wc = (const bf16_t*)(F.ws + WS_WCIN + (size_t)l * WCIN_BYTES);
                      pg8::Gemm g{HB, Wc, MREAL, 3 * D, D}; pg8::StaticOrder S; S.init(MREAL, 3 * D, F.G, (int)blockIdx.x);
                      const LnFold L{q0, CGO_CIN + l * 3 * D};
                      EpiConvIn E{F.ws, L, F.G == 256};
#if EXP_KIND == 13
                      int nrep = 2; asm volatile("" : "+s"(nrep)); for (int rep = 0; rep < nrep; ++rep)
#endif
                      pg8::gemm_phase<EpiConvIn, pg8::StaticOrder, true, GEMM_SP>(F.lds + RING_OFF, g, S, E);
                      MetaConvV EV{F.ws, L}; meta_gemm<true, 8>(HB + (size_t)MREAL * D, D, Wc, D, D, (int)blockIdx.x, F.G, F.wave, lane_id(), F.lds + RING_OFF, EV);
                      EpiBf16S EB{F.ws, WS_ACT + ACT_SUB, 1.0f, LnFold{q0, CGO_CIN + l * 3 * D + 2 * D}};
                      meta_gemm<false, 8>(HB + (size_t)MREAL * D, D, Wc + (size_t)(2 * D) * D, D, D, (int)blockIdx.x, F.G, F.wave, lane_id(), F.lds + RING_OFF, EB); }
                    PACC(6); GRID_BAR();
                    conv_phase(F, args.in[7] + (size_t)l * 3 * D, args.in[8] + (size_t)l * D);
#if EXP_KIND == 6
                    conv_phase(F, args.in[7] + (size_t)l * 3 * D, args.in[8] + (size_t)l * D);
#endif
                    PACC(7); GRID_BAR();
                    { const bf16_t* Wo = (const bf16_t*)(F.ws + WS_WCOUT + (size_t)l * SQ_BYTES); const bf16_t* GG = (const bf16_t*)(F.ws + WS_ACT + 2 * ACT_SUB);
                      pg8::Gemm g{GG, Wo, MREAL, D, D}; pg8::StaticOrder S; S.init(MREAL, D, F.G, (int)blockIdx.x);
                      EpiResidLN E{F.ws, q0, q1, 1.0f};
                      pg8::gemm_phase<EpiResidLN, pg8::StaticOrder, true, GEMM_SP>(F.lds + RING_OFF, g, S, E);
                      meta_gemm<false, 8>(GG + (size_t)MREAL * D, D, Wo, D, D, (int)blockIdx.x, F.G, F.wave, lane_id(), F.lds + RING_OFF, E); }
                } else {
                    const int j = l - NCONV;
                    { const bf16_t* Wq = (const bf16_t*)(F.ws + WS_WQ + (size_t)j * SQ_BYTES);
                      pg8::Gemm g{HB, Wq, MREAL, D, D}; pg8::StaticOrder S; S.init(MREAL, D, F.G, (int)blockIdx.x);
                      EpiBf16S E{F.ws, WS_ACT, QSCALE, LnFold{q0, CGO_WQ + j * D}, F.G == 256};
#if EXP_KIND == 10
                      int nrep = 2; asm volatile("" : "+s"(nrep)); for (int rep = 0; rep < nrep; ++rep)
#endif
                      pg8::gemm_phase<EpiBf16S, pg8::StaticOrder, true, GEMM_SP>(F.lds + RING_OFF, g, S, E);
                    }
                    PACC(9); GRID_BAR();
                    attn_phase(F);
#if EXP_KIND == 5
                    attn_phase(F);
#endif
                    PACC(10); GRID_BAR();
                    { const bf16_t* Wo = (const bf16_t*)(F.ws + WS_WO + (size_t)j * SQ_BYTES); const bf16_t* Ob = (const bf16_t*)(F.ws + WS_ACT + ACT_SUB);
                      pg8::Gemm g{Ob, Wo, MREAL, D, D}; pg8::StaticOrder S; S.init(MREAL, D, F.G, (int)blockIdx.x);
                      EpiResidLN E{F.ws, q0, q1, 1.0f};
                      pg8::gemm_phase<EpiResidLN, pg8::StaticOrder, true, GEMM_SP>(F.lds + RING_OFF, g, S, E);
                    }
                }
                PACC(8); GRID_BAR();
            }
        }
        if (l == NCONV - 1) {
            const bf16_t* Wkv = (const bf16_t*)(F.ws + WS_WKV); const int q = 1 + 3 * l + 2;
            pg8::Gemm g{HB, Wkv, MREAL, 2 * D, D}; pg8::StaticOrder S; S.init(MREAL, 2 * D, F.G, (int)blockIdx.x);
            EpiKV E{F.ws, LnFold{q, CGO_KV}};
#if EXP_KIND == 8
            int nrep = 2; asm volatile("" : "+s"(nrep)); for (int rep = 0; rep < nrep; ++rep)
#endif
            pg8::gemm_phase<EpiKV, pg8::StaticOrder, true, GEMM_SP>(F.lds + RING_OFF, g, S, E);
            meta_gemm<false, 8>(HB + (size_t)MREAL * D, D, Wkv, D, 2 * D, (int)blockIdx.x, F.G, F.wave, lane_id(), F.lds + RING_OFF, E);
            PACC(12); GRID_BAR();
        }
    }
    final_ln_phase(F, (const float*)(F.ws + WS_STATS + (size_t)(1 + 3 * (DEPTH - 1) + 2) * STATS_BYTES), args.in[2] + (size_t)(3 * (DEPTH - 1) + 2) * D, args.in[3] + (size_t)(3 * (DEPTH - 1) + 2) * D, args.out);
#if PROBE
    PACC(13); GRID_BAR();
    if (blockIdx.x == 0) {
        const float a_us = (float)prof[PROBE_A] * 0.01f, b_us = (float)prof[PROBE_B] * 0.01f;
        if (threadIdx.x == 0) args.out[0] += 100.f * a_us;
        for (int i = 1 + (int)threadIdx.x; i <= 4194304; i += 512) args.out[i] += b_us;
    }
#endif
}

extern "C" void kernel_launch(void* const* d_in, const int* in_sizes, int n_in, void* d_out, int out_size, void* d_ws, size_t ws_size, hipStream_t stream) {
    static int grid = 0;
    if (grid == 0) {
        if (n_in != 13 || in_sizes[0] != MREAL * D || out_size != MREAL * D || ws_size < WS_END) { fprintf(stderr, "kernel_launch: unexpected shapes (n_in %d, in0 %d, out %d, ws %zu)\n", n_in, n_in > 0 ? in_sizes[0] : -1, out_size, ws_size); grid = -1; return; }
        int dev = 0, cus = 0;
        if (hipGetDevice(&dev) != hipSuccess || hipDeviceGetAttribute(&cus, hipDeviceAttributeMultiprocessorCount, dev) != hipSuccess) { grid = -1; return; }
        if (hipFuncSetAttribute((const void*)yoco_fwd, hipFuncAttributeMaxDynamicSharedMemorySize, LDS_BYTES) != hipSuccess) { fprintf(stderr, "kernel_launch: hipFuncSetAttribute failed\n"); grid = -1; return; }
        int per_cu = 0;
        if (hipOccupancyMaxActiveBlocksPerMultiprocessor(&per_cu, (const void*)yoco_fwd, NWAVES * 64, LDS_BYTES) != hipSuccess || per_cu < 1) fprintf(stderr, "kernel_launch: occupancy query says %d\n", per_cu);
        (void)hipGetLastError();
        grid = cus;
    }
    if (grid < 0) return;
    if (hipMemsetAsync((char*)d_ws + WS_CTL, 0, CTL_ZERO_BYTES, stream) != hipSuccess) return;
    Args a{};
    for (int i = 0; i < 13; ++i) a.in[i] = (const float*)d_in[i];
    a.out = (float*)d_out; a.ws = (unsigned char*)d_ws;
    hipLaunchKernelGGL(yoco_fwd, dim3(grid), dim3(NWAVES * 64), LDS_BYTES, stream, a);
}
```

```cpp
#include <hip/hip_runtime.h>
#include <cstdio>
#include <cstdint>
#ifndef PROBE
#define PROBE 0
#endif
#define PROBE_A 0
#define PROBE_B 1
#ifndef XCD_COL_ROT
#define XCD_COL_ROT 1
#endif
#ifndef K_SERPENTINE
#define K_SERPENTINE 1
#endif
#ifndef EXP_UP_TWICE
#define EXP_UP_TWICE 0
#endif
#ifndef PRIO_MODE
#define PRIO_MODE 1
#endif
#ifndef GEMM_SP
#define GEMM_SP 1
#endif
#ifndef EXP_KIND
#define EXP_KIND 0
#endif
#ifndef EXP_EPI_TWICE
#define EXP_EPI_TWICE 0
#endif

constexpr int D = 2048, NB = 8, SEQ = 2048, NMETA = 16, NH = 16, HD = 128, FF = 5632, FF2 = 11264, DEPTH = 4, NCONV = 2;
constexpr int MREAL = NB * SEQ;
constexpr int MROWS = MREAL + NMETA;
constexpr int MCAP = 16640;
constexpr int TS = 2080;
constexpr float ALPHA = 1.6817928305074290f, LN_EPS = 1e-5f, QSCALE = 0.08838834764831845f * 1.4426950408889634f;

constexpr size_t MiB = 1u << 20;
constexpr size_t WS_CTL = 0, CTL_ZERO_BYTES = 5 * MiB;
constexpr size_t WS_STATS = 1 * MiB, STATS_BYTES = 160 * 1024;
constexpr size_t WS_CG = 3 * MiB + 256 * 1024;
constexpr int NCGCB = 8 * 11264 + 2 * 6144 + 2 * 2048 + 4096;
constexpr size_t WS_CB = WS_CG + (size_t)NCGCB * 4;
static_assert(WS_CB + (size_t)NCGCB * 4 <= CTL_ZERO_BYTES && WS_STATS + 13 * STATS_BYTES <= WS_CG, "zeroed region map");
constexpr size_t WS_LNG = 5 * MiB, WS_LNB = 5 * MiB + 512 * 1024;
constexpr size_t WS_W1T = 6 * MiB, W1T_BYTES = 44 * MiB;
constexpr size_t WS_W2T = WS_W1T + 8 * W1T_BYTES, W2T_BYTES = 22 * MiB;
constexpr size_t WS_WCIN = WS_W2T + 8 * W2T_BYTES, WCIN_BYTES = 24 * MiB;
constexpr size_t SQ_BYTES = 8 * MiB;
constexpr size_t WS_WCOUT = WS_WCIN + 2 * WCIN_BYTES;
constexpr size_t WS_WQ = WS_WCOUT + 2 * SQ_BYTES;
constexpr size_t WS_WO = WS_WQ + 2 * SQ_BYTES;
constexpr size_t WS_WKV = WS_WO + 2 * SQ_BYTES;
constexpr size_t WS_HB = WS_WKV + 16 * MiB;
constexpr size_t WS_X32 = WS_HB + 65 * MiB;
constexpr size_t WS_ACT = WS_X32 + 130 * MiB;
constexpr size_t ACT_SUB = 65 * MiB;
constexpr size_t WS_KB = WS_ACT + 195 * MiB;
constexpr size_t WS_VT = WS_KB + 65 * MiB;
constexpr size_t WS_END = WS_VT + 65 * MiB;
constexpr int CW_BAR = 4096;

constexpr int RING_OFF = 0, RING_BYTES = 131072;
constexpr int LDSCTL_OFF = RING_BYTES, MISC_OFF = LDSCTL_OFF + 320;
constexpr int LDS_BYTES = 147456;
constexpr int NWAVES = 8;

#define GAS __attribute__((address_space(1)))
#define LAS __attribute__((address_space(3)))
typedef unsigned short bf16_t;
typedef short bf16x8 __attribute__((ext_vector_type(8)));
typedef short s16x4 __attribute__((ext_vector_type(4)));
typedef float f32x4 __attribute__((ext_vector_type(4)));
typedef float f32x16 __attribute__((ext_vector_type(16)));
typedef unsigned u32x4 __attribute__((ext_vector_type(4)));
typedef unsigned u32x2 __attribute__((ext_vector_type(2)));
typedef _Float16 h2_t __attribute__((ext_vector_type(2)));
typedef _Float16 h8_t __attribute__((ext_vector_type(8)));
typedef float f2_t __attribute__((ext_vector_type(2)));
__device__ __forceinline__ unsigned pk2(float lo, float hi) { f2_t v = {lo, hi}; h2_t r = __builtin_convertvector(v, h2_t); return __builtin_bit_cast(unsigned, r); }
__device__ __forceinline__ int lane_id() { int r; asm volatile("v_mbcnt_lo_u32_b32 %0, -1, 0\n\tv_mbcnt_hi_u32_b32 %0, -1, %0" : "=v"(r)); return r; }
__device__ __forceinline__ float bf_lo(unsigned w) { return (float)__builtin_bit_cast(h2_t, w)[0]; }
__device__ __forceinline__ float bf_hi(unsigned w) { return (float)__builtin_bit_cast(h2_t, w)[1]; }

namespace pg8 {
#define PG8_LAS __attribute__((address_space(3)))
constexpr int BM = 256, BK = 64, HALF = 128, HTB = HALF * BK * 2, STAGE_BYTES = 8 * HTB, NXCD = 8, WGM = 8;
__host__ __device__ __forceinline__ int lds_byte(int r, int c) { const int st = (r >> 4) * 2 + (c >> 5), rr = r & 15, cc = c & 31, ob = rr * 64 + cc * 2; return st * 1024 + (ob ^ (((ob >> 9) & 1) << 5)); }
__host__ __device__ __forceinline__ void stage_rc(int b, int& R, int& C) { const int st = b / 1024, sb = b % 1024, swz = sb ^ (((sb >> 9) & 1) << 5); R = (st >> 1) * 16 + swz / 64; C = (st & 1) * 32 + (swz % 64) / 2; }
__host__ __device__ __forceinline__ int perm32(int rho) { const int n = rho >> 4, i = rho & 15; return 8 * (i >> 2) + 4 * n + (i & 3); }
struct Unit { int pm, pn; };
struct Gemm { const bf16_t* A; const bf16_t* Bt; int M, N, K; };
struct StaticOrder {
    int nM, nN, nwg, G, c;
    __host__ __device__ void init(int M, int N, int G_, int c_) { nM = M / BM; nN = N / BM; nwg = nM * nN; G = G_; c = c_; }
    __host__ __device__ bool next(int i, Unit& u) const {
        const long L = (long)i * G + c; if (L >= nwg) return false;
        int wgid = (int)L; { const int q = nwg / NXCD, r = nwg % NXCD, xcd = wgid % NXCD, off = wgid / NXCD; wgid = (xcd < r ? xcd * (q + 1) : r * (q + 1) + (xcd - r) * q) + off; }
        const int nig = WGM * nN, gid = wgid / nig, fm = gid * WGM, gsz = (nM - fm) < WGM ? (nM - fm) : WGM;
        u.pm = fm + ((wgid % nig) % gsz); u.pn = (wgid % nig) / gsz;
#if XCD_COL_ROT
        { const int x = (int)(L % NXCD), ng = nN / 4, g = u.pn >> 2, k = (ng % 3 == 0) ? 1 : 3; u.pn = 4 * ((g * k + x) % ng) + (u.pn & 3); }
#endif
        return true;
    }
    __device__ __forceinline__ void a_ready(const Unit&) const {}
    __device__ __forceinline__ void done(const Unit&) const {}
};

template <class Epi, class Sched, bool ALIGN_EPI = false, int SP2 = 0, bool PROF = false, bool REP_EPI = false, int ABL = 0>
__device__ __forceinline__ void gemm_phase(PG8_LAS unsigned char* lds, const Gemm g, const Sched& S, const Epi& E, unsigned long long* prof = nullptr) {
    int tid_ = threadIdx.x; asm volatile("" : "+v"(tid_));
    const int tid = tid_, wid = __builtin_amdgcn_readfirstlane(tid >> 6), lane = tid & 63, wr = wid >> 2, wc = wid & 3, fr = lane & 15, fq = lane >> 4;
    const int K = g.K, nt = K / BK;
    unsigned voffA[2], voffB[2];
#pragma unroll
    for (int i = 0; i < 2; ++i) { int R, C; stage_rc(tid * 16 + i * 8192, R, C); const int Rb = Epi::PERM ? ((R & ~31) + perm32(R & 31)) : R;
        voffA[i] = (unsigned)(R * K + C) * 2u; voffB[i] = (unsigned)(Rb * K + C) * 2u; }
    const unsigned kstep = (unsigned)(BK * 2);
    const unsigned hstep = (unsigned)HALF * (unsigned)K * 2u;
    const unsigned tstep = 2u * hstep;
    const __amdgpu_buffer_rsrc_t rsA = __builtin_amdgcn_make_buffer_rsrc((void*)g.A, (short)0, 0x7ffffff0, 0x00020000);
    const __amdgpu_buffer_rsrc_t rsB = __builtin_amdgcn_make_buffer_rsrc((void*)g.Bt, (short)0, 0x7ffffff0, 0x00020000);
    const unsigned ldsw = (unsigned)wid * 1024u;
    const int aoff = lds_byte(wr * 64 + fr, fq * 8), boff = lds_byte(wc * 32 + fr, fq * 8);
#define PG8_SA(b, h) (((b) * 2 + (h)) * HTB)
#define PG8_SB(b, h) ((4 + (b) * 2 + (h)) * HTB)
#define PG8_STAGE(bufoff, rs, soff, voff) do { if constexpr (ABL != 2) _Pragma("unroll") for (int _i = 0; _i < 2; ++_i) \
        __builtin_amdgcn_raw_ptr_buffer_load_lds(rs, (PG8_LAS unsigned*)(lds + (bufoff) + ldsw + _i * 8192), 16, (voff)[_i], (soff), 0, 0); } while (0)
#define PG8_LDA(dst, b, h) do { if constexpr (ABL != 3) _Pragma("unroll") for (int m = 0; m < 4; ++m) _Pragma("unroll") for (int k = 0; k < 2; ++k) dst[m][k] = *(const PG8_LAS bf16x8*)(lds + PG8_SA(b, h) + aoff + m * 2048 + k * 1024); } while (0)
#define PG8_LDB(dst, b, h) do { if constexpr (ABL != 3) _Pragma("unroll") for (int n = 0; n < 2; ++n) _Pragma("unroll") for (int k = 0; k < 2; ++k) dst[n][k] = *(const PG8_LAS bf16x8*)(lds + PG8_SB(b, h) + boff + n * 2048 + k * 1024); } while (0)
#define PG8_MMA(ai, bj, At, Bt) do { if (PRIO_MODE == 1) __builtin_amdgcn_s_setprio(1); else if (PRIO_MODE == 2) __builtin_amdgcn_s_setprio(0); \
        if constexpr (ABL == 4) { _Pragma("unroll") for (int m = 0; m < 4; ++m) _Pragma("unroll") for (int k = 0; k < 2; ++k) \
            acc32[ai][bj][m & 1] = __builtin_amdgcn_mfma_f32_32x32x16_f16(__builtin_bit_cast(h8_t, Bt[m & 1][k]), __builtin_bit_cast(h8_t, At[m][k]), acc32[ai][bj][m & 1], 0, 0, 0); } else \
        if constexpr (ABL != 1) _Pragma("unroll") for (int m = 0; m < 4; ++m) _Pragma("unroll") for (int n = 0; n < 2; ++n) _Pragma("unroll") for (int k = 0; k < 2; ++k) \
        acc[ai][bj][m][n] = __builtin_amdgcn_mfma_f32_16x16x32_f16(__builtin_bit_cast(h8_t, Bt[n][k]), __builtin_bit_cast(h8_t, At[m][k]), acc[ai][bj][m][n], 0, 0, 0); if (PRIO_MODE == 1) __builtin_amdgcn_s_setprio(0); else if (PRIO_MODE == 2) __builtin_amdgcn_s_setprio(1); } while (0)
#define PG8_WAIT_V(n) asm volatile("s_waitcnt vmcnt(" #n ")" ::: "memory")
#define PG8_WAIT_L(n) asm volatile("s_waitcnt lgkmcnt(" #n ")" ::: "memory")
#define PG8_BAR __builtin_amdgcn_s_barrier()
#define PG8_SCHED __builtin_amdgcn_sched_barrier(0)
    Unit cur, nxt; int ui = 0;
    if (!S.next(0, cur)) return;
    if (PROF && blockIdx.x == 0 && tid == 0) prof[6] = __builtin_amdgcn_s_memrealtime();
    f32x4 acc[2][2][4][2];
#pragma unroll
    for (int a = 0; a < 2; ++a)
#pragma unroll
        for (int b = 0; b < 2; ++b)
#pragma unroll
            for (int m = 0; m < 4; ++m)
#pragma unroll
                for (int n = 0; n < 2; ++n) acc[a][b][m][n] = (f32x4){0.f, 0.f, 0.f, 0.f};
    bf16x8 At[4][2], B0[2][2], B1[2][2];
    f32x16 acc32[2][2][2];
    if constexpr (ABL == 4) { _Pragma("unroll") for (int a = 0; a < 2; ++a) _Pragma("unroll") for (int b = 0; b < 2; ++b) _Pragma("unroll") for (int c = 0; c < 2; ++c) _Pragma("unroll") for (int r = 0; r < 16; ++r) acc32[a][b][c][r] = 0.f; }
    if constexpr (ABL == 3) { _Pragma("unroll") for (int m = 0; m < 4; ++m) _Pragma("unroll") for (int k = 0; k < 2; ++k) At[m][k] = (bf16x8){0, 0, 0, 0, 0, 0, 0, 0}; _Pragma("unroll") for (int n = 0; n < 2; ++n) _Pragma("unroll") for (int k = 0; k < 2; ++k) { B0[n][k] = (bf16x8){0, 0, 0, 0, 0, 0, 0, 0}; B1[n][k] = B0[n][k]; } }
    unsigned cA = (unsigned)cur.pm * tstep, cB = (unsigned)cur.pn * tstep;
    unsigned kb = 0u, ki = kstep;
#if !K_SERPENTINE
#define PG8_FLIP(kb_, ki_) do { } while (0)
#else
#define PG8_FLIP(kb_, ki_) do { ki_ = 0u - ki_; kb_ = (kb_ == 0u) ? (unsigned)(nt - 1) * kstep : 0u; } while (0)
#endif
    if constexpr (Epi::LDSPRE) { if (E.lds_ok) E.pre_phase(lds, cur, tid, wid, lane); }
    S.a_ready(cur);
    if constexpr (SP2 == 2) {
        PG8_STAGE(PG8_SB(0, 0), rsB, cB, voffB); PG8_STAGE(PG8_SB(0, 1), rsB, cB + hstep, voffB); PG8_STAGE(PG8_SA(0, 0), rsA, cA, voffA); PG8_STAGE(PG8_SA(0, 1), rsA, cA + hstep, voffA);
        if (wr == 1) PG8_BAR;
        PG8_WAIT_V(2); PG8_BAR;
        PG8_STAGE(PG8_SB(1, 0), rsB, cB + kstep, voffB); PG8_STAGE(PG8_SB(1, 1), rsB, cB + hstep + kstep, voffB);
        PG8_WAIT_V(6); PG8_BAR;
    } else if constexpr (SP2 == 1) {
        PG8_STAGE(PG8_SB(0, 0), rsB, cB, voffB); PG8_STAGE(PG8_SB(0, 1), rsB, cB + hstep, voffB); PG8_STAGE(PG8_SA(0, 0), rsA, cA, voffA); PG8_STAGE(PG8_SA(0, 1), rsA, cA + hstep, voffA);
        if (wr == 1) PG8_BAR;
        PG8_WAIT_V(2); PG8_BAR;
        PG8_STAGE(PG8_SB(1, 0), rsB, cB + kstep, voffB); PG8_STAGE(PG8_SA(1, 0), rsA, cA + kstep, voffA); PG8_STAGE(PG8_SB(1, 1), rsB, cB + hstep + kstep, voffB);
        PG8_WAIT_V(6); PG8_BAR;
    } else {
        PG8_STAGE(PG8_SB(0, 0), rsB, cB, voffB); PG8_STAGE(PG8_SA(0, 0), rsA, cA, voffA); PG8_STAGE(PG8_SB(0, 1), rsB, cB + hstep, voffB); PG8_STAGE(PG8_SA(0, 1), rsA, cA + hstep, voffA);
        if (wr == 1) PG8_BAR;
        PG8_WAIT_V(4); PG8_BAR;
        PG8_STAGE(PG8_SB(1, 0), rsB, cB + kstep, voffB); PG8_STAGE(PG8_SA(1, 0), rsA, cA + kstep, voffA); PG8_STAGE(PG8_SB(1, 1), rsB, cB + hstep + kstep, voffB);
        PG8_WAIT_V(6); PG8_BAR;
    }
    for (;;) {
        const bool has_next = S.next(ui + 1, nxt);
        const unsigned nA = has_next ? (unsigned)nxt.pm * tstep : cA, nB = has_next ? (unsigned)nxt.pn * tstep : cB;
        unsigned nkb = kb, nki = ki; PG8_FLIP(nkb, nki);
        for (int t = 0; t < nt; t += 2) {
            const bool last = (t == nt - 2);
            const unsigned a1 = cA + kb + (unsigned)(t + 1) * ki;
            const unsigned a2 = last ? nA + nkb : cA + kb + (unsigned)(t + 2) * ki, b2 = last ? nB + nkb : cB + kb + (unsigned)(t + 2) * ki;
            const unsigned a3 = a2 + (last ? nki : ki), b3 = b2 + (last ? nki : ki);
            if (last && has_next) S.a_ready(nxt);
            if constexpr (SP2 == 2) {
            PG8_LDB(B0, 0, 0); PG8_LDB(B1, 0, 1); PG8_SCHED; PG8_LDA(At, 0, 0); PG8_STAGE(PG8_SA(1, 0), rsA, a1, voffA); PG8_STAGE(PG8_SA(1, 1), rsA, a1 + hstep, voffA);
            PG8_WAIT_V(8); PG8_WAIT_L(0); PG8_BAR; PG8_MMA(0, 0, At, B0); PG8_MMA(0, 1, At, B1); PG8_BAR; PG8_SCHED;
            PG8_LDA(At, 0, 1); PG8_STAGE(PG8_SB(0, 0), rsB, b2, voffB); PG8_STAGE(PG8_SB(0, 1), rsB, b2 + hstep, voffB);
            PG8_WAIT_V(6); PG8_WAIT_L(0); PG8_BAR; PG8_MMA(1, 0, At, B0); PG8_MMA(1, 1, At, B1); PG8_BAR; PG8_SCHED;
            PG8_LDB(B0, 1, 0); PG8_LDB(B1, 1, 1); PG8_SCHED; PG8_LDA(At, 1, 0); PG8_STAGE(PG8_SA(0, 0), rsA, a2, voffA); PG8_STAGE(PG8_SA(0, 1), rsA, a2 + hstep, voffA);
            PG8_WAIT_V(8); PG8_WAIT_L(0); PG8_BAR; PG8_MMA(0, 0, At, B0); PG8_MMA(0, 1, At, B1); PG8_BAR; PG8_SCHED;
            PG8_LDA(At, 1, 1); PG8_STAGE(PG8_SB(1, 0), rsB, b3, voffB); PG8_STAGE(PG8_SB(1, 1), rsB, b3 + hstep, voffB);
            PG8_WAIT_V(6); PG8_WAIT_L(0); PG8_BAR; PG8_MMA(1, 0, At, B0); PG8_MMA(1, 1, At, B1); PG8_BAR; PG8_SCHED;
            } else if constexpr (SP2 == 1) {
            PG8_LDB(B0, 0, 0); PG8_LDB(B1, 0, 1); PG8_SCHED; PG8_LDA(At, 0, 0); PG8_STAGE(PG8_SA(1, 1), rsA, a1 + hstep, voffA);
            PG8_WAIT_V(8); PG8_WAIT_L(0); PG8_BAR; PG8_MMA(0, 0, At, B0); PG8_MMA(0, 1, At, B1); PG8_BAR; PG8_SCHED;
            PG8_LDA(At, 0, 1); PG8_STAGE(PG8_SB(0, 0), rsB, b2, voffB); PG8_STAGE(PG8_SB(0, 1), rsB, b2 + hstep, voffB); PG8_STAGE(PG8_SA(0, 0), rsA, a2, voffA);
            PG8_WAIT_V(8); PG8_WAIT_L(0); PG8_BAR; PG8_MMA(1, 0, At, B0); PG8_MMA(1, 1, At, B1); PG8_BAR; PG8_SCHED;
            PG8_LDB(B0, 1, 0); PG8_LDB(B1, 1, 1); PG8_SCHED; PG8_LDA(At, 1, 0); PG8_STAGE(PG8_SA(0, 1), rsA, a2 + hstep, voffA);
            PG8_WAIT_V(8); PG8_WAIT_L(0); PG8_BAR; PG8_MMA(0, 0, At, B0); PG8_MMA(0, 1, At, B1); PG8_BAR; PG8_SCHED;
            PG8_LDA(At, 1, 1); PG8_STAGE(PG8_SB(1, 0), rsB, b3, voffB); PG8_STAGE(PG8_SB(1, 1), rsB, b3 + hstep, voffB); PG8_STAGE(PG8_SA(1, 0), rsA, a3, voffA);
            PG8_WAIT_V(8); PG8_WAIT_L(0); PG8_BAR; PG8_MMA(1, 0, At, B0); PG8_MMA(1, 1, At, B1); PG8_BAR; PG8_SCHED;
            } else {
            PG8_LDB(B0, 0, 0); PG8_SCHED; PG8_LDA(At, 0, 0); PG8_STAGE(PG8_SA(1, 1), rsA, a1 + hstep, voffA);
            PG8_WAIT_L(8); PG8_BAR; PG8_WAIT_L(0); PG8_MMA(0, 0, At, B0); PG8_BAR; PG8_SCHED;
            PG8_LDB(B1, 0, 1); PG8_STAGE(PG8_SB(0, 0), rsB, b2, voffB);
            PG8_BAR; PG8_WAIT_L(0); PG8_MMA(0, 1, At, B1); PG8_BAR;
            PG8_LDA(At, 0, 1); PG8_STAGE(PG8_SA(0, 0), rsA, a2, voffA);
            PG8_BAR; PG8_WAIT_L(0); PG8_MMA(1, 0, At, B0); PG8_BAR; PG8_SCHED;
            PG8_STAGE(PG8_SB(0, 1), rsB, b2 + hstep, voffB);
            PG8_WAIT_V(6); PG8_BAR; PG8_MMA(1, 1, At, B1); PG8_BAR;
            PG8_LDB(B0, 1, 0); PG8_SCHED; PG8_LDA(At, 1, 0); PG8_STAGE(PG8_SA(0, 1), rsA, a2 + hstep, voffA);
            PG8_WAIT_L(8); PG8_BAR; PG8_WAIT_L(0); PG8_MMA(0, 0, At, B0); PG8_BAR; PG8_SCHED;
            PG8_LDB(B1, 1, 1); PG8_STAGE(PG8_SB(1, 0), rsB, b3, voffB);
            PG8_BAR; PG8_WAIT_L(0); PG8_MMA(0, 1, At, B1); PG8_BAR;
            PG8_LDA(At, 1, 1); PG8_STAGE(PG8_SA(1, 0), rsA, a3, voffA);
            PG8_BAR; PG8_WAIT_L(0); PG8_MMA(1, 0, At, B0); PG8_BAR; PG8_SCHED;
            PG8_STAGE(PG8_SB(1, 1), rsB, b3 + hstep, voffB);
            PG8_WAIT_V(6); PG8_BAR; PG8_MMA(1, 1, At, B1); PG8_BAR;
            }
        }
        if (PROF && blockIdx.x == 0 && tid == 0) { const unsigned long long n_ = __builtin_amdgcn_s_memrealtime(); prof[0] += n_ - prof[6]; prof[6] = n_; }
        if constexpr (ALIGN_EPI) { if (wr == 0) PG8_BAR; }
        if constexpr (Epi::LDSPRE) { if (E.lds_ok) { if (has_next) E.pre_unit(lds, nxt, (ui + 1) & 1, wid, lane); E.run_lds(lds, acc, cur, ui & 1, wr, wc, fr, fq); } else E(acc, cur, wr, wc, fr, fq); } else
        E(acc, cur, wr, wc, fr, fq);
        if constexpr (ABL == 4) { _Pragma("unroll") for (int a = 0; a < 2; ++a) _Pragma("unroll") for (int b = 0; b < 2; ++b) _Pragma("unroll") for (int c = 0; c < 2; ++c) asm volatile("" :: "v"(acc32[a][b][c])); }
        if constexpr (REP_EPI) { asm volatile("" ::: "memory"); E(acc, cur, wr, wc, fr, fq); }
        if (PROF && blockIdx.x == 0 && tid == 0) { asm volatile("s_waitcnt vmcnt(0)" ::: "memory"); const unsigned long long n_ = __builtin_amdgcn_s_memrealtime(); prof[1] += n_ - prof[6]; prof[6] = n_; }
        if (!has_next) break;
#pragma unroll
        for (int a = 0; a < 2; ++a)
#pragma unroll
            for (int b = 0; b < 2; ++b)
#pragma unroll
                for (int m = 0; m < 4; ++m)
#pragma unroll
                    for (int n = 0; n < 2; ++n) acc[a][b][m][n] = (f32x4){0.f, 0.f, 0.f, 0.f};
        cur = nxt; cA = nA; cB = nB; kb = nkb; ki = nki; ++ui;
        if constexpr (ALIGN_EPI) { if (wr == 1) PG8_BAR; }
    }
    PG8_WAIT_V(0);
    if constexpr (!ALIGN_EPI) { if (wr == 0) PG8_BAR; }
    PG8_BAR;
#undef PG8_FLIP
#undef PG8_SA
#undef PG8_SB
#undef PG8_STAGE
#undef PG8_LDA
#undef PG8_LDB
#undef PG8_MMA
#undef PG8_WAIT_V
#undef PG8_WAIT_L
#undef PG8_BAR
#undef PG8_SCHED
}
}

__device__ __forceinline__ float silu_mul(float g, float u) { return g * u * __builtin_amdgcn_rcpf(1.0f + __builtin_amdgcn_exp2f(-1.4426950408889634f * g)); }
__device__ __forceinline__ f32x4 silu_mul4(f32x4 g, f32x4 u) { return (f32x4){silu_mul(g[0], u[0]), silu_mul(g[1], u[1]), silu_mul(g[2], u[2]), silu_mul(g[3], u[3])}; }
__device__ __forceinline__ u32x2 pk4(f32x4 v) { u32x2 w; w.x = pk2(v[0], v[1]); w.y = pk2(v[2], v[3]); return w; }
__device__ __forceinline__ int uni(int v) { return __builtin_amdgcn_readfirstlane(v); }
__device__ __forceinline__ unsigned char* opaque_ws(unsigned char* ws) { const unsigned long long w0 = (unsigned long long)ws; unsigned lo = (unsigned)uni((int)(unsigned)w0), hi = (unsigned)uni((int)(unsigned)(w0 >> 32)); asm volatile("" : "+s"(lo), "+s"(hi));
    return (unsigned char*)(GAS unsigned char*)(((unsigned long long)hi << 32) | lo); }
struct LnFold { int q, cgo;
    __device__ __forceinline__ void get(unsigned char* ws, const float*& stats, const float*& cg, const float*& cb) const {
        int q_ = uni(q), o_ = uni(cgo); asm volatile("" : "+s"(q_), "+s"(o_));
        stats = (const float*)(ws + WS_STATS + (size_t)q_ * STATS_BYTES); cg = (const float*)(ws + WS_CG) + o_; cb = (const float*)(ws + WS_CB) + o_; }
};
__device__ __forceinline__ void row_norm(const float* stats, int row, float& rstd, float& t) {
    const f2_t sq = *(const f2_t*)(stats + 2 * (size_t)row); const float mu = sq.x * (1.f / D), var = sq.y * (1.f / D) - mu * mu;
    rstd = __builtin_amdgcn_rsqf(var + LN_EPS); t = -mu * rstd;
}
__device__ __forceinline__ f32x4 lnfix(f32x4 acc, float rstd, float t, f32x4 cg, f32x4 cb) { return acc * rstd + (cg * t + cb); }
__device__ __forceinline__ void stats_add(float* st, int row, float s, float q, int fq) {
    s += __shfl_xor(s, 16); s += __shfl_xor(s, 32); q += __shfl_xor(q, 16); q += __shfl_xor(q, 32);
    if (fq < 2) __hip_atomic_fetch_add(st + 2 * (size_t)row + fq, fq == 0 ? s : q, __ATOMIC_RELAXED, __HIP_MEMORY_SCOPE_AGENT);
}
#define LOAD_CGCB(cgp, cbp, tc0) f32x4 cg[2][2], cb[2][2]; _Pragma("unroll") for (int bj = 0; bj < 2; ++bj) _Pragma("unroll") for (int n = 0; n < 2; ++n) { \
        cg[bj][n] = *(const f32x4*)((cgp) + (tc0) + 128 * bj + 4 * n); cb[bj][n] = *(const f32x4*)((cbp) + (tc0) + 128 * bj + 4 * n); }

constexpr int LF_RT_OFF = RING_BYTES + 4096, LF_CGCB_OFF = LF_RT_OFF + 2048;
__device__ __forceinline__ void lf_pre_unit(unsigned char* ws0, const LnFold& L, PG8_LAS unsigned char* lds, const pg8::Unit& u, int slot, int wid, int lane) {
    if (wid < 2) { unsigned char* ws = opaque_ws(ws0); int o_ = uni(L.cgo); asm volatile("" : "+s"(o_));
        const __amdgpu_buffer_rsrc_t rs = __builtin_amdgcn_make_buffer_rsrc((void*)(ws + WS_CG), (short)0, 0x7ffffff0, 0x00020000);
        __builtin_amdgcn_raw_ptr_buffer_load_lds(rs, (PG8_LAS unsigned*)(lds + LF_CGCB_OFF + slot * 2048 + wid * 1024), 16, (unsigned)lane_id() * 16u, (unsigned)(o_ + u.pn * 256) * 4u + (unsigned)wid * (unsigned)(NCGCB * 4), 0, 0); }
}
__device__ __forceinline__ void lf_pre_phase(unsigned char* ws0, const LnFold& L, PG8_LAS unsigned char* lds, const pg8::Unit& u, int tid, int wid, int lane) {
    lf_pre_unit(ws0, L, lds, u, 0, wid, lane);
    if (tid < 256) { unsigned char* ws = opaque_ws(ws0); const float *stats, *cgp, *cbp; L.get(ws, stats, cgp, cbp); float rstd, t; row_norm(stats, u.pm * 256 + tid, rstd, t);
        *(PG8_LAS f2_t*)(lds + LF_RT_OFF + tid * 8) = (f2_t){rstd, t}; }
    __syncthreads();
}
#define LF_RT(LDS_, i_) ((LDS_) ? *(const PG8_LAS f2_t*)(rtl + (((i_) >> 2) * 128 + ((i_) & 3) * 16) * 8) : rtv[i_])
#define LF_OPERANDS(LDS_, tc0_) f32x4 cg[2][2], cb[2][2]; f2_t rtv[8]; const PG8_LAS unsigned char* rtl = nullptr; \
    if constexpr (LDS_) { int fq_ = fq, fr_ = fr; asm volatile("" : "+v"(fq_), "+v"(fr_));     \
        const PG8_LAS unsigned char* cgl_ = lds + LF_CGCB_OFF + slot * 2048 + (wc * 32 + 8 * fq_) * 4; const PG8_LAS unsigned char* rtl_ = lds + LF_RT_OFF + (wr * 64 + fr_) * 8; \
        _Pragma("unroll") for (int bj = 0; bj < 2; ++bj) _Pragma("unroll") for (int n = 0; n < 2; ++n) { cg[bj][n] = *(const PG8_LAS f32x4*)(cgl_ + (128 * bj + 4 * n) * 4); cb[bj][n] = *(const PG8_LAS f32x4*)(cgl_ + 1024 + (128 * bj + 4 * n) * 4); } \
        rtl = rtl_; \
    } else { const float *stats, *cgp, *cbp; L.get(ws, stats, cgp, cbp); \
        _Pragma("unroll") for (int bj = 0; bj < 2; ++bj) _Pragma("unroll") for (int n = 0; n < 2; ++n) { cg[bj][n] = *(const f32x4*)(cgp + (tc0_) + 128 * bj + 4 * n); cb[bj][n] = *(const f32x4*)(cbp + (tc0_) + 128 * bj + 4 * n); } \
        _Pragma("unroll") for (int i = 0; i < 8; ++i) { float rstd_, t_; row_norm(stats, row0 + (i >> 2) * 128 + (i & 3) * 16, rstd_, t_); rtv[i] = (f2_t){rstd_, t_}; } }
#define LF_MEMBERS bool lds_ok = false; \
    __device__ __forceinline__ void pre_unit(PG8_LAS unsigned char* lds, const pg8::Unit& u, int slot, int wid, int lane) const { lf_pre_unit(ws0, L, lds, u, slot, wid, lane); } \
    __device__ __forceinline__ void pre_phase(PG8_LAS unsigned char* lds, const pg8::Unit& u, int tid, int wid, int lane) const { lf_pre_phase(ws0, L, lds, u, tid, wid, lane); } \
    __device__ __forceinline__ void operator()(const f32x4 (&acc)[2][2][4][2], const pg8::Unit& u, int wr, int wc, int fr, int fq) const { body<false>(nullptr, 0, acc, u, wr, wc, fr, fq); } \
    __device__ __forceinline__ void run_lds(PG8_LAS unsigned char* lds, const f32x4 (&acc)[2][2][4][2], const pg8::Unit& u, int slot, int wr, int wc, int fr, int fq) const { body<true>(lds, slot, acc, u, wr, wc, fr, fq); }
struct EpiSwiglu {
    static constexpr bool PERM = true; static constexpr bool LDSPRE = true;
    unsigned char* ws0; LnFold L; bool lds_ok = false;
    static constexpr int RT_OFF = RING_BYTES + 4096, CGCB_OFF = RT_OFF + 2048;
    __device__ __forceinline__ void pre_unit(PG8_LAS unsigned char* lds, const pg8::Unit& u, int slot, int wid, int lane) const {
        if (wid < 2) { unsigned char* ws = opaque_ws(ws0); int o_ = uni(L.cgo); asm volatile("" : "+s"(o_));
            const __amdgpu_buffer_rsrc_t rs = __builtin_amdgcn_make_buffer_rsrc((void*)(ws + WS_CG), (short)0, 0x7ffffff0, 0x00020000);
            __builtin_amdgcn_raw_ptr_buffer_load_lds(rs, (PG8_LAS unsigned*)(lds + CGCB_OFF + slot * 2048 + wid * 1024), 16, (unsigned)lane * 16u, (unsigned)(o_ + u.pn * 256) * 4u + (unsigned)wid * (unsigned)(NCGCB * 4), 0, 0); }
    }
    __device__ __forceinline__ void pre_phase(PG8_LAS unsigned char* lds, const pg8::Unit& u, int tid, int wid, int lane) const {
        pre_unit(lds, u, 0, wid, lane);
        if (tid < 256) { unsigned char* ws = opaque_ws(ws0); const float *stats, *cgp, *cbp; L.get(ws, stats, cgp, cbp); float rstd, t; row_norm(stats, u.pm * 256 + tid, rstd, t);
            *(PG8_LAS f2_t*)(lds + RT_OFF + tid * 8) = (f2_t){rstd, t}; }
        __syncthreads();
    }
    __device__ __forceinline__ void run_lds(PG8_LAS unsigned char* lds, const f32x4 (&acc)[2][2][4][2], const pg8::Unit& u, int slot, int wr, int wc, int fr, int fq) const {
        unsigned char* ws = opaque_ws(ws0); bf16_t* O = (bf16_t*)(ws + WS_ACT);
        const int row0 = u.pm * 256 + wr * 64 + fr, col0 = u.pn * 128 + wc * 32 + 8 * fq;
        const PG8_LAS unsigned char* cgl = lds + CGCB_OFF + slot * 2048 + (wc * 32 + 8 * fq) * 4; const PG8_LAS unsigned char* rtl = lds + RT_OFF + (wr * 64 + fr) * 8;
        f32x4 cg[2][2], cb[2][2];
#pragma unroll
        for (int bj = 0; bj < 2; ++bj)
#pragma unroll
            for (int n = 0; n < 2; ++n) { cg[bj][n] = *(const PG8_LAS f32x4*)(cgl + (128 * bj + 4 * n) * 4); cb[bj][n] = *(const PG8_LAS f32x4*)(cgl + 1024 + (128 * bj + 4 * n) * 4); }
#pragma unroll
        for (int ai = 0; ai < 2; ++ai)
#pragma unroll
            for (int m = 0; m < 4; ++m) { const int row = row0 + ai * 128 + m * 16; const f2_t rt = *(const PG8_LAS f2_t*)(rtl + (ai * 128 + m * 16) * 8); const float rstd = rt.x, t = rt.y;
                const u32x2 a = pk4(silu_mul4(lnfix(acc[ai][0][m][0], rstd, t, cg[0][0], cb[0][0]), lnfix(acc[ai][1][m][0], rstd, t, cg[1][0], cb[1][0])));
                const u32x2 b = pk4(silu_mul4(lnfix(acc[ai][0][m][1], rstd, t, cg[0][1], cb[0][1]), lnfix(acc[ai][1][m][1], rstd, t, cg[1][1], cb[1][1])));
                *(u32x4*)(O + (size_t)row * FF + col0) = (u32x4){a.x, a.y, b.x, b.y}; }
    }
    __device__ __forceinline__ void operator()(const f32x4 (&acc)[2][2][4][2], const pg8::Unit& u, int wr, int wc, int fr, int fq) const {
        unsigned char* ws = opaque_ws(ws0); bf16_t* O = (bf16_t*)(ws + WS_ACT); const float *stats, *cgp, *cbp; L.get(ws, stats, cgp, cbp);
        const int row0 = u.pm * 256 + wr * 64 + fr, col0 = u.pn * 128 + wc * 32 + 8 * fq, tc0 = u.pn * 256 + wc * 32 + 8 * fq;
        LOAD_CGCB(cgp, cbp, tc0)
#pragma unroll
        for (int ai = 0; ai < 2; ++ai)
#pragma unroll
            for (int m = 0; m < 4; ++m) { const int row = row0 + ai * 128 + m * 16; float rstd, t; row_norm(stats, row, rstd, t);
                const u32x2 a = pk4(silu_mul4(lnfix(acc[ai][0][m][0], rstd, t, cg[0][0], cb[0][0]), lnfix(acc[ai][1][m][0], rstd, t, cg[1][0], cb[1][0])));
                const u32x2 b = pk4(silu_mul4(lnfix(acc[ai][0][m][1], rstd, t, cg[0][1], cb[0][1]), lnfix(acc[ai][1][m][1], rstd, t, cg[1][1], cb[1][1])));
                *(u32x4*)(O + (size_t)row * FF + col0) = (u32x4){a.x, a.y, b.x, b.y}; }
    }
    __device__ __forceinline__ void meta(int r, int col, f32x4 g, f32x4 up) const {
        unsigned char* ws = opaque_ws(ws0); bf16_t* O = (bf16_t*)(ws + WS_ACT); const float *stats, *cgp, *cbp; L.get(ws, stats, cgp, cbp);
        const int row = MREAL + r, tc = 256 * (col >> 7) + (col & 127); float rstd, t; row_norm(stats, row, rstd, t);
        g = lnfix(g, rstd, t, *(const f32x4*)(cgp + tc), *(const f32x4*)(cbp + tc)); up = lnfix(up, rstd, t, *(const f32x4*)(cgp + tc + 128), *(const f32x4*)(cbp + tc + 128));
        *(u32x2*)(O + (size_t)row * FF + col) = pk4(silu_mul4(g, up)); }
};
struct EpiNull { static constexpr bool PERM = true; static constexpr bool LDSPRE = false;
    __device__ __forceinline__ void operator()(const f32x4 (&acc)[2][2][4][2], const pg8::Unit&, int, int, int, int) const {
#pragma unroll
        for (int a = 0; a < 2; ++a)
#pragma unroll
            for (int b = 0; b < 2; ++b)
#pragma unroll
                for (int m = 0; m < 4; ++m)
#pragma unroll
                    for (int n = 0; n < 2; ++n) asm volatile("" :: "v"(acc[a][b][m][n])); } };
struct RangeOrder : pg8::StaticOrder { int r0, r1;
    __device__ bool next(int i, pg8::Unit& u) const { return (i + r0 < r1) && pg8::StaticOrder::next(i + r0, u); } };
struct FakeOrder : pg8::StaticOrder { int nun;
    __device__ bool next(int i, pg8::Unit& u) const { u.pm = 0; u.pn = 0; return i < nun; } };
struct EpiResidLN {
    static constexpr bool PERM = true; static constexpr bool LDSPRE = false; static constexpr bool dry = false; static constexpr int XM = 0;
    unsigned char* ws0; int qprev, qnew; float coef;
    __device__ __forceinline__ void operator()(const f32x4 (&acc)[2][2][4][2], const pg8::Unit& u, int wr, int wc, int fr, int fq) const {
        unsigned char* ws = opaque_ws(ws0); int qp = uni(qprev), qn = uni(qnew); asm volatile("" : "+s"(qp), "+s"(qn));
        typedef __amdgpu_buffer_rsrc_t rsrc_t;
#define MKRS(p_) __builtin_amdgcn_make_buffer_rsrc((void*)(p_), (short)0, 0x7ffffff0, 0x00020000)
        const rsrc_t rsH = MKRS(ws + WS_HB), rsO = MKRS(dry ? ws + WS_X32 : ws + WS_HB), rsS = MKRS(ws + WS_STATS + (size_t)qp * STATS_BYTES), rsN = MKRS(ws + WS_STATS + (size_t)qn * STATS_BYTES);
        const rsrc_t rsG = MKRS(ws + WS_LNG + (size_t)qp * D * 4), rsB = MKRS(ws + WS_LNB + (size_t)qp * D * 4);
#undef MKRS
        const int row0 = u.pm * 256 + wr * 64 + fr, ccol = u.pn * 256 + wc * 32 + 8 * fq;
        const unsigned hvo = (unsigned)(row0 * D + ccol) * 2u, svo = (unsigned)row0 * 8u, gvo = (unsigned)ccol * 4u;
        f32x4 gv[2][2], bv[2][2];
#pragma unroll
        for (int bj = 0; bj < 2; ++bj)
#pragma unroll
            for (int n = 0; n < 2; ++n) { gv[bj][n] = __builtin_bit_cast(f32x4, __builtin_amdgcn_raw_buffer_load_b128(rsG, (int)(gvo + 512u * bj + 16u * n), 0, 0)); bv[bj][n] = __builtin_bit_cast(f32x4, __builtin_amdgcn_raw_buffer_load_b128(rsB, (int)(gvo + 512u * bj + 16u * n), 0, 0)); }
        float S[8], Q[8];
        u32x4 hw[2][4][2]; u32x2 sw[2][4];
#define RL_LOAD(ai_) _Pragma("unroll") for (int m = 0; m < 4; ++m) { sw[ai_][m] = __builtin_amdgcn_raw_buffer_load_b64(rsS, (int)(svo + (unsigned)(128 * (ai_) + 16 * m) * 8u), 0, 0); \
            _Pragma("unroll") for (int bj = 0; bj < 2; ++bj) hw[ai_][m][bj] = (XM == 3) ? (u32x4){0x3c003c00u, 0x3c003c00u, 0x3c003c00u, 0x3c003c00u} : __builtin_amdgcn_raw_buffer_load_b128(rsH, (int)(hvo + 256u * bj), (128 * (ai_) + 16 * m) * (D * 2), 0); }
#define RL_STATS(i0_) do { const bool b0_ = (fq & 1) != 0, b1_ = (fq & 2) != 0; \
            const float y0_ = (b0_ ? Q[i0_] : S[i0_]) + __shfl_xor(b0_ ? S[i0_] : Q[i0_], 16), y1_ = (b0_ ? Q[(i0_) + 1] : S[(i0_) + 1]) + __shfl_xor(b0_ ? S[(i0_) + 1] : Q[(i0_) + 1], 16); \
            const float tot_ = (b1_ ? y1_ : y0_) + __shfl_xor(b1_ ? y0_ : y1_, 32); \
            if (XM != 2) __builtin_amdgcn_raw_ptr_buffer_atomic_fadd_f32(tot_, rsN, (int)(svo + 4u * (fq & 1) + (unsigned)(128 * ((i0_) >> 2) + 16 * ((i0_) & 3) + (b1_ ? 16 : 0)) * 8u), 0, 0); } while (0)
        RL_LOAD(0);
        __builtin_amdgcn_sched_barrier(0);
#pragma unroll
        for (int ai = 0; ai < 2; ++ai) {
#pragma unroll
            for (int m = 0; m < 4; ++m) { float s = 0.f, q = 0.f;
                if (ai == 0 && m == 2) { RL_LOAD(1); __builtin_amdgcn_sched_barrier(0); }
                const float mu = __uint_as_float(sw[ai][m].x) * (1.f / D), var = __uint_as_float(sw[ai][m].y) * (1.f / D) - mu * mu, rstd = __builtin_amdgcn_rsqf(var + LN_EPS), t = -mu * rstd;
#pragma unroll
                for (int bj = 0; bj < 2; ++bj) { const u32x4 w = hw[ai][m][bj];
                    const f32x4 h0 = {bf_lo(w.x), bf_hi(w.x), bf_lo(w.y), bf_hi(w.y)}, h1 = {bf_lo(w.z), bf_hi(w.z), bf_lo(w.w), bf_hi(w.w)};
                    const f32x4 r0 = ((h0 * rstd + t) * gv[bj][0] + bv[bj][0]) * ALPHA + acc[ai][bj][m][0] * coef, r1 = ((h1 * rstd + t) * gv[bj][1] + bv[bj][1]) * ALPHA + acc[ai][bj][m][1] * coef;
                    const u32x2 a = pk4(r0), c = pk4(r1); if (XM != 4) *(u32x4*)(ws + (dry ? WS_X32 : WS_HB) + (size_t)((128 * ai + 16 * m) * (D * 2) + 256 * bj) + (size_t)hvo) = (u32x4){a.x, a.y, c.x, c.y};
                    s += ((r0[0] + r0[1]) + (r0[2] + r0[3])) + ((r1[0] + r1[1]) + (r1[2] + r1[3]));
                    q += ((r0[0] * r0[0] + r0[1] * r0[1]) + (r0[2] * r0[2] + r0[3] * r0[3])) + ((r1[0] * r1[0] + r1[1] * r1[1]) + (r1[2] * r1[2] + r1[3] * r1[3])); }
                S[ai * 4 + m] = s; Q[ai * 4 + m] = q; __builtin_amdgcn_sched_barrier(0);
                if (m == 1) RL_STATS(ai * 4); if (m == 3) RL_STATS(ai * 4 + 2); } }
#undef RL_LOAD
#undef RL_STATS
    }
    __device__ __forceinline__ void meta(int r, int col, f32x4 a, f32x4) const {
        unsigned char* ws = opaque_ws(ws0); int qp = uni(qprev), qn = uni(qnew); asm volatile("" : "+s"(qp), "+s"(qn));
        bf16_t* Hb = (bf16_t*)(ws + WS_HB);
        const float* st_prev = (const float*)(ws + WS_STATS + (size_t)qp * STATS_BYTES); float* st_new = (float*)(ws + WS_STATS + (size_t)qn * STATS_BYTES);
        const float* g = (const float*)(ws + WS_LNG) + (size_t)qp * D; const float* b = (const float*)(ws + WS_LNB) + (size_t)qp * D;
        const int row = MREAL + r; float rstd, t; row_norm(st_prev, row, rstd, t);
        const u32x2 w = *(const u32x2*)(Hb + (size_t)row * D + col); const f32x4 h = {bf_lo(w.x), bf_hi(w.x), bf_lo(w.y), bf_hi(w.y)};
        const f32x4 rr = ((h * rstd + t) * *(const f32x4*)(g + col) + *(const f32x4*)(b + col)) * ALPHA + a * coef;
        *(u32x2*)(Hb + (size_t)row * D + col) = pk4(rr);
        stats_add(st_new, row, (rr[0] + rr[1]) + (rr[2] + rr[3]), (rr[0] * rr[0] + rr[1] * rr[1]) + (rr[2] * rr[2] + rr[3] * rr[3]), col >> 2 & 3); }
};
struct EpiConvIn {
    static constexpr bool PERM = true; static constexpr bool LDSPRE = true;
    unsigned char* ws0; LnFold L; LF_MEMBERS
    template <bool LDS> __device__ __forceinline__ void body(PG8_LAS unsigned char* lds, int slot, const f32x4 (&acc)[2][2][4][2], const pg8::Unit& u, int wr, int wc, int fr, int fq) const {
        unsigned char* ws = opaque_ws(ws0); bf16_t* V = (bf16_t*)(ws + WS_ACT); bf16_t* BG = (bf16_t*)(ws + WS_ACT + ACT_SUB);
        const int row0 = u.pm * 256 + wr * 64 + fr, tc0 = u.pn * 256 + wc * 32 + 8 * fq;
        LF_OPERANDS(LDS, tc0)
        if (u.pn < 16) {
            const int col0 = u.pn * 128 + wc * 32 + 8 * fq;
#pragma unroll
            for (int ai = 0; ai < 2; ++ai)
#pragma unroll
                for (int m = 0; m < 4; ++m) { const int row = row0 + ai * 128 + m * 16; const f2_t rt_ = LF_RT(LDS, ai * 4 + m); const float rstd = rt_.x, t = rt_.y;
                    const u32x2 a = pk4(lnfix(acc[ai][0][m][0], rstd, t, cg[0][0], cb[0][0]) * lnfix(acc[ai][1][m][0], rstd, t, cg[1][0], cb[1][0]));
                    const u32x2 b = pk4(lnfix(acc[ai][0][m][1], rstd, t, cg[0][1], cb[0][1]) * lnfix(acc[ai][1][m][1], rstd, t, cg[1][1], cb[1][1]));
                    *(u32x4*)(V + (size_t)row * D + col0) = (u32x4){a.x, a.y, b.x, b.y}; }
        } else {
            const int col0 = (u.pn - 16) * 256 + wc * 32 + 8 * fq;
#pragma unroll
            for (int ai = 0; ai < 2; ++ai)
#pragma unroll
                for (int m = 0; m < 4; ++m) { const int row = row0 + ai * 128 + m * 16; const f2_t rt_ = LF_RT(LDS, ai * 4 + m); const float rstd = rt_.x, t = rt_.y; bf16_t* p = BG + (size_t)row * D + col0;
#pragma unroll
                    for (int bj = 0; bj < 2; ++bj) { const u32x2 a = pk4(lnfix(acc[ai][bj][m][0], rstd, t, cg[bj][0], cb[bj][0])), b = pk4(lnfix(acc[ai][bj][m][1], rstd, t, cg[bj][1], cb[bj][1]));
                        *(u32x4*)(p + bj * 128) = (u32x4){a.x, a.y, b.x, b.y}; } }
        }
    }
};
struct MetaConvV { unsigned char* ws0; LnFold L;
    __device__ __forceinline__ void meta(int r, int col, f32x4 c, f32x4 uu) const {
        unsigned char* ws = opaque_ws(ws0); bf16_t* V = (bf16_t*)(ws + WS_ACT); const float *stats, *cgp, *cbp; L.get(ws, stats, cgp, cbp);
        const int row = MREAL + r, tc = 256 * (col >> 7) + (col & 127); float rstd, t; row_norm(stats, row, rstd, t);
        c = lnfix(c, rstd, t, *(const f32x4*)(cgp + tc), *(const f32x4*)(cbp + tc)); uu = lnfix(uu, rstd, t, *(const f32x4*)(cgp + tc + 128), *(const f32x4*)(cbp + tc + 128));
        *(u32x2*)(V + (size_t)row * D + col) = pk4(c * uu); } };
struct EpiBf16S {
    static constexpr bool PERM = true; static constexpr bool LDSPRE = true;
    unsigned char* ws0; size_t ooff; float scale; LnFold L; LF_MEMBERS
    template <bool LDS> __device__ __forceinline__ void body(PG8_LAS unsigned char* lds, int slot, const f32x4 (&acc)[2][2][4][2], const pg8::Unit& u, int wr, int wc, int fr, int fq) const {
        unsigned char* ws = opaque_ws(ws0); bf16_t* O = (bf16_t*)(ws + ooff);
        const int row0 = u.pm * 256 + wr * 64 + fr, col0 = u.pn * 256 + wc * 32 + 8 * fq;
        LF_OPERANDS(LDS, col0)
#pragma unroll
        for (int ai = 0; ai < 2; ++ai)
#pragma unroll
            for (int m = 0; m < 4; ++m) { const int row = row0 + ai * 128 + m * 16; const f2_t rt_ = LF_RT(LDS, ai * 4 + m); const float rstd = rt_.x, t = rt_.y; bf16_t* p = O + (size_t)row * D + col0;
#pragma unroll
                for (int bj = 0; bj < 2; ++bj) { const u32x2 a = pk4(lnfix(acc[ai][bj][m][0], rstd, t, cg[bj][0], cb[bj][0]) * scale), b = pk4(lnfix(acc[ai][bj][m][1], rstd, t, cg[bj][1], cb[bj][1]) * scale);
                    *(u32x4*)(p + bj * 128) = (u32x4){a.x, a.y, b.x, b.y}; } }
    }
    __device__ __forceinline__ void meta(int r, int col, f32x4 a, f32x4) const {
        unsigned char* ws = opaque_ws(ws0); bf16_t* O = (bf16_t*)(ws + ooff); const float *stats, *cgp, *cbp; L.get(ws, stats, cgp, cbp);
        const int row = MREAL + r; float rstd, t; row_norm(stats, row, rstd, t);
        *(u32x2*)(O + (size_t)row * D + col) = pk4(lnfix(a, rstd, t, *(const f32x4*)(cgp + col), *(const f32x4*)(cbp + col)) * scale); }
};
__device__ __forceinline__ int vperm(int ts) { return (ts & ~12) | ((ts & 4) << 1) | ((ts & 8) >> 1); }
struct EpiKV {
    static constexpr bool PERM = true; static constexpr bool LDSPRE = false;
    unsigned char* ws0; LnFold L;
    __device__ __forceinline__ void operator()(const f32x4 (&acc)[2][2][4][2], const pg8::Unit& u, int wr, int wc, int fr, int fq) const {
        unsigned char* ws = opaque_ws(ws0); bf16_t* KB = (bf16_t*)(ws + WS_KB); bf16_t* VT = (bf16_t*)(ws + WS_VT); const float *stats, *cgp, *cbp; L.get(ws, stats, cgp, cbp);
        const int row0 = u.pm * 256 + wr * 64 + fr, d0 = wc * 32 + 8 * fq, tc0 = u.pn * 256 + wc * 32 + 8 * fq;
        LOAD_CGCB(cgp, cbp, tc0)
        if (u.pn < 8) {
#pragma unroll
            for (int ai = 0; ai < 2; ++ai)
#pragma unroll
                for (int m = 0; m < 4; ++m) { const int row = row0 + ai * 128 + m * 16, b = row >> 11, ts = 32 + (row & 2047); float rstd, t; row_norm(stats, row, rstd, t);
#pragma unroll
                    for (int bj = 0; bj < 2; ++bj) { const int h = 2 * u.pn + bj; bf16_t* p = KB + ((size_t)(b * NH + h) * TS + ts) * HD + d0;
                        const u32x2 a = pk4(lnfix(acc[ai][bj][m][0], rstd, t, cg[bj][0], cb[bj][0])), bq = pk4(lnfix(acc[ai][bj][m][1], rstd, t, cg[bj][1], cb[bj][1])); *(u32x4*)p = (u32x4){a.x, a.y, bq.x, bq.y}; } }
        } else {
#pragma unroll
            for (int ai = 0; ai < 2; ++ai)
#pragma unroll
                for (int m = 0; m < 4; ++m) { const int row = row0 + ai * 128 + m * 16, b = row >> 11, ts = 32 + (row & 2047); float rstd, t; row_norm(stats, row, rstd, t);
#pragma unroll
                    for (int bj = 0; bj < 2; ++bj) { const int h = 2 * (u.pn - 8) + bj; bf16_t* p = VT + ((size_t)(b * NH + h) * HD + d0) * TS + vperm(ts);
#pragma unroll
                        for (int n = 0; n < 2; ++n) { const u32x2 w = pk4(lnfix(acc[ai][bj][m][n], rstd, t, cg[bj][n], cb[bj][n]));
                            p[(size_t)(4 * n + 0) * TS] = (bf16_t)(w.x & 0xffffu); p[(size_t)(4 * n + 1) * TS] = (bf16_t)(w.x >> 16);
                            p[(size_t)(4 * n + 2) * TS] = (bf16_t)(w.y & 0xffffu); p[(size_t)(4 * n + 3) * TS] = (bf16_t)(w.y >> 16); } } }
        }
    }
    __device__ __forceinline__ void meta(int r, int col, f32x4 a, f32x4) const {
        unsigned char* ws = opaque_ws(ws0); bf16_t* KB = (bf16_t*)(ws + WS_KB); bf16_t* VT = (bf16_t*)(ws + WS_VT); const float *stats, *cgp, *cbp; L.get(ws, stats, cgp, cbp);
        const int row = MREAL + r; float rstd, t; row_norm(stats, row, rstd, t);
        const u32x2 w = pk4(lnfix(a, rstd, t, *(const f32x4*)(cgp + col), *(const f32x4*)(cbp + col))); const int ts = 16 + r;
        if (col < D) { const int h = col >> 7, d = col & 127;
            for (int b = 0; b < NB; ++b) *(u32x2*)(KB + ((size_t)(b * NH + h) * TS + ts) * HD + d) = w;
        } else { const int c2 = col - D, h = c2 >> 7, d = c2 & 127;
            for (int b = 0; b < NB; ++b) { bf16_t* p = VT + ((size_t)(b * NH + h) * HD + d) * TS + vperm(ts);
                p[0] = (bf16_t)(w.x & 0xffffu); p[(size_t)TS] = (bf16_t)(w.x >> 16); p[(size_t)2 * TS] = (bf16_t)(w.y & 0xffffu); p[(size_t)3 * TS] = (bf16_t)(w.y >> 16); } }
    }
};

template <bool PAIR, int KS, class F>
__device__ __forceinline__ void meta_gemm(const bf16_t* A, int lda, const bf16_t* Bt, int K, int ncols, int wg, int nwg, int wave, int lane, LAS unsigned char* lds, const F& f) {
    constexpr int UPW = 8 / KS;
    const int fr = lane & 15, fq = lane >> 4, nunits = ncols >> 4, kper = K / KS, slot = wave / KS, kbeg = (wave % KS) * kper;
    LAS f32x4* red = (LAS f32x4*)lds;
    for (int u0 = wg * UPW; u0 < nunits; u0 += nwg * UPW) {
        const int u = u0 + slot; const bool live = u < nunits;
        f32x4 acc0 = {0.f, 0.f, 0.f, 0.f}, acc1 = {0.f, 0.f, 0.f, 0.f};
        if (live) {
            int br0 = 16 * u, br1 = 0;
            if (PAIR) { const int j0 = 16 * u; br0 = 256 * (j0 >> 7) + (j0 & 127); br1 = br0 + 128; }
            const bf16_t* ap = A + (size_t)fr * lda + 8 * fq + kbeg;
            const bf16_t* bp0 = Bt + (size_t)(br0 + fr) * K + 8 * fq + kbeg;
            const bf16_t* bp1 = Bt + (size_t)(br1 + fr) * K + 8 * fq + kbeg;
#pragma unroll 8
            for (int k0 = 0; k0 < kper; k0 += 32) {
                const bf16x8 a = *(const bf16x8*)(ap + k0), b0 = *(const bf16x8*)(bp0 + k0);
                acc0 = __builtin_amdgcn_mfma_f32_16x16x32_f16(__builtin_bit_cast(h8_t, b0), __builtin_bit_cast(h8_t, a), acc0, 0, 0, 0);
                if (PAIR) { const bf16x8 b1 = *(const bf16x8*)(bp1 + k0); acc1 = __builtin_amdgcn_mfma_f32_16x16x32_f16(__builtin_bit_cast(h8_t, b1), __builtin_bit_cast(h8_t, a), acc1, 0, 0, 0); }
            }
        }
        red[(wave * 2 + 0) * 64 + lane] = acc0; if (PAIR) red[(wave * 2 + 1) * 64 + lane] = acc1;
        __syncthreads();
        if (live && (wave % KS) == 0) {
#pragma unroll
            for (int w = 1; w < KS; ++w) { acc0 = acc0 + red[((wave + w) * 2 + 0) * 64 + lane]; if (PAIR) acc1 = acc1 + red[((wave + w) * 2 + 1) * 64 + lane]; }
            f.meta(fr, 16 * u + 4 * fq, acc0, acc1);
        }
        __syncthreads();
    }
}

#define XB_TMO      128
#define XB_XCNT(j)  (256  + 64 * (j))
#define XB_XSUB(j)  (1280 + 64 * (j))
#define XB_XGEN(j)  (2304 + 64 * (j))
#define XB_TOP      3328
#define XB_TOPGEN   3392
#define XCD_BAR_WORDS 3456
#define XB_SPIN_CAP (1u << 18)
__device__ __forceinline__ unsigned xb_ld(unsigned* p)              { return __hip_atomic_load(p, __ATOMIC_RELAXED, __HIP_MEMORY_SCOPE_AGENT); }
__device__ __forceinline__ unsigned xb_add(unsigned* p, unsigned v) { return __hip_atomic_fetch_add(p, v, __ATOMIC_RELAXED, __HIP_MEMORY_SCOPE_AGENT); }
__device__ __forceinline__ unsigned xb_xcc_id() { return (unsigned)__builtin_amdgcn_s_getreg((3 << 11) | 20) & 0xFu; }
#define XB_SPIN(cond, bar) do { unsigned _sp = 0; while (cond) { __builtin_amdgcn_s_sleep(1); \
    if ((++_sp & 255u) == 0u) { if (xb_ld(&(bar)[XB_TMO])) break; if (_sp > XB_SPIN_CAP) { atomicAdd(&(bar)[XB_TMO], 1u); break; } } } } while (0)
struct XcdBarrier { unsigned* bar; unsigned x; volatile LAS unsigned* st; };
__device__ __forceinline__ XcdBarrier xcd_barrier_post(unsigned* bar, volatile LAS unsigned* st) {
    XcdBarrier b; b.bar = bar; b.x = xb_xcc_id(); b.st = st;
    if (threadIdx.x == 0) (void)xb_add(&bar[XB_XCNT(b.x)], 1u);
    return b;
}
__device__ __forceinline__ void xcd_barrier_complete(unsigned* bar, unsigned x, unsigned& nloc, unsigned& nx) {
    const unsigned G = gridDim.x * gridDim.y * gridDim.z;
    unsigned sum, cnt, mine, sp = 0u;
    for (;;) {
        sum = 0u; cnt = 0u; mine = 0u;
#pragma unroll
        for (unsigned j = 0; j < 16; ++j) { const unsigned c = xb_ld(&bar[XB_XCNT(j)]); sum += c; cnt += (c > 0u) ? 1u : 0u; mine = (j == x) ? c : mine; }
        if (sum == G) break;
        __builtin_amdgcn_s_sleep(1);
        if ((++sp & 255u) == 0u) { if (xb_ld(&bar[XB_TMO])) break; if (sp > XB_SPIN_CAP) { atomicAdd(&bar[XB_TMO], 1u); break; } }
    }
    nloc = mine > 0u ? mine : 1u; nx = cnt > 0u ? cnt : 1u;
}
__device__ __forceinline__ void xcd_barrier(const XcdBarrier& b, int wave) {
    asm volatile("s_waitcnt vmcnt(0)" ::: "memory");
    __syncthreads();
    if (wave == 0 && lane_id() == 0) {
        unsigned* bar = b.bar;
        unsigned bx = (unsigned)__builtin_amdgcn_readfirstlane((int)b.x); asm volatile("" : "+s"(bx));
        __builtin_amdgcn_s_waitcnt(0);
        unsigned nloc = b.st[0], nx = b.st[1];
        if (nloc == 0u) { xcd_barrier_complete(bar, bx, nloc, nx); b.st[0] = nloc; b.st[1] = nx; }
        const unsigned old = xb_add(&bar[XB_XSUB(bx)], 1u);
        const unsigned gen = old / nloc;
        if (old + 1u == (gen + 1u) * nloc) {
            __builtin_amdgcn_fence(__ATOMIC_RELEASE, "agent");
            asm volatile("s_waitcnt vmcnt(0)" ::: "memory");
            const unsigned og = xb_add(&bar[XB_TOP], 1u);
            const unsigned tg = og / nx;
            if (og + 1u == (tg + 1u) * nx) xb_add(&bar[XB_TOPGEN], 1u);
            else XB_SPIN(xb_ld(&bar[XB_TOPGEN]) == tg, bar);
            __builtin_amdgcn_fence(__ATOMIC_ACQUIRE, "agent");
            xb_add(&bar[XB_XGEN(bx)], 1u);
            asm volatile("s_waitcnt vmcnt(0)" ::: "memory");
        } else {
            XB_SPIN(xb_ld(&bar[XB_XGEN(bx)]) == gen, bar);
            __builtin_amdgcn_fence(__ATOMIC_ACQUIRE, "agent");
            asm volatile("s_waitcnt vmcnt(0)" ::: "memory");
        }
    }
    __syncthreads();
}

struct Frame {
    LAS unsigned char* lds;
    int tid, lane, wave, vcu, G, gw, ngw;
    unsigned char* ws;
};
#define LDS_WAIT() asm volatile("s_waitcnt lgkmcnt(0)" ::: "memory")
__device__ __forceinline__ float wave_sum(float v) {
#pragma unroll
    for (int o = 1; o < 64; o <<= 1) v += __shfl_xor(v, o);
    return v;
}

template <int MODE> __device__ __forceinline__ void transpose_item(f32x4 (&v)[12], const float* W, int K, int Nsrc, int srccol0, bf16_t* WT, int dstrow0, int k0, LAS float* scr, int lane, const float* gk, const float* bk, float* cg, float* cb, bool do_atomics = true) {
    if (MODE != 1) { const float* src = W + (size_t)(k0 + (lane >> 3)) * Nsrc + srccol0 + 4 * (lane & 7);
#pragma unroll
        for (int i = 0; i < 8; ++i) v[i] = *(const f32x4*)(src + (size_t)(8 * i) * Nsrc);
        if (gk) { const int c_ = lane & 7; v[8] = *(const f32x4*)(gk + k0 + 8 * c_); v[9] = *(const f32x4*)(gk + k0 + 8 * c_ + 4); v[10] = *(const f32x4*)(bk + k0 + 8 * c_); v[11] = *(const f32x4*)(bk + k0 + 8 * c_ + 4); } }
    if (MODE == 0) return;
#pragma unroll
    for (int i = 0; i < 8; ++i) { LAS float* d = scr + (8 * i + (lane >> 3)) * 33 + 4 * (lane & 7); d[0] = v[i][0]; d[1] = v[i][1]; d[2] = v[i][2]; d[3] = v[i][3]; }
    LDS_WAIT(); asm volatile("" ::: "memory");
    const int c = lane & 7;
    if (gk) {
        const f32x4 g0 = v[8], g1 = v[9], b0 = v[10], b1 = v[11];
        float sg[4], sb[4];
#pragma unroll
        for (int j = 0; j < 4; ++j) { const int n = (lane >> 3) + 8 * j; const LAS float* s = scr + (8 * c) * 33 + n;
            const float w0 = s[0 * 33], w1 = s[1 * 33], w2 = s[2 * 33], w3 = s[3 * 33], w4 = s[4 * 33], w5 = s[5 * 33], w6 = s[6 * 33], w7 = s[7 * 33];
            u32x4 o; o.x = pk2(w0 * g0[0], w1 * g0[1]); o.y = pk2(w2 * g0[2], w3 * g0[3]); o.z = pk2(w4 * g1[0], w5 * g1[1]); o.w = pk2(w6 * g1[2], w7 * g1[3]);
            *(u32x4*)(WT + (size_t)(dstrow0 + n) * K + k0 + 8 * c) = o;
            float a = ((bf_lo(o.x) + bf_hi(o.x)) + (bf_lo(o.y) + bf_hi(o.y))) + ((bf_lo(o.z) + bf_hi(o.z)) + (bf_lo(o.w) + bf_hi(o.w)));
            float bsum = ((w0 * b0[0] + w1 * b0[1]) + (w2 * b0[2] + w3 * b0[3])) + ((w4 * b1[0] + w5 * b1[1]) + (w6 * b1[2] + w7 * b1[3]));
            a += __shfl_xor(a, 1); a += __shfl_xor(a, 2); a += __shfl_xor(a, 4); bsum += __shfl_xor(bsum, 1); bsum += __shfl_xor(bsum, 2); bsum += __shfl_xor(bsum, 4);
            sg[j] = a; sb[j] = bsum; }
        const int srcl = 8 * (lane & 7); float ag = 0.f, ab = 0.f;
#pragma unroll
        for (int j = 0; j < 4; ++j) { const float tg = __shfl(sg[j], srcl), tb = __shfl(sb[j], srcl); if ((lane >> 3) == j) { ag = tg; ab = tb; } }
        if (lane < 32 && do_atomics) { __hip_atomic_fetch_add(cg + dstrow0 + lane, ag, __ATOMIC_RELAXED, __HIP_MEMORY_SCOPE_AGENT); __hip_atomic_fetch_add(cb + dstrow0 + lane, ab, __ATOMIC_RELAXED, __HIP_MEMORY_SCOPE_AGENT); }
    } else {
#pragma unroll
        for (int j = 0; j < 4; ++j) { const int n = (lane >> 3) + 8 * j; const LAS float* s = scr + (8 * c) * 33 + n;
            u32x4 o; o.x = pk2(s[0 * 33], s[1 * 33]); o.y = pk2(s[2 * 33], s[3 * 33]); o.z = pk2(s[4 * 33], s[5 * 33]); o.w = pk2(s[6 * 33], s[7 * 33]);
            *(u32x4*)(WT + (size_t)(dstrow0 + n) * K + k0 + 8 * c) = o; }
    }
    LDS_WAIT(); asm volatile("" ::: "memory");
}
constexpr int IT_W1 = (D / 64) * (FF2 / 32), IT_W2 = (FF / 64) * (D / 32), IT_CIN = (D / 64) * (3 * D / 32), IT_SQ = (D / 64) * (D / 32), IT_KV = (D / 64) * (2 * D / 32);
constexpr int IT_END_W1 = 8 * IT_W1, IT_END_W2 = IT_END_W1 + 8 * IT_W2, IT_END_CIN = IT_END_W2 + 2 * IT_CIN, IT_END_COUT = IT_END_CIN + 2 * IT_SQ, IT_END_WQ = IT_END_COUT + 2 * IT_SQ,
              IT_END_WO = IT_END_WQ + 2 * IT_SQ, IT_TOTAL = IT_END_WO + IT_KV;
constexpr int CGO_W1 = 0, CGO_CIN = 8 * FF2, CGO_WQ = CGO_CIN + 2 * 3 * D, CGO_KV = CGO_WQ + 2 * D;
static_assert(CGO_KV + 2 * D == NCGCB, "cg/cb map");
template <int MODE> __device__ __forceinline__ void prologue_item(f32x4 (&v)[12], Frame& F, const float* ln_g, const float* ln_b, const float* w_in, const float* w_out, const float* cw_in, const float* cw_out, const float* wq, const float* wo, const float* wkv, int it, LAS float* scr, bool do_atomics = true) {
    const float* W; bf16_t* WT; int K, Nsrc, nb, kb, srccol0, dstrow0; int lnq = -1, cgo = 0;
    if (it < IT_END_W1) { const int j = it / IT_W1, r = it % IT_W1; K = D; Nsrc = FF2; W = w_in + (size_t)j * D * FF2; WT = (bf16_t*)(F.ws + WS_W1T + (size_t)j * W1T_BYTES);
        nb = r / (D / 64); kb = r % (D / 64); dstrow0 = 32 * nb; const int pn = dstrow0 >> 8, c = dstrow0 & 255; srccol0 = (c < 128) ? (128 * pn + c) : (FF + 128 * pn + (c - 128));
        const int l = j >> 1; lnq = (j & 1) ? (3 * l + 1) : (3 * l - 1); cgo = CGO_W1 + j * FF2; }
    else if (it < IT_END_W2) { const int q = it - IT_END_W1, j = q / IT_W2, r = q % IT_W2; K = FF; Nsrc = D; W = w_out + (size_t)j * FF * D; WT = (bf16_t*)(F.ws + WS_W2T + (size_t)j * W2T_BYTES);
        nb = r / (FF / 64); kb = r % (FF / 64); dstrow0 = 32 * nb; srccol0 = dstrow0; }
    else if (it < IT_END_CIN) { const int q = it - IT_END_W2, j = q / IT_CIN, r = q % IT_CIN; K = D; Nsrc = 3 * D; W = cw_in + (size_t)j * D * 3 * D; WT = (bf16_t*)(F.ws + WS_WCIN + (size_t)j * WCIN_BYTES);
        nb = r / (D / 64); kb = r % (D / 64); dstrow0 = 32 * nb; const int pn = dstrow0 >> 8, c = dstrow0 & 255;
        srccol0 = (pn < 16) ? ((c < 128) ? (D + 128 * pn + c) : (2 * D + 128 * pn + (c - 128))) : (256 * (pn - 16) + c); lnq = 3 * j; cgo = CGO_CIN + j * 3 * D; }
    else if (it < IT_END_WO) { const int q = it - IT_END_CIN, j = q / IT_SQ, r = q % IT_SQ; K = D; Nsrc = D;
        const float* src = (j < 2) ? cw_out : (j < 4) ? wq : wo; const size_t wsoff = (j < 2) ? WS_WCOUT : (j < 4) ? WS_WQ : WS_WO; const int l = j & 1;
        W = src + (size_t)l * D * D; WT = (bf16_t*)(F.ws + wsoff + (size_t)l * SQ_BYTES);
        nb = r / (D / 64); kb = r % (D / 64); dstrow0 = 32 * nb; srccol0 = dstrow0; if (j == 2 || j == 3) { lnq = 3 * (NCONV + l); cgo = CGO_WQ + l * D; } }
    else { const int r = it - IT_END_WO; K = D; Nsrc = 2 * D; W = wkv; WT = (bf16_t*)(F.ws + WS_WKV); nb = r / (D / 64); kb = r % (D / 64); dstrow0 = 32 * nb; srccol0 = dstrow0; lnq = 3 * (NCONV - 1) + 2; cgo = CGO_KV; }
    const float* gk = (lnq >= 0) ? ln_g + (size_t)lnq * D : nullptr; const float* bk = (lnq >= 0) ? ln_b + (size_t)lnq * D : nullptr;
    transpose_item<MODE>(v, W, K, Nsrc, srccol0, WT, dstrow0, 64 * kb, scr, F.lane, gk, bk, (float*)(F.ws + WS_CG) + cgo, (float*)(F.ws + WS_CB) + cgo, do_atomics);
}
__device__ __forceinline__ void p0_prologue(Frame& F, const float* x, const float* meta, const float* ln_g, const float* ln_b, const float* w_in, const float* w_out, const float* cw_in, const float* cw_out, const float* wq, const float* wo, const float* wkv) {
    LAS float* scr = (LAS float*)(F.lds + RING_OFF + F.wave * 16384);
    {
        f32x4 va[12], vb[12]; const int st = F.ngw; int it = F.gw;
        if (it < IT_TOTAL) prologue_item<0>(va, F, ln_g, ln_b, w_in, w_out, cw_in, cw_out, wq, wo, wkv, it, scr);
        for (; it < IT_TOTAL; it += 2 * st) {
            const bool hb = it + st < IT_TOTAL;
            if (hb) prologue_item<0>(vb, F, ln_g, ln_b, w_in, w_out, cw_in, cw_out, wq, wo, wkv, it + st, scr);
            prologue_item<1>(va, F, ln_g, ln_b, w_in, w_out, cw_in, cw_out, wq, wo, wkv, it, scr);
            if (hb) { if (it + 2 * st < IT_TOTAL) prologue_item<0>(va, F, ln_g, ln_b, w_in, w_out, cw_in, cw_out, wq, wo, wkv, it + 2 * st, scr);
                      prologue_item<1>(vb, F, ln_g, ln_b, w_in, w_out, cw_in, cw_out, wq, wo, wkv, it + st, scr); }
        }
    }
#if EXP_KIND == 4
    { f32x4 vd[12]; for (int it = F.gw; it < IT_TOTAL; it += F.ngw) prologue_item<2>(vd, F, ln_g, ln_b, w_in, w_out, cw_in, cw_out, wq, wo, wkv, it, scr, false); }
#endif
    bf16_t* HBp = (bf16_t*)(F.ws + WS_HB);
    for (int row = F.gw; row < MROWS; row += 2 * F.ngw) {
        const int rowb = (row + F.ngw < MROWS) ? row + F.ngw : row; f32x4 v[2][8];
#pragma unroll
        for (int r = 0; r < 2; ++r) { const int rr = r ? rowb : row; const float* src = (rr < MREAL) ? x + (size_t)rr * D : meta + (size_t)(rr - MREAL) * D;
#pragma unroll
            for (int j = 0; j < 8; ++j) v[r][j] = *(const f32x4*)(src + 4 * F.lane + 256 * j); }
        asm volatile("" ::: "memory");
#pragma unroll
        for (int r = 0; r < 2; ++r) { const int rr = r ? rowb : row;
#pragma unroll
            for (int j = 0; j < 8; ++j) *(u32x2*)(HBp + (size_t)rr * D + 4 * F.lane + 256 * j) = pk4(v[r][j]); }
    }
    { float* st0 = (float*)(F.ws + WS_STATS); float* lng = (float*)(F.ws + WS_LNG); float* lnb = (float*)(F.ws + WS_LNB);
      for (int i = F.gw * 64 + F.lane; i < MROWS; i += F.ngw * 64) { st0[2 * i] = 0.f; st0[2 * i + 1] = (float)D * (1.0f - LN_EPS); }
      for (int i = F.gw * 64 + F.lane; i < 13 * D; i += F.ngw * 64) { lng[i] = (i < D) ? 1.0f : ln_g[i - D]; lnb[i] = (i < D) ? 0.0f : ln_b[i - D]; } }
    bf16_t* KB = (bf16_t*)(F.ws + WS_KB); bf16_t* VT = (bf16_t*)(F.ws + WS_VT);
    for (int bh = F.gw; bh < NB * NH; bh += F.ngw) {
        for (int i = F.lane; i < 16 * HD / 8; i += 64) *(u32x4*)(KB + (size_t)bh * TS * HD + 8 * i) = (u32x4){0u, 0u, 0u, 0u};
        for (int i = F.lane; i < HD * 2; i += 64) *(u32x4*)(VT + ((size_t)bh * HD + (i >> 1)) * TS + 8 * (i & 1)) = (u32x4){0u, 0u, 0u, 0u};
    }
}

__device__ __forceinline__ void final_ln_phase(Frame& F, const float* stats, const float* gain, const float* bias, float* out) {
    const bf16_t* Hb = (const bf16_t*)(F.ws + WS_HB);
    f32x4 g[4][2], bb[4][2];
#pragma unroll
    for (int j = 0; j < 4; ++j)
#pragma unroll
        for (int h = 0; h < 2; ++h) { g[j][h] = *(const f32x4*)(gain + 8 * F.lane + 512 * j + 4 * h); bb[j][h] = *(const f32x4*)(bias + 8 * F.lane + 512 * j + 4 * h); }
    for (int row = F.gw; row < MREAL; row += 2 * F.ngw) {
        const int rowb = (row + F.ngw < MREAL) ? row + F.ngw : row;
        float rs[2], ts[2]; u32x4 w[2][4];
#pragma unroll
        for (int r = 0; r < 2; ++r) { const int rr = r ? rowb : row; row_norm(stats, rr, rs[r], ts[r]); const bf16_t* xr = Hb + (size_t)rr * D + 8 * F.lane;
#pragma unroll
            for (int j = 0; j < 4; ++j) w[r][j] = *(const u32x4*)(xr + 512 * j); }
        asm volatile("" ::: "memory");
#pragma unroll
        for (int r = 0; r < 2; ++r) { const int rr = r ? rowb : row; float* o = out + (size_t)rr * D + 8 * F.lane; const float rstd = rs[r], t = ts[r];
#pragma unroll
            for (int j = 0; j < 4; ++j) { const u32x4 ww = w[r][j];
                const f32x4 v0 = {bf_lo(ww.x), bf_hi(ww.x), bf_lo(ww.y), bf_hi(ww.y)}, v1 = {bf_lo(ww.z), bf_hi(ww.z), bf_lo(ww.w), bf_hi(ww.w)};
                *(f32x4*)(o + 512 * j) = (v0 * rstd + t) * g[j][0] + bb[j][0]; *(f32x4*)(o + 512 * j + 4) = (v1 * rstd + t) * g[j][1] + bb[j][1]; } }
    }
}

__device__ __forceinline__ void unpack8(u32x4 w, float (&f)[8]) { f[0] = bf_lo(w.x); f[1] = bf_hi(w.x); f[2] = bf_lo(w.y); f[3] = bf_hi(w.y); f[4] = bf_lo(w.z); f[5] = bf_hi(w.z); f[6] = bf_lo(w.w); f[7] = bf_hi(w.w); }
__device__ __forceinline__ void conv_phase(Frame& F, const float* cw, const float* cb) {
    const bf16_t* V = (const bf16_t*)(F.ws + WS_ACT); const bf16_t* BG = (const bf16_t*)(F.ws + WS_ACT + ACT_SUB); bf16_t* GG = (bf16_t*)(F.ws + WS_ACT + 2 * ACT_SUB);
    for (int row = F.gw; row < MROWS; row += F.ngw) {
        const bf16_t* cur = V + (size_t)row * D; const bf16_t* p1 = cur; const bf16_t* p2 = cur; float m1 = 1.f, m2 = 1.f;
        if (row < MREAL) { const int t = row & (SEQ - 1);
            if (t >= 2) { p1 = cur - D; p2 = cur - 2 * D; }
            else if (t == 1) { p1 = cur - D; p2 = V + (size_t)(MREAL + 15) * D; }
            else { p1 = V + (size_t)(MREAL + 15) * D; p2 = V + (size_t)(MREAL + 14) * D; }
        } else { const int i = row - MREAL; if (i >= 1) p1 = cur - D; else m1 = 0.f; if (i >= 2) p2 = cur - 2 * D; else m2 = 0.f; }
#pragma unroll
        for (int j = 0; j < 4; ++j) { const int c0 = 8 * (F.lane + 64 * j);
            float a[8], b1[8], b2[8], bg[8];
            unpack8(*(const u32x4*)(cur + c0), a); unpack8(*(const u32x4*)(p1 + c0), b1); unpack8(*(const u32x4*)(p2 + c0), b2); unpack8(*(const u32x4*)(BG + (size_t)row * D + c0), bg);
            float o[8];
#pragma unroll
            for (int h = 0; h < 2; ++h) { const f32x4 w0 = *(const f32x4*)(cw + c0 + 4 * h), w1 = *(const f32x4*)(cw + D + c0 + 4 * h), w2 = *(const f32x4*)(cw + 2 * D + c0 + 4 * h), bbv = *(const f32x4*)(cb + c0 + 4 * h);
#pragma unroll
                for (int e = 0; e < 4; ++e) o[4 * h + e] = bg[4 * h + e] * (w0[e] * (b2[4 * h + e] * m2) + w1[e] * (b1[4 * h + e] * m1) + w2[e] * a[4 * h + e] + bbv[e]); }
            *(u32x4*)(GG + (size_t)row * D + c0) = (u32x4){pk2(o[0], o[1]), pk2(o[2], o[3]), pk2(o[4], o[5]), pk2(o[6], o[7])};
        }
    }
}

#ifndef ATTN_EARLY_EXIT
#define ATTN_EARLY_EXIT 1
#endif
__device__ __forceinline__ void attn_unit(Frame& F, const bf16_t* Qb, bf16_t* Ob, const bf16_t* KB, const bf16_t* VT, int b, int h, int qi) {
    const int lane = F.lane, ql = lane & 31, hh = lane >> 5;
    const bool qvalid = (qi > 0) || (ql >= 16);
    const int qrow = (qi > 0) ? (b * SEQ + 32 * (qi - 1) + ql) : (MREAL + (qvalid ? ql - 16 : 0));
    const bf16_t* qp = Qb + (size_t)qrow * D + h * HD + 8 * hh;
    bf16x8 qf[8];
#pragma unroll
    for (int s = 0; s < 8; ++s) qf[s] = *(const bf16x8*)(qp + 16 * s);
    const bf16_t* kbase = KB + (size_t)(b * NH + h) * TS * HD + (size_t)ql * HD + 8 * hh;
    const bf16_t* vbase = VT + ((size_t)(b * NH + h) * HD + ql) * TS + 8 * hh;
    f32x16 oacc[4];
#pragma unroll
    for (int i = 0; i < 4; ++i)
#pragma unroll
        for (int r = 0; r < 16; ++r) oacc[i][r] = 0.f;
    float C = qvalid ? 0.f : -1e30f;
    const int qs = 32 * qi + ql;
    bf16x8 kf[8]; u32x4 vf[4][2];
#define ATT_LOADK(kt_) do { const bf16_t* kp_ = kbase + (size_t)(32 * (kt_)) * HD; _Pragma("unroll") for (int s = 0; s < 8; ++s) kf[s] = *(const bf16x8*)(kp_ + 16 * s); } while (0)
#define ATT_LOADV(kt_) do { const bf16_t* vp_ = vbase + 32 * (kt_); _Pragma("unroll") for (int blk = 0; blk < 4; ++blk) _Pragma("unroll") for (int s2 = 0; s2 < 2; ++s2) { \
        vf[blk][s2] = *(const u32x4*)(vp_ + (size_t)(32 * blk) * TS + 16 * s2); } } while (0)
    ATT_LOADK(qi); ATT_LOADV(qi);
    __builtin_amdgcn_sched_barrier(0);
    for (int kt = qi; kt >= 0; --kt) {
        f32x16 z;
#pragma unroll
        for (int r = 0; r < 16; ++r) z[r] = 0.f;
#pragma unroll
        for (int s = 0; s < 8; ++s) z = __builtin_amdgcn_mfma_f32_32x32x16_f16(__builtin_bit_cast(h8_t, kf[s]), __builtin_bit_cast(h8_t, qf[s]), z, 0, 0, 0);
        if (kt > 0) ATT_LOADK(kt - 1);
        float lk[16]; float TT;
        const bool edge = (kt == qi) || (kt == 0);
#pragma unroll
        for (int r = 0; r < 16; ++r) { const float zz = z[r], sp = fmaxf(zz, 0.f) + __builtin_amdgcn_logf(1.f + __builtin_amdgcn_exp2f(-fabsf(zz))); z[r] = zz - sp; lk[r] = -sp; }
        if (edge) {
#pragma unroll
            for (int r = 0; r < 16; ++r) { const int ks = 32 * kt + (r & 3) + 8 * (r >> 2) + 4 * hh; const bool vld = (ks < qs) && (ks >= 16); lk[r] = vld ? lk[r] : 0.f; z[r] = vld ? z[r] : -1e30f; }
        }
        float G[4], PG[4];
#pragma unroll
        for (int g = 0; g < 4; ++g) { G[g] = (lk[4 * g] + lk[4 * g + 1]) + (lk[4 * g + 2] + lk[4 * g + 3]); PG[g] = __shfl_xor(G[g], 32); }
        float suf[4]; suf[3] = 0.f; suf[2] = G[3] + PG[3]; suf[1] = suf[2] + (G[2] + PG[2]); suf[0] = suf[1] + (G[1] + PG[1]);
        TT = suf[0] + (G[0] + PG[0]);
#pragma unroll
        for (int g = 0; g < 4; ++g) { const float base = C + suf[g] + (hh == 0 ? PG[g] : 0.f);
            const float s2 = lk[4 * g + 3], s1 = s2 + lk[4 * g + 2], s0 = s1 + lk[4 * g + 1];
            z[4 * g + 0] = __builtin_amdgcn_exp2f(z[4 * g + 0] + (base + s0)); z[4 * g + 1] = __builtin_amdgcn_exp2f(z[4 * g + 1] + (base + s1));
            z[4 * g + 2] = __builtin_amdgcn_exp2f(z[4 * g + 2] + (base + s2)); z[4 * g + 3] = __builtin_amdgcn_exp2f(z[4 * g + 3] + base); }
#define a z
        C += TT;
        bf16x8 pf[2];
#pragma unroll
        for (int s2 = 0; s2 < 2; ++s2) { const u32x4 w = {pk2(a[8 * s2], a[8 * s2 + 1]), pk2(a[8 * s2 + 2], a[8 * s2 + 3]), pk2(a[8 * s2 + 4], a[8 * s2 + 5]), pk2(a[8 * s2 + 6], a[8 * s2 + 7])}; pf[s2] = __builtin_bit_cast(bf16x8, w); }
#undef a
#pragma unroll
        for (int blk = 0; blk < 4; ++blk)
#pragma unroll
            for (int s2 = 0; s2 < 2; ++s2) oacc[blk] = __builtin_amdgcn_mfma_f32_32x32x16_f16(__builtin_bit_cast(h8_t, vf[blk][s2]), __builtin_bit_cast(h8_t, pf[s2]), oacc[blk], 0, 0, 0);
#if ATTN_EARLY_EXIT
        if (__all(C < -151.0f)) break;
#endif
        if (kt > 0) ATT_LOADV(kt - 1);
    }
#undef ATT_LOADK
#undef ATT_LOADV
    if (qvalid) { bf16_t* op = Ob + (size_t)qrow * D + h * HD + 4 * hh;
#pragma unroll
        for (int blk = 0; blk < 4; ++blk)
#pragma unroll
            for (int g = 0; g < 4; ++g) *(u32x2*)(op + 32 * blk + 8 * g) = pk4((f32x4){oacc[blk][4 * g], oacc[blk][4 * g + 1], oacc[blk][4 * g + 2], oacc[blk][4 * g + 3]}); }
}
__device__ __forceinline__ void attn_phase(Frame& F) {
    const bf16_t* Qb = (const bf16_t*)(F.ws + WS_ACT); bf16_t* Ob = (bf16_t*)(F.ws + WS_ACT + ACT_SUB);
    const bf16_t* KB = (const bf16_t*)(F.ws + WS_KB); const bf16_t* VT = (const bf16_t*)(F.ws + WS_VT);
    int k = 0;
    for (int u = F.gw; u < NB * NH * 64; u += F.ngw, ++k) {
        F.lane = lane_id();
        const int bh = u >> 6, q0 = u & 63, qi = (k & 1) ? (64 - q0) : (1 + q0); attn_unit(F, Qb, Ob, KB, VT, bh >> 4, bh & 15, qi);
    }
}

struct Args { const float* in[13]; float* out; unsigned char* ws; };
__global__ void __launch_bounds__(NWAVES * 64, 2) yoco_fwd(Args args) {
    extern __shared__ __attribute__((aligned(16))) unsigned char lds[];
    Frame F;
    F.lds = (LAS unsigned char*)lds;
    F.tid = threadIdx.x; F.lane = F.tid & 63; F.wave = __builtin_amdgcn_readfirstlane(F.tid >> 6);
    F.G = gridDim.x; { const int bx = blockIdx.x; F.vcu = (F.G % 8 == 0) ? (bx % 8) * (F.G / 8) + bx / 8 : bx; }
    F.gw = F.vcu * NWAVES + F.wave; F.ngw = F.G * NWAVES;
    F.ws = args.ws;
    for (int u = F.tid; u < (LDS_BYTES - LDSCTL_OFF) / 4; u += NWAVES * 64) ((LAS unsigned*)(F.lds + LDSCTL_OFF))[u] = 0u;
    __syncthreads();
    unsigned* ctl = (unsigned*)(F.ws + WS_CTL);
    XcdBarrier bar = xcd_barrier_post(ctl + CW_BAR, (volatile LAS unsigned*)(F.lds + MISC_OFF) + 8);
#if PROBE
#define prof ((unsigned long long*)(F.ws + WS_CTL + 65536))
    if (blockIdx.x == 0 && threadIdx.x == 0) prof[31] = __builtin_amdgcn_s_memrealtime();
#define PACC(slot) do { if (blockIdx.x == 0 && threadIdx.x == 0) { const unsigned long long n_ = __builtin_amdgcn_s_memrealtime(); prof[slot] += n_ - prof[31]; prof[31] = n_; } } while (0)
#else
#define PACC(slot) do { } while (0)
#endif
#if EXP_KIND == 7
#define GRID_BAR() do { xcd_barrier(bar, F.wave); xcd_barrier(bar, F.wave); PHASE_BEGIN(); PACC(3); } while (0)
#else
#define GRID_BAR() do { xcd_barrier(bar, F.wave); PHASE_BEGIN(); PACC(3); } while (0)
#endif
#define PHASE_BEGIN() do { const int l_ = lane_id(); F.lane = l_; F.tid = F.wave * 64 + l_; F.gw = F.vcu * NWAVES + F.wave; \
        unsigned long long w_ = (unsigned long long)args.ws; asm volatile("" : "+s"(w_)); F.ws = (unsigned char*)(GAS unsigned char*)w_; } while (0)
#define HB ((bf16_t*)(F.ws + WS_HB))
#define ACT ((bf16_t*)(F.ws + WS_ACT))

#define STATS(q) ((float*)(F.ws + WS_STATS + (size_t)(q) * STATS_BYTES))
#define CGV(o) ((const float*)(F.ws + WS_CG) + (o))
#define CBV(o) ((const float*)(F.ws + WS_CB) + (o))
    PHASE_BEGIN();
    p0_prologue(F, args.in[0], args.in[1], args.in[2], args.in[3], args.in[4], args.in[5], args.in[6], args.in[9], args.in[10], args.in[12], args.in[11]);
    PACC(2); GRID_BAR();

    for (int l = 0; l < DEPTH; ++l) {
        for (int s = 0; s < 2; ++s) {
            const int qin = (s == 1) ? (1 + 3 * l + 1) : (l == 0 ? 0 : 1 + 3 * (l - 1) + 2), qout = 1 + 3 * l + (s == 0 ? 0 : 2);
            { const bf16_t* W1 = (const bf16_t*)(F.ws + WS_W1T + (size_t)(2 * l + s) * W1T_BYTES);
              pg8::Gemm g{HB, W1, MREAL, FF2, D}; pg8::StaticOrder S; S.init(MREAL, FF2, F.G, (int)blockIdx.x);
              EpiSwiglu E{F.ws, LnFold{qin, CGO_W1 + (2 * l + s) * FF2}, F.G == 256};
#if PROBE && PROBE_A == 16
              pg8::gemm_phase<EpiSwiglu, pg8::StaticOrder, true, GEMM_SP, true>(F.lds + RING_OFF, g, S, E, (l == 0 && s == 0) ? prof + 16 : prof + 24);
#else
#if EXP_KIND == 12
              { RangeOrder R; R.init(MREAL, FF2, F.G, (int)blockIdx.x); int nrep = 2; asm volatile("" : "+s"(nrep));
                for (int rep = 0; rep < nrep; ++rep) { R.r0 = rep ? 5 : 0; R.r1 = rep ? 11 : 5; pg8::gemm_phase<EpiSwiglu, RangeOrder, true, GEMM_SP>(F.lds + RING_OFF, g, R, E); if (rep == 0) GRID_BAR(); } }
#else
#if EXP_UP_TWICE
              int nrep = 2; asm volatile("" : "+s"(nrep)); for (int rep = 0; rep < nrep; ++rep)
#endif
              pg8::gemm_phase<EpiSwiglu, pg8::StaticOrder, true, GEMM_SP, false, EXP_EPI_TWICE != 0>(F.lds + RING_OFF, g, S, E);
#endif
#endif
#if EXP_KIND == 1
              { EpiNull EN; pg8::gemm_phase<EpiNull, pg8::StaticOrder, true, GEMM_SP>(F.lds + RING_OFF, g, S, EN); }
#elif EXP_KIND == 25
              { EpiNull EN; pg8::Gemm gc{HB, (const bf16_t*)(F.ws + WS_W1T + (size_t)((2 * l + s + 4) & 7) * W1T_BYTES), MREAL, FF2, D}; pg8::gemm_phase<EpiNull, pg8::StaticOrder, true, GEMM_SP>(F.lds + RING_OFF, gc, S, EN); }
#elif EXP_KIND == 2
              { EpiNull EN; FakeOrder FO; FO.nun = 11; pg8::gemm_phase<EpiNull, FakeOrder, true, GEMM_SP>(F.lds + RING_OFF, g, FO, EN); }
#elif EXP_KIND == 21 || EXP_KIND == 22 || EXP_KIND == 23 || EXP_KIND == 24
              { EpiNull EN; FakeOrder FO; FO.nun = 11; pg8::gemm_phase<EpiNull, FakeOrder, true, GEMM_SP, false, false, EXP_KIND - 20>(F.lds + RING_OFF, g, FO, EN); }
#elif EXP_KIND == 3
              { EpiNull EN; pg8::gemm_phase<EpiNull, pg8::StaticOrder, true, 0>(F.lds + RING_OFF, g, S, EN); }
#endif
#if EXP_KIND == 14
              meta_gemm<true, 4>(HB + (size_t)MREAL * D, D, W1, D, FF, (int)blockIdx.x, F.G, F.wave, lane_id(), F.lds + RING_OFF, E);
#endif
              if (l < NCONV) meta_gemm<true, 4>(HB + (size_t)MREAL * D, D, W1, D, FF, (int)blockIdx.x, F.G, F.wave, lane_id(), F.lds + RING_OFF, E); }
            PACC(4); GRID_BAR();
            { const bf16_t* W2 = (const bf16_t*)(F.ws + WS_W2T + (size_t)(2 * l + s) * W2T_BYTES);
              pg8::Gemm g{ACT, W2, MREAL, D, FF}; pg8::StaticOrder S; S.init(MREAL, D, F.G, (int)blockIdx.x);
              EpiResidLN E{F.ws, qin, qout, 0.5f};
#if PROBE && PROBE_A == 18
              pg8::gemm_phase<EpiResidLN, pg8::StaticOrder, true, GEMM_SP, true>(F.lds + RING_OFF, g, S, E, (l == 0 && s == 0) ? prof + 18 : prof + 26);
#else
              pg8::gemm_phase<EpiResidLN, pg8::StaticOrder, true, GEMM_SP>(F.lds + RING_OFF, g, S, E);
#if EXP_KIND == 9
              { EpiNull EN; pg8::gemm_phase<EpiNull, pg8::StaticOrder, true, GEMM_SP>(F.lds + RING_OFF, g, S, EN); }
#elif EXP_KIND == 11
              { EpiResidLN ED{F.ws, qin, 13, 0.5f}; pg8::gemm_phase<EpiResidLN, pg8::StaticOrder, true, GEMM_SP>(F.lds + RING_OFF, g, S, ED); }
#endif
#endif
              if (l < NCONV) meta_gemm<false, 8>(ACT + (size_t)MREAL * FF, FF, W2, FF, D, (int)blockIdx.x, F.G, F.wave, lane_id(), F.lds + RING_OFF, E); }
            PACC(5); GRID_BAR();
            if (s == 0) {
                const int q0 = 1 + 3 * l, q1 = q0 + 1;
                if (l < NCONV) {
                    { const bf16_t* Wc = (const bf16_t*)(F.ws + WS_WCIN + (size_t)l * WCIN_BYTES);
                      pg8::Gemm g{HB, Wc, MREAL, 3 * D, D}; pg8::StaticOrder S; S.init(MREAL, 3 * D, F.G, (int)blockIdx.x);
                      const LnFold L{q0, CGO_CIN + l * 3 * D};
                      EpiConvIn E{F.ws, L, F.G == 256};
#if EXP_KIND == 13
                      int nrep = 2; asm volatile("" : "+s"(nrep)); for (int rep = 0; rep < nrep; ++rep)
#endif
                      pg8::gemm_phase<EpiConvIn, pg8::StaticOrder, true, GEMM_SP>(F.lds + RING_OFF, g, S, E);
                      MetaConvV EV{F.ws, L}; meta_gemm<true, 8>(HB + (size_t)MREAL * D, D, Wc, D, D, (int)blockIdx.x, F.G, F.wave, lane_id(), F.lds + RING_OFF, EV);
                      EpiBf16S EB{F.ws, WS_ACT + ACT_SUB, 1.0f, LnFold{q0, CGO_CIN + l * 3 * D + 2 * D}};
                      meta_gemm<false, 8>(HB + (size_t)MREAL * D, D, Wc + (size_t)(2 * D) * D, D, D, (int)blockIdx.x, F.G, F.wave, lane_id(), F.lds + RING_OFF, EB); }
                    PACC(6); GRID_BAR();
                    conv_phase(F, args.in[7] + (size_t)l * 3 * D, args.in[8] + (size_t)l * D);
#if EXP_KIND == 6
                    conv_phase(F, args.in[7] + (size_t)l * 3 * D, args.in[8] + (size_t)l * D);
#endif
                    PACC(7); GRID_BAR();
                    { const bf16_t* Wo = (const bf16_t*)(F.ws + WS_WCOUT + (size_t)l * SQ_BYTES); const bf16_t* GG = (const bf16_t*)(F.ws + WS_ACT + 2 * ACT_SUB);
                      pg8::Gemm g{GG, Wo, MREAL, D, D}; pg8::StaticOrder S; S.init(MREAL, D, F.G, (int)blockIdx.x);
                      EpiResidLN E{F.ws, q0, q1, 1.0f};
                      pg8::gemm_phase<EpiResidLN, pg8::StaticOrder, true, GEMM_SP>(F.lds + RING_OFF, g, S, E);
                      meta_gemm<false, 8>(GG + (size_t)MREAL * D, D, Wo, D, D, (int)blockIdx.x, F.G, F.wave, lane_id(), F.lds + RING_OFF, E); }
                } else {
                    const int j = l - NCONV;
                    { const bf16_t* Wq = (const bf16_t*)(F.ws + WS_WQ + (size_t)j * SQ_BYTES);
                      pg8::Gemm g{HB, Wq, MREAL, D, D}; pg8::StaticOrder S; S.init(MREAL, D, F.G, (int)blockIdx.x);
                      EpiBf16S E{F.ws, WS_ACT, QSCALE, LnFold{q0, CGO_WQ + j * D}, F.G == 256};
#if EXP_KIND == 10
                      int nrep = 2; asm volatile("" : "+s"(nrep)); for (int rep = 0; rep < nrep; ++rep)
#endif
                      pg8::gemm_phase<EpiBf16S, pg8::StaticOrder, true, GEMM_SP>(F.lds + RING_OFF, g, S, E);
                    }
                    PACC(9); GRID_BAR();
                    attn_phase(F);
#if EXP_KIND == 5
                    attn_phase(F);
#endif
                    PACC(10); GRID_BAR();
                    { const bf16_t* Wo = (const bf16_t*)(F.ws + WS_WO + (size_t)j * SQ_BYTES); const bf16_t* Ob = (const bf16_t*)(F.ws + WS_ACT + ACT_SUB);
                      pg8::Gemm g{Ob, Wo, MREAL, D, D}; pg8::StaticOrder S; S.init(MREAL, D, F.G, (int)blockIdx.x);
                      EpiResidLN E{F.ws, q0, q1, 1.0f};
                      pg8::gemm_phase<EpiResidLN, pg8::StaticOrder, true, GEMM_SP>(F.lds + RING_OFF, g, S, E);
                    }
                }
                PACC(8); GRID_BAR();
            }
        }
        if (l == NCONV - 1) {
            const bf16_t* Wkv = (const bf16_t*)(F.ws + WS_WKV); const int q = 1 + 3 * l + 2;
            pg8::Gemm g{HB, Wkv, MREAL, 2 * D, D}; pg8::StaticOrder S; S.init(MREAL, 2 * D, F.G, (int)blockIdx.x);
            EpiKV E{F.ws, LnFold{q, CGO_KV}};
#if EXP_KIND == 8
            int nrep = 2; asm volatile("" : "+s"(nrep)); for (int rep = 0; rep < nrep; ++rep)
#endif
            pg8::gemm_phase<EpiKV, pg8::StaticOrder, true, GEMM_SP>(F.lds + RING_OFF, g, S, E);
            meta_gemm<false, 8>(HB + (size_t)MREAL * D, D, Wkv, D, 2 * D, (int)blockIdx.x, F.G, F.wave, lane_id(), F.lds + RING_OFF, E);
            PACC(12); GRID_BAR();
        }
    }
    final_ln_phase(F, (const float*)(F.ws + WS_STATS + (size_t)(1 + 3 * (DEPTH - 1) + 2) * STATS_BYTES), args.in[2] + (size_t)(3 * (DEPTH - 1) + 2) * D, args.in[3] + (size_t)(3 * (DEPTH - 1) + 2) * D, args.out);
#if PROBE
    PACC(13); GRID_BAR();
    if (blockIdx.x == 0) {
        const float a_us = (float)prof[PROBE_A] * 0.01f, b_us = (float)prof[PROBE_B] * 0.01f;
        if (threadIdx.x == 0) args.out[0] += 100.f * a_us;
        for (int i = 1 + (int)threadIdx.x; i <= 4194304; i += 512) args.out[i] += b_us;
    }
#endif
}

extern "C" void kernel_launch(void* const* d_in, const int* in_sizes, int n_in, void* d_out, int out_size, void* d_ws, size_t ws_size, hipStream_t stream) {
    static int grid = 0;
    if (grid == 0) {
        if (n_in != 13 || in_sizes[0] != MREAL * D || out_size != MREAL * D || ws_size < WS_END) { fprintf(stderr, "kernel_launch: unexpected shapes (n_in %d, in0 %d, out %d, ws %zu)\n", n_in, n_in > 0 ? in_sizes[0] : -1, out_size, ws_size); grid = -1; return; }
        int dev = 0, cus = 0;
        if (hipGetDevice(&dev) != hipSuccess || hipDeviceGetAttribute(&cus, hipDeviceAttributeMultiprocessorCount, dev) != hipSuccess) { grid = -1; return; }
        if (hipFuncSetAttribute((const void*)yoco_fwd, hipFuncAttributeMaxDynamicSharedMemorySize, LDS_BYTES) != hipSuccess) { fprintf(stderr, "kernel_launch: hipFuncSetAttribute failed\n"); grid = -1; return; }
        int per_cu = 0;
        if (hipOccupancyMaxActiveBlocksPerMultiprocessor(&per_cu, (const void*)yoco_fwd, NWAVES * 64, LDS_BYTES) != hipSuccess || per_cu < 1) fprintf(stderr, "kernel_launch: occupancy query says %d\n", per_cu);
        (void)hipGetLastError();
        grid = cus;
    }
    if (grid < 0) return;
    if (hipMemsetAsync((char*)d_ws + WS_CTL, 0, CTL_ZERO_BYTES, stream) != hipSuccess) return;
    Args a{};
    for (int i = 0; i < 13; ++i) a.in[i] = (const float*)d_in[i];
    a.out = (float*)d_out; a.ws = (unsigned char*)d_ws;
    hipLaunchKernelGGL(yoco_fwd, dim3(grid), dim3(NWAVES * 64), LDS_BYTES, stream, a);
}
```

```cpp
#include <hip/hip_runtime.h>
#include <cstdio>
#include <cstdint>
#ifndef PROBE
#define PROBE 0
#endif
#define PROBE_A 0
#define PROBE_B 1
#ifndef XCD_COL_ROT
#define XCD_COL_ROT 1
#endif
#ifndef K_SERPENTINE
#define K_SERPENTINE 1
#endif
#ifndef EXP_UP_TWICE
#define EXP_UP_TWICE 0
#endif
#ifndef PRIO_MODE
#define PRIO_MODE 1
#endif
#ifndef GEMM_SP
#define GEMM_SP 1
#endif
#ifndef EXP_KIND
#define EXP_KIND 0
#endif
#ifndef EXP_EPI_TWICE
#define EXP_EPI_TWICE 0
#endif

constexpr int D = 2048, NB = 8, SEQ = 2048, NMETA = 16, NH = 16, HD = 128, FF = 5632, FF2 = 11264, DEPTH = 4, NCONV = 2;
constexpr int MREAL = NB * SEQ;
constexpr int MROWS = MREAL + NMETA;
constexpr int MCAP = 16640;
constexpr int TS = 2080;
constexpr float ALPHA = 1.6817928305074290f, LN_EPS = 1e-5f, QSCALE = 0.08838834764831845f * 1.4426950408889634f;

constexpr size_t MiB = 1u << 20;
constexpr size_t WS_CTL = 0, CTL_ZERO_BYTES = 5 * MiB;
constexpr size_t WS_STATS = 1 * MiB, STATS_BYTES = 160 * 1024;
constexpr size_t WS_CG = 3 * MiB + 256 * 1024;
constexpr int NCGCB = 8 * 11264 + 2 * 6144 + 2 * 2048 + 4096;
constexpr size_t WS_CB = WS_CG + (size_t)NCGCB * 4;
static_assert(WS_CB + (size_t)NCGCB * 4 <= CTL_ZERO_BYTES && WS_STATS + 13 * STATS_BYTES <= WS_CG, "zeroed region map");
constexpr size_t WS_LNG = 5 * MiB, WS_LNB = 5 * MiB + 512 * 1024;
constexpr size_t WS_W1T = 6 * MiB, W1T_BYTES = 44 * MiB;
constexpr size_t WS_W2T = WS_W1T + 8 * W1T_BYTES, W2T_BYTES = 22 * MiB;
constexpr size_t WS_WCIN = WS_W2T + 8 * W2T_BYTES, WCIN_BYTES = 24 * MiB;
constexpr size_t SQ_BYTES = 8 * MiB;
constexpr size_t WS_WCOUT = WS_WCIN + 2 * WCIN_BYTES;
constexpr size_t WS_WQ = WS_WCOUT + 2 * SQ_BYTES;
constexpr size_t WS_WO = WS_WQ + 2 * SQ_BYTES;
constexpr size_t WS_WKV = WS_WO + 2 * SQ_BYTES;
constexpr size_t WS_HB = WS_WKV + 16 * MiB;
constexpr size_t WS_X32 = WS_HB + 65 * MiB;
constexpr size_t WS_ACT = WS_X32 + 130 * MiB;
constexpr size_t ACT_SUB = 65 * MiB;
constexpr size_t WS_KB = WS_ACT + 195 * MiB;
constexpr size_t WS_VT = WS_KB + 65 * MiB;
constexpr size_t WS_END = WS_VT + 65 * MiB;
constexpr int CW_BAR = 4096;

constexpr int RING_OFF = 0, RING_BYTES = 131072;
constexpr int LDSCTL_OFF = RING_BYTES, MISC_OFF = LDSCTL_OFF + 320;
constexpr int LDS_BYTES = 147456;
constexpr int NWAVES = 8;

#define GAS __attribute__((address_space(1)))
#define LAS __attribute__((address_space(3)))
typedef unsigned short bf16_t;
typedef short bf16x8 __attribute__((ext_vector_type(8)));
typedef short s16x4 __attribute__((ext_vector_type(4)));
typedef float f32x4 __attribute__((ext_vector_type(4)));
typedef float f32x16 __attribute__((ext_vector_type(16)));
typedef unsigned u32x4 __attribute__((ext_vector_type(4)));
typedef unsigned u32x2 __attribute__((ext_vector_type(2)));
typedef _Float16 h2_t __attribute__((ext_vector_type(2)));
typedef _Float16 h8_t __attribute__((ext_vector_type(8)));
typedef float f2_t __attribute__((ext_vector_type(2)));
__device__ __forceinline__ unsigned pk2(float lo, float hi) { f2_t v = {lo, hi}; h2_t r = __builtin_convertvector(v, h2_t); return __builtin_bit_cast(unsigned, r); }
__device__ __forceinline__ int lane_id() { int r; asm volatile("v_mbcnt_lo_u32_b32 %0, -1, 0\n\tv_mbcnt_hi_u32_b32 %0, -1, %0" : "=v"(r)); return r; }
__device__ __forceinline__ float bf_lo(unsigned w) { return (float)__builtin_bit_cast(h2_t, w)[0]; }
__device__ __forceinline__ float bf_hi(unsigned w) { return (float)__builtin_bit_cast(h2_t, w)[1]; }

namespace pg8 {
#define PG8_LAS __attribute__((address_space(3)))
constexpr int BM = 256, BK = 64, HALF = 128, HTB = HALF * BK * 2, STAGE_BYTES = 8 * HTB, NXCD = 8, WGM = 8;
__host__ __device__ __forceinline__ int lds_byte(int r, int c) { const int st = (r >> 4) * 2 + (c >> 5), rr = r & 15, cc = c & 31, ob = rr * 64 + cc * 2; return st * 1024 + (ob ^ (((ob >> 9) & 1) << 5)); }
__host__ __device__ __forceinline__ void stage_rc(int b, int& R, int& C) { const int st = b / 1024, sb = b % 1024, swz = sb ^ (((sb >> 9) & 1) << 5); R = (st >> 1) * 16 + swz / 64; C = (st & 1) * 32 + (swz % 64) / 2; }
__host__ __device__ __forceinline__ int perm32(int rho) { const int n = rho >> 4, i = rho & 15; return 8 * (i >> 2) + 4 * n + (i & 3); }
struct Unit { int pm, pn; };
struct Gemm { const bf16_t* A; const bf16_t* Bt; int M, N, K; };
struct StaticOrder {
    int nM, nN, nwg, G, c;
    __host__ __device__ void init(int M, int N, int G_, int c_) { nM = M / BM; nN = N / BM; nwg = nM * nN; G = G_; c = c_; }
    __host__ __device__ bool next(int i, Unit& u) const {
        const long L = (long)i * G + c; if (L >= nwg) return false;
        int wgid = (int)L; { const int q = nwg / NXCD, r = nwg % NXCD, xcd = wgid % NXCD, off = wgid / NXCD; wgid = (xcd < r ? xcd * (q + 1) : r * (q + 1) + (xcd - r) * q) + off; }
        const int nig = WGM * nN, gid = wgid / nig, fm = gid * WGM, gsz = (nM - fm) < WGM ? (nM - fm) : WGM;
        u.pm = fm + ((wgid % nig) % gsz); u.pn = (wgid % nig) / gsz;
#if XCD_COL_ROT
        { const int x = (int)(L % NXCD), ng = nN / 4, g = u.pn >> 2, k = (ng % 3 == 0) ? 1 : 3; u.pn = 4 * ((g * k + x) % ng) + (u.pn & 3); }
#endif
        return true;
    }
    __device__ __forceinline__ void a_ready(const Unit&) const {}
    __device__ __forceinline__ void done(const Unit&) const {}
};

template <class Epi, class Sched, bool ALIGN_EPI = false, int SP2 = 0, bool PROF = false, bool REP_EPI = false, int ABL = 0>
__device__ __forceinline__ void gemm_phase(PG8_LAS unsigned char* lds, const Gemm g, const Sched& S, const Epi& E, unsigned long long* prof = nullptr) {
    int tid_ = threadIdx.x; asm volatile("" : "+v"(tid_));
    const int tid = tid_, wid = __builtin_amdgcn_readfirstlane(tid >> 6), lane = tid & 63, wr = wid >> 2, wc = wid & 3, fr = lane & 15, fq = lane >> 4;
    const int K = g.K, nt = K / BK;
    unsigned voffA[2], voffB[2];
#pragma unroll
    for (int i = 0; i < 2; ++i) { int R, C; stage_rc(tid * 16 + i * 8192, R, C); const int Rb = Epi::PERM ? ((R & ~31) + perm32(R & 31)) : R;
        voffA[i] = (unsigned)(R * K + C) * 2u; voffB[i] = (unsigned)(Rb * K + C) * 2u; }
    const unsigned kstep = (unsigned)(BK * 2);
    const unsigned hstep = (unsigned)HALF * (unsigned)K * 2u;
    const unsigned tstep = 2u * hstep;
    const __amdgpu_buffer_rsrc_t rsA = __builtin_amdgcn_make_buffer_rsrc((void*)g.A, (short)0, 0x7ffffff0, 0x00020000);
    const __amdgpu_buffer_rsrc_t rsB = __builtin_amdgcn_make_buffer_rsrc((void*)g.Bt, (short)0, 0x7ffffff0, 0x00020000);
    const unsigned ldsw = (unsigned)wid * 1024u;
    const int aoff = lds_byte(wr * 64 + fr, fq * 8), boff = lds_byte(wc * 32 + fr, fq * 8);
#define PG8_SA(b, h) (((b) * 2 + (h)) * HTB)
#define PG8_SB(b, h) ((4 + (b) * 2 + (h)) * HTB)
#define PG8_STAGE(bufoff, rs, soff, voff) do { if constexpr (ABL != 2) _Pragma("unroll") for (int _i = 0; _i < 2; ++_i) \
        __builtin_amdgcn_raw_ptr_buffer_load_lds(rs, (PG8_LAS unsigned*)(lds + (bufoff) + ldsw + _i * 8192), 16, (voff)[_i], (soff), 0, 0); } while (0)
#define PG8_LDA(dst, b, h) do { if constexpr (ABL != 3) _Pragma("unroll") for (int m = 0; m < 4; ++m) _Pragma("unroll") for (int k = 0; k < 2; ++k) dst[m][k] = *(const PG8_LAS bf16x8*)(lds + PG8_SA(b, h) + aoff + m * 2048 + k * 1024); } while (0)
#define PG8_LDB(dst, b, h) do { if constexpr (ABL != 3) _Pragma("unroll") for (int n = 0; n < 2; ++n) _Pragma("unroll") for (int k = 0; k < 2; ++k) dst[n][k] = *(const PG8_LAS bf16x8*)(lds + PG8_SB(b, h) + boff + n * 2048 + k * 1024); } while (0)
#define PG8_MMA(ai, bj, At, Bt) do { if (PRIO_MODE == 1) __builtin_amdgcn_s_setprio(1); else if (PRIO_MODE == 2) __builtin_amdgcn_s_setprio(0); \
        if constexpr (ABL == 4) { _Pragma("unroll") for (int m = 0; m < 4; ++m) _Pragma("unroll") for (int k = 0; k < 2; ++k) \
            acc32[ai][bj][m & 1] = __builtin_amdgcn_mfma_f32_32x32x16_f16(__builtin_bit_cast(h8_t, Bt[m & 1][k]), __builtin_bit_cast(h8_t, At[m][k]), acc32[ai][bj][m & 1], 0, 0, 0); } else \
        if constexpr (ABL != 1) _Pragma("unroll") for (int m = 0; m < 4; ++m) _Pragma("unroll") for (int n = 0; n < 2; ++n) _Pragma("unroll") for (int k = 0; k < 2; ++k) \
        acc[ai][bj][m][n] = __builtin_amdgcn_mfma_f32_16x16x32_f16(__builtin_bit_cast(h8_t, Bt[n][k]), __builtin_bit_cast(h8_t, At[m][k]), acc[ai][bj][m][n], 0, 0, 0); if (PRIO_MODE == 1) __builtin_amdgcn_s_setprio(0); else if (PRIO_MODE == 2) __builtin_amdgcn_s_setprio(1); } while (0)
#define PG8_WAIT_V(n) asm volatile("s_waitcnt vmcnt(" #n ")" ::: "memory")
#define PG8_WAIT_L(n) asm volatile("s_waitcnt lgkmcnt(" #n ")" ::: "memory")
#define PG8_BAR __builtin_amdgcn_s_barrier()
#define PG8_SCHED __builtin_amdgcn_sched_barrier(0)
    Unit cur, nxt; int ui = 0;
    if (!S.next(0, cur)) return;
    if (PROF && blockIdx.x == 0 && tid == 0) prof[6] = __builtin_amdgcn_s_memrealtime();
    f32x4 acc[2][2][4][2];
#pragma unroll
    for (int a = 0; a < 2; ++a)
#pragma unroll
        for (int b = 0; b < 2; ++b)
#pragma unroll
            for (int m = 0; m < 4; ++m)
#pragma unroll
                for (int n = 0; n < 2; ++n) acc[a][b][m][n] = (f32x4){0.f, 0.f, 0.f, 0.f};
    bf16x8 At[4][2], B0[2][2], B1[2][2];
    f32x16 acc32[2][2][2];
    if constexpr (ABL == 4) { _Pragma("unroll") for (int a = 0; a < 2; ++a) _Pragma("unroll") for (int b = 0; b < 2; ++b) _Pragma("unroll") for (int c = 0; c < 2; ++c) _Pragma("unroll") for (int r = 0; r < 16; ++r) acc32[a][b][c][r] = 0.f; }
    if constexpr (ABL == 3) { _Pragma("unroll") for (int m = 0; m < 4; ++m) _Pragma("unroll") for (int k = 0; k < 2; ++k) At[m][k] = (bf16x8){0, 0, 0, 0, 0, 0, 0, 0}; _Pragma("unroll") for (int n = 0; n < 2; ++n) _Pragma("unroll") for (int k = 0; k < 2; ++k) { B0[n][k] = (bf16x8){0, 0, 0, 0, 0, 0, 0, 0}; B1[n][k] = B0[n][k]; } }
    unsigned cA = (unsigned)cur.pm * tstep, cB = (unsigned)cur.pn * tstep;
    unsigned kb = 0u, ki = kstep;
#if !K_SERPENTINE
#define PG8_FLIP(kb_, ki_) do { } while (0)
#else
#define PG8_FLIP(kb_, ki_) do { ki_ = 0u - ki_; kb_ = (kb_ == 0u) ? (unsigned)(nt - 1) * kstep : 0u; } while (0)
#endif
    if constexpr (Epi::LDSPRE) { if (E.lds_ok) E.pre_phase(lds, cur, tid, wid, lane); }
    S.a_ready(cur);
    if constexpr (SP2 == 2) {
        PG8_STAGE(PG8_SB(0, 0), rsB, cB, voffB); PG8_STAGE(PG8_SB(0, 1), rsB, cB + hstep, voffB); PG8_STAGE(PG8_SA(0, 0), rsA, cA, voffA); PG8_STAGE(PG8_SA(0, 1), rsA, cA + hstep, voffA);
        if (wr == 1) PG8_BAR;
        PG8_WAIT_V(2); PG8_BAR;
        PG8_STAGE(PG8_SB(1, 0), rsB, cB + kstep, voffB); PG8_STAGE(PG8_SB(1, 1), rsB, cB + hstep + kstep, voffB);
        PG8_WAIT_V(6); PG8_BAR;
    } else if constexpr (SP2 == 1) {
        PG8_STAGE(PG8_SB(0, 0), rsB, cB, voffB); PG8_STAGE(PG8_SB(0, 1), rsB, cB + hstep, voffB); PG8_STAGE(PG8_SA(0, 0), rsA, cA, voffA); PG8_STAGE(PG8_SA(0, 1), rsA, cA + hstep, voffA);
        if (wr == 1) PG8_BAR;
        PG8_WAIT_V(2); PG8_BAR;
        PG8_STAGE(PG8_SB(1, 0), rsB, cB + kstep, voffB); PG8_STAGE(PG8_SA(1, 0), rsA, cA + kstep, voffA); PG8_STAGE(PG8_SB(1, 1), rsB, cB + hstep + kstep, voffB);
        PG8_WAIT_V(6); PG8_BAR;
    } else {
        PG8_STAGE(PG8_SB(0, 0), rsB, cB, voffB); PG8_STAGE(PG8_SA(0, 0), rsA, cA, voffA); PG8_STAGE(PG8_SB(0, 1), rsB, cB + hstep, voffB); PG8_STAGE(PG8_SA(0, 1), rsA, cA + hstep, voffA);
        if (wr == 1) PG8_BAR;
        PG8_WAIT_V(4); PG8_BAR;
        PG8_STAGE(PG8_SB(1, 0), rsB, cB + kstep, voffB); PG8_STAGE(PG8_SA(1, 0), rsA, cA + kstep, voffA); PG8_STAGE(PG8_SB(1, 1), rsB, cB + hstep + kstep, voffB);
        PG8_WAIT_V(6); PG8_BAR;
    }
    for (;;) {
        const bool has_next = S.next(ui + 1, nxt);
        const unsigned nA = has_next ? (unsigned)nxt.pm * tstep : cA, nB = has_next ? (unsigned)nxt.pn * tstep : cB;
        unsigned nkb = kb, nki = ki; PG8_FLIP(nkb, nki);
        for (int t = 0; t < nt; t += 2) {
            const bool last = (t == nt - 2);
            const unsigned a1 = cA + kb + (unsigned)(t + 1) * ki;
            const unsigned a2 = last ? nA + nkb : cA + kb + (unsigned)(t + 2) * ki, b2 = last ? nB + nkb : cB + kb + (unsigned)(t + 2) * ki;
            const unsigned a3 = a2 + (last ? nki : ki), b3 = b2 + (last ? nki : ki);
            if (last && has_next) S.a_ready(nxt);
            if constexpr (SP2 == 2) {
            PG8_LDB(B0, 0, 0); PG8_LDB(B1, 0, 1); PG8_SCHED; PG8_LDA(At, 0, 0); PG8_STAGE(PG8_SA(1, 0), rsA, a1, voffA); PG8_STAGE(PG8_SA(1, 1), rsA, a1 + hstep, voffA);
            PG8_WAIT_V(8); PG8_WAIT_L(0); PG8_BAR; PG8_MMA(0, 0, At, B0); PG8_MMA(0, 1, At, B1); PG8_BAR; PG8_SCHED;
            PG8_LDA(At, 0, 1); PG8_STAGE(PG8_SB(0, 0), rsB, b2, voffB); PG8_STAGE(PG8_SB(0, 1), rsB, b2 + hstep, voffB);
            PG8_WAIT_V(6); PG8_WAIT_L(0); PG8_BAR; PG8_MMA(1, 0, At, B0); PG8_MMA(1, 1, At, B1); PG8_BAR; PG8_SCHED;
            PG8_LDB(B0, 1, 0); PG8_LDB(B1, 1, 1); PG8_SCHED; PG8_LDA(At, 1, 0); PG8_STAGE(PG8_SA(0, 0), rsA, a2, voffA); PG8_STAGE(PG8_SA(0, 1), rsA, a2 + hstep, voffA);
            PG8_WAIT_V(8); PG8_WAIT_L(0); PG8_BAR; PG8_MMA(0, 0, At, B0); PG8_MMA(0, 1, At, B1); PG8_BAR; PG8_SCHED;
            PG8_LDA(At, 1, 1); PG8_STAGE(PG8_SB(1, 0), rsB, b3, voffB); PG8_STAGE(PG8_SB(1, 1), rsB, b3 + hstep, voffB);
            PG8_WAIT_V(6); PG8_WAIT_L(0); PG8_BAR; PG8_MMA(1, 0, At, B0); PG8_MMA(1, 1, At, B1); PG8_BAR; PG8_SCHED;
            } else if constexpr (SP2 == 1) {
            PG8_LDB(B0, 0, 0); PG8_LDB(B1, 0, 1); PG8_SCHED; PG8_LDA(At, 0, 0); PG8_STAGE(PG8_SA(1, 1), rsA, a1 + hstep, voffA);
            PG8_WAIT_V(8); PG8_WAIT_L(0); PG8_BAR; PG8_MMA(0, 0, At, B0); PG8_MMA(0, 1, At, B1); PG8_BAR; PG8_SCHED;
            PG8_LDA(At, 0, 1); PG8_STAGE(PG8_SB(0, 0), rsB, b2, voffB); PG8_STAGE(PG8_SB(0, 1), rsB, b2 + hstep, voffB); PG8_STAGE(PG8_SA(0, 0), rsA, a2, voffA);
            PG8_WAIT_V(8); PG8_WAIT_L(0); PG8_BAR; PG8_MMA(1, 0, At, B0); PG8_MMA(1, 1, At, B1); PG8_BAR; PG8_SCHED;
            PG8_LDB(B0, 1, 0); PG8_LDB(B1, 1, 1); PG8_SCHED; PG8_LDA(At, 1, 0); PG8_STAGE(PG8_SA(0, 1), rsA, a2 + hstep, voffA);
            PG8_WAIT_V(8); PG8_WAIT_L(0); PG8_BAR; PG8_MMA(0, 0, At, B0); PG8_MMA(0, 1, At, B1); PG8_BAR; PG8_SCHED;
            PG8_LDA(At, 1, 1); PG8_STAGE(PG8_SB(1, 0), rsB, b3, voffB); PG8_STAGE(PG8_SB(1, 1), rsB, b3 + hstep, voffB); PG8_STAGE(PG8_SA(1, 0), rsA, a3, voffA);
            PG8_WAIT_V(8); PG8_WAIT_L(0); PG8_BAR; PG8_MMA(1, 0, At, B0); PG8_MMA(1, 1, At, B1); PG8_BAR; PG8_SCHED;
            } else {
            PG8_LDB(B0, 0, 0); PG8_SCHED; PG8_LDA(At, 0, 0); PG8_STAGE(PG8_SA(1, 1), rsA, a1 + hstep, voffA);
            PG8_WAIT_L(8); PG8_BAR; PG8_WAIT_L(0); PG8_MMA(0, 0, At, B0); PG8_BAR; PG8_SCHED;
            PG8_LDB(B1, 0, 1); PG8_STAGE(PG8_SB(0, 0), rsB, b2, voffB);
            PG8_BAR; PG8_WAIT_L(0); PG8_MMA(0, 1, At, B1); PG8_BAR;
            PG8_LDA(At, 0, 1); PG8_STAGE(PG8_SA(0, 0), rsA, a2, voffA);
            PG8_BAR; PG8_WAIT_L(0); PG8_MMA(1, 0, At, B0); PG8_BAR; PG8_SCHED;
            PG8_STAGE(PG8_SB(0, 1), rsB, b2 + hstep, voffB);
            PG8_WAIT_V(6); PG8_BAR; PG8_MMA(1, 1, At, B1); PG8_BAR;
            PG8_LDB(B0, 1, 0); PG8_SCHED; PG8_LDA(At, 1, 0); PG8_STAGE(PG8_SA(0, 1), rsA, a2 + hstep, voffA);
            PG8_WAIT_L(8); PG8_BAR; PG8_WAIT_L(0); PG8_MMA(0, 0, At, B0); PG8_BAR; PG8_SCHED;
            PG8_LDB(B1, 1, 1); PG8_STAGE(PG8_SB(1, 0), rsB, b3, voffB);
            PG8_BAR; PG8_WAIT_L(0); PG8_MMA(0, 1, At, B1); PG8_BAR;
            PG8_LDA(At, 1, 1); PG8_STAGE(PG8_SA(1, 0), rsA, a3, voffA);
            PG8_BAR; PG8_WAIT_L(0); PG8_MMA(1, 0, At, B0); PG8_BAR; PG8_SCHED;
            PG8_STAGE(PG8_SB(1, 1), rsB, b3 + hstep, voffB);
            PG8_WAIT_V(6); PG8_BAR; PG8_MMA(1, 1, At, B1); PG8_BAR;
            }
        }
        if (PROF && blockIdx.x == 0 && tid == 0) { const unsigned long long n_ = __builtin_amdgcn_s_memrealtime(); prof[0] += n_ - prof[6]; prof[6] = n_; }
        if constexpr (ALIGN_EPI) { if (wr == 0) PG8_BAR; }
        if constexpr (Epi::LDSPRE) { if (E.lds_ok) { if (has_next) E.pre_unit(lds, nxt, (ui + 1) & 1, wid, lane); E.run_lds(lds, acc, cur, ui & 1, wr, wc, fr, fq); } else E(acc, cur, wr, wc, fr, fq); } else
        E(acc, cur, wr, wc, fr, fq);
        if constexpr (ABL == 4) { _Pragma("unroll") for (int a = 0; a < 2; ++a) _Pragma("unroll") for (int b = 0; b < 2; ++b) _Pragma("unroll") for (int c = 0; c < 2; ++c) asm volatile("" :: "v"(acc32[a][b][c])); }
        if constexpr (REP_EPI) { asm volatile("" ::: "memory"); E(acc, cur, wr, wc, fr, fq); }
        if (PROF && blockIdx.x == 0 && tid == 0) { asm volatile("s_waitcnt vmcnt(0)" ::: "memory"); const unsigned long long n_ = __builtin_amdgcn_s_memrealtime(); prof[1] += n_ - prof[6]; prof[6] = n_; }
        if (!has_next) break;
#pragma unroll
        for (int a = 0; a < 2; ++a)
#pragma unroll
            for (int b = 0; b < 2; ++b)
#pragma unroll
                for (int m = 0; m < 4; ++m)
#pragma unroll
                    for (int n = 0; n < 2; ++n) acc[a][b][m][n] = (f32x4){0.f, 0.f, 0.f, 0.f};
        cur = nxt; cA = nA; cB = nB; kb = nkb; ki = nki; ++ui;
        if constexpr (ALIGN_EPI) { if (wr == 1) PG8_BAR; }
    }
    PG8_WAIT_V(0);
    if constexpr (!ALIGN_EPI) { if (wr == 0) PG8_BAR; }
    PG8_BAR;
#undef PG8_FLIP
#undef PG8_SA
#undef PG8_SB
#undef PG8_STAGE
#undef PG8_LDA
#undef PG8_LDB
#undef PG8_MMA
#undef PG8_WAIT_V
#undef PG8_WAIT_L
#undef PG8_BAR
#undef PG8_SCHED
}
}

__device__ __forceinline__ float silu_mul(float g, float u) { return g * u * __builtin_amdgcn_rcpf(1.0f + __builtin_amdgcn_exp2f(-1.4426950408889634f * g)); }
__device__ __forceinline__ f32x4 silu_mul4(f32x4 g, f32x4 u) { return (f32x4){silu_mul(g[0], u[0]), silu_mul(g[1], u[1]), silu_mul(g[2], u[2]), silu_mul(g[3], u[3])}; }
__device__ __forceinline__ u32x2 pk4(f32x4 v) { u32x2 w; w.x = pk2(v[0], v[1]); w.y = pk2(v[2], v[3]); return w; }
__device__ __forceinline__ int uni(int v) { return __builtin_amdgcn_readfirstlane(v); }
__device__ __forceinline__ unsigned char* opaque_ws(unsigned char* ws) { const unsigned long long w0 = (unsigned long long)ws; unsigned lo = (unsigned)uni((int)(unsigned)w0), hi = (unsigned)uni((int)(unsigned)(w0 >> 32)); asm volatile("" : "+s"(lo), "+s"(hi));
    return (unsigned char*)(GAS unsigned char*)(((unsigned long long)hi << 32) | lo); }
struct LnFold { int q, cgo;
    __device__ __forceinline__ void get(unsigned char* ws, const float*& stats, const float*& cg, const float*& cb) const {
        int q_ = uni(q), o_ = uni(cgo); asm volatile("" : "+s"(q_), "+s"(o_));
        stats = (const float*)(ws + WS_STATS + (size_t)q_ * STATS_BYTES); cg = (const float*)(ws + WS_CG) + o_; cb = (const float*)(ws + WS_CB) + o_; }
};
__device__ __forceinline__ void row_norm(const float* stats, int row, float& rstd, float& t) {
    const f2_t sq = *(const f2_t*)(stats + 2 * (size_t)row); const float mu = sq.x * (1.f / D), var = sq.y * (1.f / D) - mu * mu;
    rstd = __builtin_amdgcn_rsqf(var + LN_EPS); t = -mu * rstd;
}
__device__ __forceinline__ f32x4 lnfix(f32x4 acc, float rstd, float t, f32x4 cg, f32x4 cb) { return acc * rstd + (cg * t + cb); }
__device__ __forceinline__ void stats_add(float* st, int row, float s, float q, int fq) {
    s += __shfl_xor(s, 16); s += __shfl_xor(s, 32); q += __shfl_xor(q, 16); q += __shfl_xor(q, 32);
    if (fq < 2) __hip_atomic_fetch_add(st + 2 * (size_t)row + fq, fq == 0 ? s : q, __ATOMIC_RELAXED, __HIP_MEMORY_SCOPE_AGENT);
}
#define LOAD_CGCB(cgp, cbp, tc0) f32x4 cg[2][2], cb[2][2]; _Pragma("unroll") for (int bj = 0; bj < 2; ++bj) _Pragma("unroll") for (int n = 0; n < 2; ++n) { \
        cg[bj][n] = *(const f32x4*)((cgp) + (tc0) + 128 * bj + 4 * n); cb[bj][n] = *(const f32x4*)((cbp) + (tc0) + 128 * bj + 4 * n); }

constexpr int LF_RT_OFF = RING_BYTES + 4096, LF_CGCB_OFF = LF_RT_OFF + 2048;
__device__ __forceinline__ void lf_pre_unit(unsigned char* ws0, const LnFold& L, PG8_LAS unsigned char* lds, const pg8::Unit& u, int slot, int wid, int lane) {
    if (wid < 2) { unsigned char* ws = opaque_ws(ws0); int o_ = uni(L.cgo); asm volatile("" : "+s"(o_));
        const __amdgpu_buffer_rsrc_t rs = __builtin_amdgcn_make_buffer_rsrc((void*)(ws + WS_CG), (short)0, 0x7ffffff0, 0x00020000);
        __builtin_amdgcn_raw_ptr_buffer_load_lds(rs, (PG8_LAS unsigned*)(lds + LF_CGCB_OFF + slot * 2048 + wid * 1024), 16, (unsigned)lane_id() * 16u, (unsigned)(o_ + u.pn * 256) * 4u + (unsigned)wid * (unsigned)(NCGCB * 4), 0, 0); }
}
__device__ __forceinline__ void lf_pre_phase(unsigned char* ws0, const LnFold& L, PG8_LAS unsigned char* lds, const pg8::Unit& u, int tid, int wid, int lane) {
    lf_pre_unit(ws0, L, lds, u, 0, wid, lane);
    if (tid < 256) { unsigned char* ws = opaque_ws(ws0); const float *stats, *cgp, *cbp; L.get(ws, stats, cgp, cbp); float rstd, t; row_norm(stats, u.pm * 256 + tid, rstd, t);
        *(PG8_LAS f2_t*)(lds + LF_RT_OFF + tid * 8) = (f2_t){rstd, t}; }
    __syncthreads();
}
#define LF_RT(LDS_, i_) ((LDS_) ? *(const PG8_LAS f2_t*)(rtl + (((i_) >> 2) * 128 + ((i_) & 3) * 16) * 8) : rtv[i_])
#define LF_OPERANDS(LDS_, tc0_) f32x4 cg[2][2], cb[2][2]; f2_t rtv[8]; const PG8_LAS unsigned char* rtl = nullptr; \
    if constexpr (LDS_) { int fq_ = fq, fr_ = fr; asm volatile("" : "+v"(fq_), "+v"(fr_));     \
        const PG8_LAS unsigned char* cgl_ = lds + LF_CGCB_OFF + slot * 2048 + (wc * 32 + 8 * fq_) * 4; const PG8_LAS unsigned char* rtl_ = lds + LF_RT_OFF + (wr * 64 + fr_) * 8; \
        _Pragma("unroll") for (int bj = 0; bj < 2; ++bj) _Pragma("unroll") for (int n = 0; n < 2; ++n) { cg[bj][n] = *(const PG8_LAS f32x4*)(cgl_ + (128 * bj + 4 * n) * 4); cb[bj][n] = *(const PG8_LAS f32x4*)(cgl_ + 1024 + (128 * bj + 4 * n) * 4); } \
        rtl = rtl_; \
    } else { const float *stats, *cgp, *cbp; L.get(ws, stats, cgp, cbp); \
        _Pragma("unroll") for (int bj = 0; bj < 2; ++bj) _Pragma("unroll") for (int n = 0; n < 2; ++n) { cg[bj][n] = *(const f32x4*)(cgp + (tc0_) + 128 * bj + 4 * n); cb[bj][n] = *(const f32x4*)(cbp + (tc0_) + 128 * bj + 4 * n); } \
        _Pragma("unroll") for (int i = 0; i < 8; ++i) { float rstd_, t_; row_norm(stats, row0 + (i >> 2) * 128 + (i & 3) * 16, rstd_, t_); rtv[i] = (f2_t){rstd_, t_}; } }
#define LF_MEMBERS bool lds_ok = false; \
    __device__ __forceinline__ void pre_unit(PG8_LAS unsigned char* lds, const pg8::Unit& u, int slot, int wid, int lane) const { lf_pre_unit(ws0, L, lds, u, slot, wid, lane); } \
    __device__ __forceinline__ void pre_phase(PG8_LAS unsigned char* lds, const pg8::Unit& u, int tid, int wid, int lane) const { lf_pre_phase(ws0, L, lds, u, tid, wid, lane); } \
    __device__ __forceinline__ void operator()(const f32x4 (&acc)[2][2][4][2], const pg8::Unit& u, int wr, int wc, int fr, int fq) const { body<false>(nullptr, 0, acc, u, wr, wc, fr, fq); } \
    __device__ __forceinline__ void run_lds(PG8_LAS unsigned char* lds, const f32x4 (&acc)[2][2][4][2], const pg8::Unit& u, int slot, int wr, int wc, int fr, int fq) const { body<true>(lds, slot, acc, u, wr, wc, fr, fq); }
struct EpiSwiglu {
    static constexpr bool PERM = true; static constexpr bool LDSPRE = true;
    unsigned char* ws0; LnFold L; bool lds_ok = false;
    static constexpr int RT_OFF = RING_BYTES + 4096, CGCB_OFF = RT_OFF + 2048;
    __device__ __forceinline__ void pre_unit(PG8_LAS unsigned char* lds, const pg8::Unit& u, int slot, int wid, int lane) const {
        if (wid < 2) { unsigned char* ws = opaque_ws(ws0); int o_ = uni(L.cgo); asm volatile("" : "+s"(o_));
            const __amdgpu_buffer_rsrc_t rs = __builtin_amdgcn_make_buffer_rsrc((void*)(ws + WS_CG), (short)0, 0x7ffffff0, 0x00020000);
            __builtin_amdgcn_raw_ptr_buffer_load_lds(rs, (PG8_LAS unsigned*)(lds + CGCB_OFF + slot * 2048 + wid * 1024), 16, (unsigned)lane * 16u, (unsigned)(o_ + u.pn * 256) * 4u + (unsigned)wid * (unsigned)(NCGCB * 4), 0, 0); }
    }
    __device__ __forceinline__ void pre_phase(PG8_LAS unsigned char* lds, const pg8::Unit& u, int tid, int wid, int lane) const {
        pre_unit(lds, u, 0, wid, lane);
        if (tid < 256) { unsigned char* ws = opaque_ws(ws0); const float *stats, *cgp, *cbp; L.get(ws, stats, cgp, cbp); float rstd, t; row_norm(stats, u.pm * 256 + tid, rstd, t);
            *(PG8_LAS f2_t*)(lds + RT_OFF + tid * 8) = (f2_t){rstd, t}; }
        __syncthreads();
    }
    __device__ __forceinline__ void run_lds(PG8_LAS unsigned char* lds, const f32x4 (&acc)[2][2][4][2], const pg8::Unit& u, int slot, int wr, int wc, int fr, int fq) const {
        unsigned char* ws = opaque_ws(ws0); bf16_t* O = (bf16_t*)(ws + WS_ACT);
        const int row0 = u.pm * 256 + wr * 64 + fr, col0 = u.pn * 128 + wc * 32 + 8 * fq;
        const PG8_LAS unsigned char* cgl = lds + CGCB_OFF + slot * 2048 + (wc * 32 + 8 * fq) * 4; const PG8_LAS unsigned char* rtl = lds + RT_OFF + (wr * 64 + fr) * 8;
        f32x4 cg[2][2], cb[2][2];
#pragma unroll
        for (int bj = 0; bj < 2; ++bj)
#pragma unroll
            for (int n = 0; n < 2; ++n) { cg[bj][n] = *(const PG8_LAS f32x4*)(cgl + (128 * bj + 4 * n) * 4); cb[bj][n] = *(const PG8_LAS f32x4*)(cgl + 1024 + (128 * bj + 4 * n) * 4); }
#pragma unroll
        for (int ai = 0; ai < 2; ++ai)
#pragma unroll
            for (int m = 0; m < 4; ++m) { const int row = row0 + ai * 128 + m * 16; const f2_t rt = *(const PG8_LAS f2_t*)(rtl + (ai * 128 + m * 16) * 8); const float rstd = rt.x, t = rt.y;
                const u32x2 a = pk4(silu_mul4(lnfix(acc[ai][0][m][0], rstd, t, cg[0][0], cb[0][0]), lnfix(acc[ai][1][m][0], rstd, t, cg[1][0], cb[1][0])));
                const u32x2 b = pk4(silu_mul4(lnfix(acc[ai][0][m][1], rstd, t, cg[0][1], cb[0][1]), lnfix(acc[ai][1][m][1], rstd, t, cg[1][1], cb[1][1])));
                *(u32x4*)(O + (size_t)row * FF + col0) = (u32x4){a.x, a.y, b.x, b.y}; }
    }
    __device__ __forceinline__ void operator()(const f32x4 (&acc)[2][2][4][2], const pg8::Unit& u, int wr, int wc, int fr, int fq) const {
        unsigned char* ws = opaque_ws(ws0); bf16_t* O = (bf16_t*)(ws + WS_ACT); const float *stats, *cgp, *cbp; L.get(ws, stats, cgp, cbp);
        const int row0 = u.pm * 256 + wr * 64 + fr, col0 = u.pn * 128 + wc * 32 + 8 * fq, tc0 = u.pn * 256 + wc * 32 + 8 * fq;
        LOAD_CGCB(cgp, cbp, tc0)
#pragma unroll
        for (int ai = 0; ai < 2; ++ai)
#pragma unroll
            for (int m = 0; m < 4; ++m) { const int row = row0 + ai * 128 + m * 16; float rstd, t; row_norm(stats, row, rstd, t);
                const u32x2 a = pk4(silu_mul4(lnfix(acc[ai][0][m][0], rstd, t, cg[0][0], cb[0][0]), lnfix(acc[ai][1][m][0], rstd, t, cg[1][0], cb[1][0])));
                const u32x2 b = pk4(silu_mul4(lnfix(acc[ai][0][m][1], rstd, t, cg[0][1], cb[0][1]), lnfix(acc[ai][1][m][1], rstd, t, cg[1][1], cb[1][1])));
                *(u32x4*)(O + (size_t)row * FF + col0) = (u32x4){a.x, a.y, b.x, b.y}; }
    }
    __device__ __forceinline__ void meta(int r, int col, f32x4 g, f32x4 up) const {
        unsigned char* ws = opaque_ws(ws0); bf16_t* O = (bf16_t*)(ws + WS_ACT); const float *stats, *cgp, *cbp; L.get(ws, stats, cgp, cbp);
        const int row = MREAL + r, tc = 256 * (col >> 7) + (col & 127); float rstd, t; row_norm(stats, row, rstd, t);
        g = lnfix(g, rstd, t, *(const f32x4*)(cgp + tc), *(const f32x4*)(cbp + tc)); up = lnfix(up, rstd, t, *(const f32x4*)(cgp + tc + 128), *(const f32x4*)(cbp + tc + 128));
        *(u32x2*)(O + (size_t)row * FF + col) = pk4(silu_mul4(g, up)); }
};
struct EpiNull { static constexpr bool PERM = true; static constexpr bool LDSPRE = false;
    __device__ __forceinline__ void operator()(const f32x4 (&acc)[2][2][4][2], const pg8::Unit&, int, int, int, int) const {
#pragma unroll
        for (int a = 0; a < 2; ++a)
#pragma unroll
            for (int b = 0; b < 2; ++b)
#pragma unroll
                for (int m = 0; m < 4; ++m)
#pragma unroll
                    for (int n = 0; n < 2; ++n) asm volatile("" :: "v"(acc[a][b][m][n])); } };
struct RangeOrder : pg8::StaticOrder { int r0, r1;
    __device__ bool next(int i, pg8::Unit& u) const { return (i + r0 < r1) && pg8::StaticOrder::next(i + r0, u); } };
struct FakeOrder : pg8::StaticOrder { int nun;
    __device__ bool next(int i, pg8::Unit& u) const { u.pm = 0; u.pn = 0; return i < nun; } };
struct EpiResidLN {
    static constexpr bool PERM = true; static constexpr bool LDSPRE = false; static constexpr bool dry = false; static constexpr int XM = 0;
    unsigned char* ws0; int qprev, qnew; float coef;
    __device__ __forceinline__ void operator()(const f32x4 (&acc)[2][2][4][2], const pg8::Unit& u, int wr, int wc, int fr, int fq) const {
        unsigned char* ws = opaque_ws(ws0); int qp = uni(qprev), qn = uni(qnew); asm volatile("" : "+s"(qp), "+s"(qn));
        typedef __amdgpu_buffer_rsrc_t rsrc_t;
#define MKRS(p_) __builtin_amdgcn_make_buffer_rsrc((void*)(p_), (short)0, 0x7ffffff0, 0x00020000)
        const rsrc_t rsH = MKRS(ws + WS_HB), rsO = MKRS(dry ? ws + WS_X32 : ws + WS_HB), rsS = MKRS(ws + WS_STATS + (size_t)qp * STATS_BYTES), rsN = MKRS(ws + WS_STATS + (size_t)qn * STATS_BYTES);
        const rsrc_t rsG = MKRS(ws + WS_LNG + (size_t)qp * D * 4), rsB = MKRS(ws + WS_LNB + (size_t)qp * D * 4);
#undef MKRS
        const int row0 = u.pm * 256 + wr * 64 + fr, ccol = u.pn * 256 + wc * 32 + 8 * fq;
        const unsigned hvo = (unsigned)(row0 * D + ccol) * 2u, svo = (unsigned)row0 * 8u, gvo = (unsigned)ccol * 4u;
        f32x4 gv[2][2], bv[2][2];
#pragma unroll
        for (int bj = 0; bj < 2; ++bj)
#pragma unroll
            for (int n = 0; n < 2; ++n) { gv[bj][n] = __builtin_bit_cast(f32x4, __builtin_amdgcn_raw_buffer_load_b128(rsG, (int)(gvo + 512u * bj + 16u * n), 0, 0)); bv[bj][n] = __builtin_bit_cast(f32x4, __builtin_amdgcn_raw_buffer_load_b128(rsB, (int)(gvo + 512u * bj + 16u * n), 0, 0)); }
        float S[8], Q[8];
        u32x4 hw[2][4][2]; u32x2 sw[2][4];
#define RL_LOAD(ai_) _Pragma("unroll") for (int m = 0; m < 4; ++m) { sw[ai_][m] = __builtin_amdgcn_raw_buffer_load_b64(rsS, (int)(svo + (unsigned)(128 * (ai_) + 16 * m) * 8u), 0, 0); \
            _Pragma("unroll") for (int bj = 0; bj < 2; ++bj) hw[ai_][m][bj] = (XM == 3) ? (u32x4){0x3c003c00u, 0x3c003c00u, 0x3c003c00u, 0x3c003c00u} : __builtin_amdgcn_raw_buffer_load_b128(rsH, (int)(hvo + 256u * bj), (128 * (ai_) + 16 * m) * (D * 2), 0); }
#define RL_STATS(i0_) do { const bool b0_ = (fq & 1) != 0, b1_ = (fq & 2) != 0; \
            const float y0_ = (b0_ ? Q[i0_] : S[i0_]) + __shfl_xor(b0_ ? S[i0_] : Q[i0_], 16), y1_ = (b0_ ? Q[(i0_) + 1] : S[(i0_) + 1]) + __shfl_xor(b0_ ? S[(i0_) + 1] : Q[(i0_) + 1], 16); \
            const float tot_ = (b1_ ? y1_ : y0_) + __shfl_xor(b1_ ? y0_ : y1_, 32); \
            if (XM != 2) __builtin_amdgcn_raw_ptr_buffer_atomic_fadd_f32(tot_, rsN, (int)(svo + 4u * (fq & 1) + (unsigned)(128 * ((i0_) >> 2) + 16 * ((i0_) & 3) + (b1_ ? 16 : 0)) * 8u), 0, 0); } while (0)
        RL_LOAD(0);
        __builtin_amdgcn_sched_barrier(0);
#pragma unroll
        for (int ai = 0; ai < 2; ++ai) {
#pragma unroll
            for (int m = 0; m < 4; ++m) { float s = 0.f, q = 0.f;
                if (ai == 0 && m == 2) { RL_LOAD(1); __builtin_amdgcn_sched_barrier(0); }
                const float mu = __uint_as_float(sw[ai][m].x) * (1.f / D), var = __uint_as_float(sw[ai][m].y) * (1.f / D) - mu * mu, rstd = __builtin_amdgcn_rsqf(var + LN_EPS), t = -mu * rstd;
#pragma unroll
                for (int bj = 0; bj < 2; ++bj) { const u32x4 w = hw[ai][m][bj];
                    const f32x4 h0 = {bf_lo(w.x), bf_hi(w.x), bf_lo(w.y), bf_hi(w.y)}, h1 = {bf_lo(w.z), bf_hi(w.z), bf_lo(w.w), bf_hi(w.w)};
                    const f32x4 r0 = ((h0 * rstd + t) * gv[bj][0] + bv[bj][0]) * ALPHA + acc[ai][bj][m][0] * coef, r1 = ((h1 * rstd + t) * gv[bj][1] + bv[bj][1]) * ALPHA + acc[ai][bj][m][1] * coef;
                    const u32x2 a = pk4(r0), c = pk4(r1); if (XM != 4) *(u32x4*)(ws + (dry ? WS_X32 : WS_HB) + (size_t)((128 * ai + 16 * m) * (D * 2) + 256 * bj) + (size_t)hvo) = (u32x4){a.x, a.y, c.x, c.y};
                    s += ((r0[0] + r0[1]) + (r0[2] + r0[3])) + ((r1[0] + r1[1]) + (r1[2] + r1[3]));
                    q += ((r0[0] * r0[0] + r0[1] * r0[1]) + (r0[2] * r0[2] + r0[3] * r0[3])) + ((r1[0] * r1[0] + r1[1] * r1[1]) + (r1[2] * r1[2] + r1[3] * r1[3])); }
                S[ai * 4 + m] = s; Q[ai * 4 + m] = q; __builtin_amdgcn_sched_barrier(0);
                if (m == 1) RL_STATS(ai * 4); if (m == 3) RL_STATS(ai * 4 + 2); } }
#undef RL_LOAD
#undef RL_STATS
    }
    __device__ __forceinline__ void meta(int r, int col, f32x4 a, f32x4) const {
        unsigned char* ws = opaque_ws(ws0); int qp = uni(qprev), qn = uni(qnew); asm volatile("" : "+s"(qp), "+s"(qn));
        bf16_t* Hb = (bf16_t*)(ws + WS_HB);
        const float* st_prev = (const float*)(ws + WS_STATS + (size_t)qp * STATS_BYTES); float* st_new = (float*)(ws + WS_STATS + (size_t)qn * STATS_BYTES);
        const float* g = (const float*)(ws + WS_LNG) + (size_t)qp * D; const float* b = (const float*)(ws + WS_LNB) + (size_t)qp * D;
        const int row = MREAL + r; float rstd, t; row_norm(st_prev, row, rstd, t);
        const u32x2 w = *(const u32x2*)(Hb + (size_t)row * D + col); const f32x4 h = {bf_lo(w.x), bf_hi(w.x), bf_lo(w.y), bf_hi(w.y)};
        const f32x4 rr = ((h * rstd + t) * *(const f32x4*)(g + col) + *(const f32x4*)(b + col)) * ALPHA + a * coef;
        *(u32x2*)(Hb + (size_t)row * D + col) = pk4(rr);
        stats_add(st_new, row, (rr[0] + rr[1]) + (rr[2] + rr[3]), (rr[0] * rr[0] + rr[1] * rr[1]) + (rr[2] * rr[2] + rr[3] * rr[3]), col >> 2 & 3); }
};
struct EpiConvIn {
    static constexpr bool PERM = true; static constexpr bool LDSPRE = true;
    unsigned char* ws0; LnFold L; LF_MEMBERS
    template <bool LDS> __device__ __forceinline__ void body(PG8_LAS unsigned char* lds, int slot, const f32x4 (&acc)[2][2][4][2], const pg8::Unit& u, int wr, int wc, int fr, int fq) const {
        unsigned char* ws = opaque_ws(ws0); bf16_t* V = (bf16_t*)(ws + WS_ACT); bf16_t* BG = (bf16_t*)(ws + WS_ACT + ACT_SUB);
        const int row0 = u.pm * 256 + wr * 64 + fr, tc0 = u.pn * 256 + wc * 32 + 8 * fq;
        LF_OPERANDS(LDS, tc0)
        if (u.pn < 16) {
            const int col0 = u.pn * 128 + wc * 32 + 8 * fq;
#pragma unroll
            for (int ai = 0; ai < 2; ++ai)
#pragma unroll
                for (int m = 0; m < 4; ++m) { const int row = row0 + ai * 128 + m * 16; const f2_t rt_ = LF_RT(LDS, ai * 4 + m); const float rstd = rt_.x, t = rt_.y;
                    const u32x2 a = pk4(lnfix(acc[ai][0][m][0], rstd, t, cg[0][0], cb[0][0]) * lnfix(acc[ai][1][m][0], rstd, t, cg[1][0], cb[1][0]));
                    const u32x2 b = pk4(lnfix(acc[ai][0][m][1], rstd, t, cg[0][1], cb[0][1]) * lnfix(acc[ai][1][m][1], rstd, t, cg[1][1], cb[1][1]));
                    *(u32x4*)(V + (size_t)row * D + col0) = (u32x4){a.x, a.y, b.x, b.y}; }
        } else {
            const int col0 = (u.pn - 16) * 256 + wc * 32 + 8 * fq;
#pragma unroll
            for (int ai = 0; ai < 2; ++ai)
#pragma unroll
                for (int m = 0; m < 4; ++m) { const int row = row0 + ai * 128 + m * 16; const f2_t rt_ = LF_RT(LDS, ai * 4 + m); const float rstd = rt_.x, t = rt_.y; bf16_t* p = BG + (size_t)row * D + col0;
#pragma unroll
                    for (int bj = 0; bj < 2; ++bj) { const u32x2 a = pk4(lnfix(acc[ai][bj][m][0], rstd, t, cg[bj][0], cb[bj][0])), b = pk4(lnfix(acc[ai][bj][m][1], rstd, t, cg[bj][1], cb[bj][1]));
                        *(u32x4*)(p + bj * 128) = (u32x4){a.x, a.y, b.x, b.y}; } }
        }
    }
};
struct MetaConvV { unsigned char* ws0; LnFold L;
    __device__ __forceinline__ void meta(int r, int col, f32x4 c, f32x4 uu) const {
        unsigned char* ws = opaque_ws(ws0); bf16_t* V = (bf16_t*)(ws + WS_ACT); const float *stats, *cgp, *cbp; L.get(ws, stats, cgp, cbp);
        const int row = MREAL + r, tc = 256 * (col >> 7) + (col & 127); float rstd, t; row_norm(stats, row, rstd, t);
        c = lnfix(c, rstd, t, *(const f32x4*)(cgp + tc), *(const f32x4*)(cbp + tc)); uu = lnfix(uu, rstd, t, *(const f32x4*)(cgp + tc + 128), *(const f32x4*)(cbp + tc + 128));
        *(u32x2*)(V + (size_t)row * D + col) = pk4(c * uu); } };
struct EpiBf16S {
    static constexpr bool PERM = true; static constexpr bool LDSPRE = true;
    unsigned char* ws0; size_t ooff; float scale; LnFold L; LF_MEMBERS
    template <bool LDS> __device__ __forceinline__ void body(PG8_LAS unsigned char* lds, int slot, const f32x4 (&acc)[2][2][4][2], const pg8::Unit& u, int wr, int wc, int fr, int fq) const {
        unsigned char* ws = opaque_ws(ws0); bf16_t* O = (bf16_t*)(ws + ooff);
        const int row0 = u.pm * 256 + wr * 64 + fr, col0 = u.pn * 256 + wc * 32 + 8 * fq;
        LF_OPERANDS(LDS, col0)
#pragma unroll
        for (int ai = 0; ai < 2; ++ai)
#pragma unroll
            for (int m = 0; m < 4; ++m) { const int row = row0 + ai * 128 + m * 16; const f2_t rt_ = LF_RT(LDS, ai * 4 + m); const float rstd = rt_.x, t = rt_.y; bf16_t* p = O + (size_t)row * D + col0;
#pragma unroll
                for (int bj = 0; bj < 2; ++bj) { const u32x2 a = pk4(lnfix(acc[ai][bj][m][0], rstd, t, cg[bj][0], cb[bj][0]) * scale), b = pk4(lnfix(acc[ai][bj][m][1], rstd, t, cg[bj][1], cb[bj][1]) * scale);
                    *(u32x4*)(p + bj * 128) = (u32x4){a.x, a.y, b.x, b.y}; } }
    }
    __device__ __forceinline__ void meta(int r, int col, f32x4 a, f32x4) const {
        unsigned char* ws = opaque_ws(ws0); bf16_t* O = (bf16_t*)(ws + ooff); const float *stats, *cgp, *cbp; L.get(ws, stats, cgp, cbp);
        const int row = MREAL + r; float rstd, t; row_norm(stats, row, rstd, t);
        *(u32x2*)(O + (size_t)row * D + col) = pk4(lnfix(a, rstd, t, *(const f32x4*)(cgp + col), *(const f32x4*)(cbp + col)) * scale); }
};
__device__ __forceinline__ int vperm(int ts) { return (ts & ~12) | ((ts & 4) << 1) | ((ts & 8) >> 1); }
struct EpiKV {
    static constexpr bool PERM = true; static constexpr bool LDSPRE = false;
    unsigned char* ws0; LnFold L;
    __device__ __forceinline__ void operator()(const f32x4 (&acc)[2][2][4][2], const pg8::Unit& u, int wr, int wc, int fr, int fq) const {
        unsigned char* ws = opaque_ws(ws0); bf16_t* KB = (bf16_t*)(ws + WS_KB); bf16_t* VT = (bf16_t*)(ws + WS_VT); const float *stats, *cgp, *cbp; L.get(ws, stats, cgp, cbp);
        const int row0 = u.pm * 256 + wr * 64 + fr, d0 = wc * 32 + 8 * fq, tc0 = u.pn * 256 + wc * 32 + 8 * fq;
        LOAD_CGCB(cgp, cbp, tc0)
        if (u.pn < 8) {
#pragma unroll
            for (int ai = 0; ai < 2; ++ai)
#pragma unroll
                for (int m = 0; m < 4; ++m) { const int row = row0 + ai * 128 + m * 16, b = row >> 11, ts = 32 + (row & 2047); float rstd, t; row_norm(stats, row, rstd, t);
#pragma unroll
                    for (int bj = 0; bj < 2; ++bj) { const int h = 2 * u.pn + bj; bf16_t* p = KB + ((size_t)(b * NH + h) * TS + ts) * HD + d0;
                        const u32x2 a = pk4(lnfix(acc[ai][bj][m][0], rstd, t, cg[bj][0], cb[bj][0])), bq = pk4(lnfix(acc[ai][bj][m][1], rstd, t, cg[bj][1], cb[bj][1])); *(u32x4*)p = (u32x4){a.x, a.y, bq.x, bq.y}; } }
        } else {
#pragma unroll
            for (int ai = 0; ai < 2; ++ai)
#pragma unroll
                for (int m = 0; m < 4; ++m) { const int row = row0 + ai * 128 + m * 16, b = row >> 11, ts = 32 + (row & 2047); float rstd, t; row_norm(stats, row, rstd, t);
#pragma unroll
                    for (int bj = 0; bj < 2; ++bj) { const int h = 2 * (u.pn - 8) + bj; bf16_t* p = VT + ((size_t)(b * NH + h) * HD + d0) * TS + vperm(ts);
#pragma unroll
                        for (int n = 0; n < 2; ++n) { const u32x2 w = pk4(lnfix(acc[ai][bj][m][n], rstd, t, cg[bj][n], cb[bj][n]));
                            p[(size_t)(4 * n + 0) * TS] = (bf16_t)(w.x & 0xffffu); p[(size_t)(4 * n + 1) * TS] = (bf16_t)(w.x >> 16);
                            p[(size_t)(4 * n + 2) * TS] = (bf16_t)(w.y & 0xffffu); p[(size_t)(4 * n + 3) * TS] = (bf16_t)(w.y >> 16); } } }
        }
    }
    __device__ __forceinline__ void meta(int r, int col, f32x4 a, f32x4) const {
        unsigned char* ws = opaque_ws(ws0); bf16_t* KB = (bf16_t*)(ws + WS_KB); bf16_t* VT = (bf16_t*)(ws + WS_VT); const float *stats, *cgp, *cbp; L.get(ws, stats, cgp, cbp);
        const int row = MREAL + r; float rstd, t; row_norm(stats, row, rstd, t);
        const u32x2 w = pk4(lnfix(a, rstd, t, *(const f32x4*)(cgp + col), *(const f32x4*)(cbp + col))); const int ts = 16 + r;
        if (col < D) { const int h = col >> 7, d = col & 127;
            for (int b = 0; b < NB; ++b) *(u32x2*)(KB + ((size_t)(b * NH + h) * TS + ts) * HD + d) = w;
        } else { const int c2 = col - D, h = c2 >> 7, d = c2 & 127;
            for (int b = 0; b < NB; ++b) { bf16_t* p = VT + ((size_t)(b * NH + h) * HD + d) * TS + vperm(ts);
                p[0] = (bf16_t)(w.x & 0xffffu); p[(size_t)TS] = (bf16_t)(w.x >> 16); p[(size_t)2 * TS] = (bf16_t)(w.y & 0xffffu); p[(size_t)3 * TS] = (bf16_t)(w.y >> 16); } }
    }
};

template <bool PAIR, int KS, int NB = 8, class F>
__device__ __forceinline__ void meta_gemm(const bf16_t* A, int lda, const bf16_t* Bt, int K, int ncols, int wg, int nwg, int wave, int lane, LAS unsigned char* lds, const F& f) {
    constexpr int UPW = 8 / KS;
    const int fr = lane & 15, fq = lane >> 4, nunits = ncols >> 4, kper = K / KS, slot = wave / KS, kbeg = (wave % KS) * kper;
    LAS f32x4* red = (LAS f32x4*)lds;
    for (int u0 = wg * UPW; u0 < nunits; u0 += nwg * UPW) {
        const int u = u0 + slot; const bool live = u < nunits;
        f32x4 acc0 = {0.f, 0.f, 0.f, 0.f}, acc1 = {0.f, 0.f, 0.f, 0.f};
        if (live) {
            int br0 = 16 * u, br1 = 0;
            if (PAIR) { const int j0 = 16 * u; br0 = 256 * (j0 >> 7) + (j0 & 127); br1 = br0 + 128; }
            const bf16_t* ap = A + (size_t)fr * lda + 8 * fq + kbeg;
            const bf16_t* bp0 = Bt + (size_t)(br0 + fr) * K + 8 * fq + kbeg;
            const bf16_t* bp1 = Bt + (size_t)(br1 + fr) * K + 8 * fq + kbeg;
            for (int kb = 0; kb < kper; kb += 32 * NB) {
                bf16x8 av[NB], bv0[NB], bv1[NB];
#pragma unroll
                for (int i = 0; i < NB; ++i) { av[i] = *(const bf16x8*)(ap + kb + 32 * i); bv0[i] = *(const bf16x8*)(bp0 + kb + 32 * i); if (PAIR) bv1[i] = *(const bf16x8*)(bp1 + kb + 32 * i); }
                __builtin_amdgcn_sched_barrier(0);
#pragma unroll
                for (int i = 0; i < NB; ++i) { acc0 = __builtin_amdgcn_mfma_f32_16x16x32_f16(__builtin_bit_cast(h8_t, bv0[i]), __builtin_bit_cast(h8_t, av[i]), acc0, 0, 0, 0);
                    if (PAIR) acc1 = __builtin_amdgcn_mfma_f32_16x16x32_f16(__builtin_bit_cast(h8_t, bv1[i]), __builtin_bit_cast(h8_t, av[i]), acc1, 0, 0, 0); }
                __builtin_amdgcn_sched_barrier(0);
            }
        }
        red[(wave * 2 + 0) * 64 + lane] = acc0; if (PAIR) red[(wave * 2 + 1) * 64 + lane] = acc1;
        __syncthreads();
        if (live && (wave % KS) == 0) {
#pragma unroll
            for (int w = 1; w < KS; ++w) { acc0 = acc0 + red[((wave + w) * 2 + 0) * 64 + lane]; if (PAIR) acc1 = acc1 + red[((wave + w) * 2 + 1) * 64 + lane]; }
            f.meta(fr, 16 * u + 4 * fq, acc0, acc1);
        }
        __syncthreads();
    }
}

#define XB_TMO      128
#define XB_XCNT(j)  (256  + 64 * (j))
#define XB_XSUB(j)  (1280 + 64 * (j))
#define XB_XGEN(j)  (2304 + 64 * (j))
#define XB_TOP      3328
#define XB_TOPGEN   3392
#define XCD_BAR_WORDS 3456
#define XB_SPIN_CAP (1u << 18)
__device__ __forceinline__ unsigned xb_ld(unsigned* p)              { return __hip_atomic_load(p, __ATOMIC_RELAXED, __HIP_MEMORY_SCOPE_AGENT); }
__device__ __forceinline__ unsigned xb_add(unsigned* p, unsigned v) { return __hip_atomic_fetch_add(p, v, __ATOMIC_RELAXED, __HIP_MEMORY_SCOPE_AGENT); }
__device__ __forceinline__ unsigned xb_xcc_id() { return (unsigned)__builtin_amdgcn_s_getreg((3 << 11) | 20) & 0xFu; }
#define XB_SPIN(cond, bar) do { unsigned _sp = 0; while (cond) { __builtin_amdgcn_s_sleep(1); \
    if ((++_sp & 255u) == 0u) { if (xb_ld(&(bar)[XB_TMO])) break; if (_sp > XB_SPIN_CAP) { atomicAdd(&(bar)[XB_TMO], 1u); break; } } } } while (0)
struct XcdBarrier { unsigned* bar; unsigned x; volatile LAS unsigned* st; };
__device__ __forceinline__ XcdBarrier xcd_barrier_post(unsigned* bar, volatile LAS unsigned* st) {
    XcdBarrier b; b.bar = bar; b.x = xb_xcc_id(); b.st = st;
    if (threadIdx.x == 0) (void)xb_add(&bar[XB_XCNT(b.x)], 1u);
    return b;
}
__device__ __forceinline__ void xcd_barrier_complete(unsigned* bar, unsigned x, unsigned& nloc, unsigned& nx) {
    const unsigned G = gridDim.x * gridDim.y * gridDim.z;
    unsigned sum, cnt, mine, sp = 0u;
    for (;;) {
        sum = 0u; cnt = 0u; mine = 0u;
#pragma unroll
        for (unsigned j = 0; j < 16; ++j) { const unsigned c = xb_ld(&bar[XB_XCNT(j)]); sum += c; cnt += (c > 0u) ? 1u : 0u; mine = (j == x) ? c : mine; }
        if (sum == G) break;
        __builtin_amdgcn_s_sleep(1);
        if ((++sp & 255u) == 0u) { if (xb_ld(&bar[XB_TMO])) break; if (sp > XB_SPIN_CAP) { atomicAdd(&bar[XB_TMO], 1u); break; } }
    }
    nloc = mine > 0u ? mine : 1u; nx = cnt > 0u ? cnt : 1u;
}
__device__ __forceinline__ void xcd_barrier(const XcdBarrier& b, int wave) {
    asm volatile("s_waitcnt vmcnt(0)" ::: "memory");
    __syncthreads();
    if (wave == 0 && lane_id() == 0) {
        unsigned* bar = b.bar;
        unsigned bx = (unsigned)__builtin_amdgcn_readfirstlane((int)b.x); asm volatile("" : "+s"(bx));
        __builtin_amdgcn_s_waitcnt(0);
        unsigned nloc = b.st[0], nx = b.st[1];
        if (nloc == 0u) { xcd_barrier_complete(bar, bx, nloc, nx); b.st[0] = nloc; b.st[1] = nx; }
        const unsigned old = xb_add(&bar[XB_XSUB(bx)], 1u);
        const unsigned gen = old / nloc;
        if (old + 1u == (gen + 1u) * nloc) {
            __builtin_amdgcn_fence(__ATOMIC_RELEASE, "agent");
            asm volatile("s_waitcnt vmcnt(0)" ::: "memory");
            const unsigned og = xb_add(&bar[XB_TOP], 1u);
            const unsigned tg = og / nx;
            if (og + 1u == (tg + 1u) * nx) xb_add(&bar[XB_TOPGEN], 1u);
            else XB_SPIN(xb_ld(&bar[XB_TOPGEN]) == tg, bar);
            __builtin_amdgcn_fence(__ATOMIC_ACQUIRE, "agent");
            xb_add(&bar[XB_XGEN(bx)], 1u);
            asm volatile("s_waitcnt vmcnt(0)" ::: "memory");
        } else {
            XB_SPIN(xb_ld(&bar[XB_XGEN(bx)]) == gen, bar);
            __builtin_amdgcn_fence(__ATOMIC_ACQUIRE, "agent");
            asm volatile("s_waitcnt vmcnt(0)" ::: "memory");
        }
    }
    __syncthreads();
}

struct Frame {
    LAS unsigned char* lds;
    int tid, lane, wave, vcu, G, gw, ngw;
    unsigned char* ws;
};
#define LDS_WAIT() asm volatile("s_waitcnt lgkmcnt(0)" ::: "memory")
__device__ __forceinline__ float wave_sum(float v) {
#pragma unroll
    for (int o = 1; o < 64; o <<= 1) v += __shfl_xor(v, o);
    return v;
}

template <int MODE> __device__ __forceinline__ void transpose_item(f32x4 (&v)[12], const float* W, int K, int Nsrc, int srccol0, bf16_t* WT, int dstrow0, int k0, LAS float* scr, int lane, const float* gk, const float* bk, float* cg, float* cb, bool do_atomics = true) {
    if (MODE != 1) { const float* src = W + (size_t)(k0 + (lane >> 3)) * Nsrc + srccol0 + 4 * (lane & 7);
#pragma unroll
        for (int i = 0; i < 8; ++i) v[i] = *(const f32x4*)(src + (size_t)(8 * i) * Nsrc);
        if (gk) { const int c_ = lane & 7; v[8] = *(const f32x4*)(gk + k0 + 8 * c_); v[9] = *(const f32x4*)(gk + k0 + 8 * c_ + 4); v[10] = *(const f32x4*)(bk + k0 + 8 * c_); v[11] = *(const f32x4*)(bk + k0 + 8 * c_ + 4); } }
    if (MODE == 0) return;
#pragma unroll
    for (int i = 0; i < 8; ++i) { LAS float* d = scr + (8 * i + (lane >> 3)) * 33 + 4 * (lane & 7); d[0] = v[i][0]; d[1] = v[i][1]; d[2] = v[i][2]; d[3] = v[i][3]; }
    LDS_WAIT(); asm volatile("" ::: "memory");
    const int c = lane & 7;
    if (gk) {
        const f32x4 g0 = v[8], g1 = v[9], b0 = v[10], b1 = v[11];
        float sg[4], sb[4];
#pragma unroll
        for (int j = 0; j < 4; ++j) { const int n = (lane >> 3) + 8 * j; const LAS float* s = scr + (8 * c) * 33 + n;
            const float w0 = s[0 * 33], w1 = s[1 * 33], w2 = s[2 * 33], w3 = s[3 * 33], w4 = s[4 * 33], w5 = s[5 * 33], w6 = s[6 * 33], w7 = s[7 * 33];
            u32x4 o; o.x = pk2(w0 * g0[0], w1 * g0[1]); o.y = pk2(w2 * g0[2], w3 * g0[3]); o.z = pk2(w4 * g1[0], w5 * g1[1]); o.w = pk2(w6 * g1[2], w7 * g1[3]);
            *(u32x4*)(WT + (size_t)(dstrow0 + n) * K + k0 + 8 * c) = o;
            float a = ((bf_lo(o.x) + bf_hi(o.x)) + (bf_lo(o.y) + bf_hi(o.y))) + ((bf_lo(o.z) + bf_hi(o.z)) + (bf_lo(o.w) + bf_hi(o.w)));
            float bsum = ((w0 * b0[0] + w1 * b0[1]) + (w2 * b0[2] + w3 * b0[3])) + ((w4 * b1[0] + w5 * b1[1]) + (w6 * b1[2] + w7 * b1[3]));
            a += __shfl_xor(a, 1); a += __shfl_xor(a, 2); a += __shfl_xor(a, 4); bsum += __shfl_xor(bsum, 1); bsum += __shfl_xor(bsum, 2); bsum += __shfl_xor(bsum, 4);
            sg[j] = a; sb[j] = bsum; }
        const int srcl = 8 * (lane & 7); float ag = 0.f, ab = 0.f;
#pragma unroll
        for (int j = 0; j < 4; ++j) { const float tg = __shfl(sg[j], srcl), tb = __shfl(sb[j], srcl); if ((lane >> 3) == j) { ag = tg; ab = tb; } }
        if (lane < 32 && do_atomics) { __hip_atomic_fetch_add(cg + dstrow0 + lane, ag, __ATOMIC_RELAXED, __HIP_MEMORY_SCOPE_AGENT); __hip_atomic_fetch_add(cb + dstrow0 + lane, ab, __ATOMIC_RELAXED, __HIP_MEMORY_SCOPE_AGENT); }
    } else {
#pragma unroll
        for (int j = 0; j < 4; ++j) { const int n = (lane >> 3) + 8 * j; const LAS float* s = scr + (8 * c) * 33 + n;
            u32x4 o; o.x = pk2(s[0 * 33], s[1 * 33]); o.y = pk2(s[2 * 33], s[3 * 33]); o.z = pk2(s[4 * 33], s[5 * 33]); o.w = pk2(s[6 * 33], s[7 * 33]);
            *(u32x4*)(WT + (size_t)(dstrow0 + n) * K + k0 + 8 * c) = o; }
    }
    LDS_WAIT(); asm volatile("" ::: "memory");
}
constexpr int IT_W1 = (D / 64) * (FF2 / 32), IT_W2 = (FF / 64) * (D / 32), IT_CIN = (D / 64) * (3 * D / 32), IT_SQ = (D / 64) * (D / 32), IT_KV = (D / 64) * (2 * D / 32);
constexpr int IT_END_W1 = 8 * IT_W1, IT_END_W2 = IT_END_W1 + 8 * IT_W2, IT_END_CIN = IT_END_W2 + 2 * IT_CIN, IT_END_COUT = IT_END_CIN + 2 * IT_SQ, IT_END_WQ = IT_END_COUT + 2 * IT_SQ,
              IT_END_WO = IT_END_WQ + 2 * IT_SQ, IT_TOTAL = IT_END_WO + IT_KV;
constexpr int CGO_W1 = 0, CGO_CIN = 8 * FF2, CGO_WQ = CGO_CIN + 2 * 3 * D, CGO_KV = CGO_WQ + 2 * D;
static_assert(CGO_KV + 2 * D == NCGCB, "cg/cb map");
template <int MODE> __device__ __forceinline__ void prologue_item(f32x4 (&v)[12], Frame& F, const float* ln_g, const float* ln_b, const float* w_in, const float* w_out, const float* cw_in, const float* cw_out, const float* wq, const float* wo, const float* wkv, int it, LAS float* scr, bool do_atomics = true) {
    const float* W; bf16_t* WT; int K, Nsrc, nb, kb, srccol0, dstrow0; int lnq = -1, cgo = 0;
    if (it < IT_END_W1) { const int j = it / IT_W1, r = it % IT_W1; K = D; Nsrc = FF2; W = w_in + (size_t)j * D * FF2; WT = (bf16_t*)(F.ws + WS_W1T + (size_t)j * W1T_BYTES);
        nb = r / (D / 64); kb = r % (D / 64); dstrow0 = 32 * nb; const int pn = dstrow0 >> 8, c = dstrow0 & 255; srccol0 = (c < 128) ? (128 * pn + c) : (FF + 128 * pn + (c - 128));
        const int l = j >> 1; lnq = (j & 1) ? (3 * l + 1) : (3 * l - 1); cgo = CGO_W1 + j * FF2; }
    else if (it < IT_END_W2) { const int q = it - IT_END_W1, j = q / IT_W2, r = q % IT_W2; K = FF; Nsrc = D; W = w_out + (size_t)j * FF * D; WT = (bf16_t*)(F.ws + WS_W2T + (size_t)j * W2T_BYTES);
        nb = r / (FF / 64); kb = r % (FF / 64); dstrow0 = 32 * nb; srccol0 = dstrow0; }
    else if (it < IT_END_CIN) { const int q = it - IT_END_W2, j = q / IT_CIN, r = q % IT_CIN; K = D; Nsrc = 3 * D; W = cw_in + (size_t)j * D * 3 * D; WT = (bf16_t*)(F.ws + WS_WCIN + (size_t)j * WCIN_BYTES);
        nb = r / (D / 64); kb = r % (D / 64); dstrow0 = 32 * nb; const int pn = dstrow0 >> 8, c = dstrow0 & 255;
        srccol0 = (pn < 16) ? ((c < 128) ? (D + 128 * pn + c) : (2 * D + 128 * pn + (c - 128))) : (256 * (pn - 16) + c); lnq = 3 * j; cgo = CGO_CIN + j * 3 * D; }
    else if (it < IT_END_WO) { const int q = it - IT_END_CIN, j = q / IT_SQ, r = q % IT_SQ; K = D; Nsrc = D;
        const float* src = (j < 2) ? cw_out : (j < 4) ? wq : wo; const size_t wsoff = (j < 2) ? WS_WCOUT : (j < 4) ? WS_WQ : WS_WO; const int l = j & 1;
        W = src + (size_t)l * D * D; WT = (bf16_t*)(F.ws + wsoff + (size_t)l * SQ_BYTES);
        nb = r / (D / 64); kb = r % (D / 64); dstrow0 = 32 * nb; srccol0 = dstrow0; if (j == 2 || j == 3) { lnq = 3 * (NCONV + l); cgo = CGO_WQ + l * D; } }
    else { const int r = it - IT_END_WO; K = D; Nsrc = 2 * D; W = wkv; WT = (bf16_t*)(F.ws + WS_WKV); nb = r / (D / 64); kb = r % (D / 64); dstrow0 = 32 * nb; srccol0 = dstrow0; lnq = 3 * (NCONV - 1) + 2; cgo = CGO_KV; }
    const float* gk = (lnq >= 0) ? ln_g + (size_t)lnq * D : nullptr; const float* bk = (lnq >= 0) ? ln_b + (size_t)lnq * D : nullptr;
    transpose_item<MODE>(v, W, K, Nsrc, srccol0, WT, dstrow0, 64 * kb, scr, F.lane, gk, bk, (float*)(F.ws + WS_CG) + cgo, (float*)(F.ws + WS_CB) + cgo, do_atomics);
}
__device__ __forceinline__ void p0_prologue(Frame& F, const float* x, const float* meta, const float* ln_g, const float* ln_b, const float* w_in, const float* w_out, const float* cw_in, const float* cw_out, const float* wq, const float* wo, const float* wkv) {
    LAS float* scr = (LAS float*)(F.lds + RING_OFF + F.wave * 16384);
    {
        f32x4 va[12], vb[12]; const int st = F.ngw; int it = F.gw;
        if (it < IT_TOTAL) prologue_item<0>(va, F, ln_g, ln_b, w_in, w_out, cw_in, cw_out, wq, wo, wkv, it, scr);
        for (; it < IT_TOTAL; it += 2 * st) {
            const bool hb = it + st < IT_TOTAL;
            if (hb) prologue_item<0>(vb, F, ln_g, ln_b, w_in, w_out, cw_in, cw_out, wq, wo, wkv, it + st, scr);
            prologue_item<1>(va, F, ln_g, ln_b, w_in, w_out, cw_in, cw_out, wq, wo, wkv, it, scr);
            if (hb) { if (it + 2 * st < IT_TOTAL) prologue_item<0>(va, F, ln_g, ln_b, w_in, w_out, cw_in, cw_out, wq, wo, wkv, it + 2 * st, scr);
                      prologue_item<1>(vb, F, ln_g, ln_b, w_in, w_out, cw_in, cw_out, wq, wo, wkv, it + st, scr); }
        }
    }
#if EXP_KIND == 4
    { f32x4 vd[12]; for (int it = F.gw; it < IT_TOTAL; it += F.ngw) prologue_item<2>(vd, F, ln_g, ln_b, w_in, w_out, cw_in, cw_out, wq, wo, wkv, it, scr, false); }
#endif
    bf16_t* HBp = (bf16_t*)(F.ws + WS_HB);
    for (int row = F.gw; row < MROWS; row += 2 * F.ngw) {
        const int rowb = (row + F.ngw < MROWS) ? row + F.ngw : row; f32x4 v[2][8];
#pragma unroll
        for (int r = 0; r < 2; ++r) { const int rr = r ? rowb : row; const float* src = (rr < MREAL) ? x + (size_t)rr * D : meta + (size_t)(rr - MREAL) * D;
#pragma unroll
            for (int j = 0; j < 8; ++j) v[r][j] = *(const f32x4*)(src + 4 * F.lane + 256 * j); }
        asm volatile("" ::: "memory");
#pragma unroll
        for (int r = 0; r < 2; ++r) { const int rr = r ? rowb : row;
#pragma unroll
            for (int j = 0; j < 8; ++j) *(u32x2*)(HBp + (size_t)rr * D + 4 * F.lane + 256 * j) = pk4(v[r][j]); }
    }
    { float* st0 = (float*)(F.ws + WS_STATS); float* lng = (float*)(F.ws + WS_LNG); float* lnb = (float*)(F.ws + WS_LNB);
      for (int i = F.gw * 64 + F.lane; i < MROWS; i += F.ngw * 64) { st0[2 * i] = 0.f; st0[2 * i + 1] = (float)D * (1.0f - LN_EPS); }
      for (int i = F.gw * 64 + F.lane; i < 13 * D; i += F.ngw * 64) { lng[i] = (i < D) ? 1.0f : ln_g[i - D]; lnb[i] = (i < D) ? 0.0f : ln_b[i - D]; } }
    bf16_t* KB = (bf16_t*)(F.ws + WS_KB); bf16_t* VT = (bf16_t*)(F.ws + WS_VT);
    for (int bh = F.gw; bh < NB * NH; bh += F.ngw) {
        for (int i = F.lane; i < 16 * HD / 8; i += 64) *(u32x4*)(KB + (size_t)bh * TS * HD + 8 * i) = (u32x4){0u, 0u, 0u, 0u};
        for (int i = F.lane; i < HD * 2; i += 64) *(u32x4*)(VT + ((size_t)bh * HD + (i >> 1)) * TS + 8 * (i & 1)) = (u32x4){0u, 0u, 0u, 0u};
    }
}

__device__ __forceinline__ void final_ln_phase(Frame& F, const float* stats, const float* gain, const float* bias, float* out) {
    const bf16_t* Hb = (const bf16_t*)(F.ws + WS_HB);
    f32x4 g[4][2], bb[4][2];
#pragma unroll
    for (int j = 0; j < 4; ++j)
#pragma unroll
        for (int h = 0; h < 2; ++h) { g[j][h] = *(const f32x4*)(gain + 8 * F.lane + 512 * j + 4 * h); bb[j][h] = *(const f32x4*)(bias + 8 * F.lane + 512 * j + 4 * h); }
    for (int row = F.gw; row < MREAL; row += 2 * F.ngw) {
        const int rowb = (row + F.ngw < MREAL) ? row + F.ngw : row;
        float rs[2], ts[2]; u32x4 w[2][4];
#pragma unroll
        for (int r = 0; r < 2; ++r) { const int rr = r ? rowb : row; row_norm(stats, rr, rs[r], ts[r]); const bf16_t* xr = Hb + (size_t)rr * D + 8 * F.lane;
#pragma unroll
            for (int j = 0; j < 4; ++j) w[r][j] = *(const u32x4*)(xr + 512 * j); }
        asm volatile("" ::: "memory");
#pragma unroll
        for (int r = 0; r < 2; ++r) { const int rr = r ? rowb : row; float* o = out + (size_t)rr * D + 8 * F.lane; const float rstd = rs[r], t = ts[r];
#pragma unroll
            for (int j = 0; j < 4; ++j) { const u32x4 ww = w[r][j];
                const f32x4 v0 = {bf_lo(ww.x), bf_hi(ww.x), bf_lo(ww.y), bf_hi(ww.y)}, v1 = {bf_lo(ww.z), bf_hi(ww.z), bf_lo(ww.w), bf_hi(ww.w)};
                *(f32x4*)(o + 512 * j) = (v0 * rstd + t) * g[j][0] + bb[j][0]; *(f32x4*)(o + 512 * j + 4) = (v1 * rstd + t) * g[j][1] + bb[j][1]; } }
    }
}

__device__ __forceinline__ void unpack8(u32x4 w, float (&f)[8]) { f[0] = bf_lo(w.x); f[1] = bf_hi(w.x); f[2] = bf_lo(w.y); f[3] = bf_hi(w.y); f[4] = bf_lo(w.z); f[5] = bf_hi(w.z); f[6] = bf_lo(w.w); f[7] = bf_hi(w.w); }
__device__ __forceinline__ void conv_phase(Frame& F, const float* cw, const float* cb) {
    const bf16_t* V = (const bf16_t*)(F.ws + WS_ACT); const bf16_t* BG = (const bf16_t*)(F.ws + WS_ACT + ACT_SUB); bf16_t* GG = (bf16_t*)(F.ws + WS_ACT + 2 * ACT_SUB);
    for (int row = F.gw; row < MROWS; row += F.ngw) {
        const bf16_t* cur = V + (size_t)row * D; const bf16_t* p1 = cur; const bf16_t* p2 = cur; float m1 = 1.f, m2 = 1.f;
        if (row < MREAL) { const int t = row & (SEQ - 1);
            if (t >= 2) { p1 = cur - D; p2 = cur - 2 * D; }
            else if (t == 1) { p1 = cur - D; p2 = V + (size_t)(MREAL + 15) * D; }
            else { p1 = V + (size_t)(MREAL + 15) * D; p2 = V + (size_t)(MREAL + 14) * D; }
        } else { const int i = row - MREAL; if (i >= 1) p1 = cur - D; else m1 = 0.f; if (i >= 2) p2 = cur - 2 * D; else m2 = 0.f; }
#pragma unroll
        for (int j = 0; j < 4; ++j) { const int c0 = 8 * (F.lane + 64 * j);
            float a[8], b1[8], b2[8], bg[8];
            unpack8(*(const u32x4*)(cur + c0), a); unpack8(*(const u32x4*)(p1 + c0), b1); unpack8(*(const u32x4*)(p2 + c0), b2); unpack8(*(const u32x4*)(BG + (size_t)row * D + c0), bg);
            float o[8];
#pragma unroll
            for (int h = 0; h < 2; ++h) { const f32x4 w0 = *(const f32x4*)(cw + c0 + 4 * h), w1 = *(const f32x4*)(cw + D + c0 + 4 * h), w2 = *(const f32x4*)(cw + 2 * D + c0 + 4 * h), bbv = *(const f32x4*)(cb + c0 + 4 * h);
#pragma unroll
                for (int e = 0; e < 4; ++e) o[4 * h + e] = bg[4 * h + e] * (w0[e] * (b2[4 * h + e] * m2) + w1[e] * (b1[4 * h + e] * m1) + w2[e] * a[4 * h + e] + bbv[e]); }
            *(u32x4*)(GG + (size_t)row * D + c0) = (u32x4){pk2(o[0], o[1]), pk2(o[2], o[3]), pk2(o[4], o[5]), pk2(o[6], o[7])};
        }
    }
}

#ifndef ATTN_EARLY_EXIT
#define ATTN_EARLY_EXIT 1
#endif
__device__ __forceinline__ void attn_unit(Frame& F, const bf16_t* Qb, bf16_t* Ob, const bf16_t* KB, const bf16_t* VT, int b, int h, int qi) {
    const int lane = F.lane, ql = lane & 31, hh = lane >> 5;
    const bool qvalid = (qi > 0) || (ql >= 16);
    const int qrow = (qi > 0) ? (b * SEQ + 32 * (qi - 1) + ql) : (MREAL + (qvalid ? ql - 16 : 0));
    const bf16_t* qp = Qb + (size_t)qrow * D + h * HD + 8 * hh;
    bf16x8 qf[8];
#pragma unroll
    for (int s = 0; s < 8; ++s) qf[s] = *(const bf16x8*)(qp + 16 * s);
    const bf16_t* kbase = KB + (size_t)(b * NH + h) * TS * HD + (size_t)ql * HD + 8 * hh;
    const bf16_t* vbase = VT + ((size_t)(b * NH + h) * HD + ql) * TS + 8 * hh;
    f32x16 oacc[4];
#pragma unroll
    for (int i = 0; i < 4; ++i)
#pragma unroll
        for (int r = 0; r < 16; ++r) oacc[i][r] = 0.f;
    float C = qvalid ? 0.f : -1e30f;
    const int qs = 32 * qi + ql;
    bf16x8 kf[8]; u32x4 vf[4][2];
#define ATT_LOADK(kt_) do { const bf16_t* kp_ = kbase + (size_t)(32 * (kt_)) * HD; _Pragma("unroll") for (int s = 0; s < 8; ++s) kf[s] = *(const bf16x8*)(kp_ + 16 * s); } while (0)
#define ATT_LOADV(kt_) do { const bf16_t* vp_ = vbase + 32 * (kt_); _Pragma("unroll") for (int blk = 0; blk < 4; ++blk) _Pragma("unroll") for (int s2 = 0; s2 < 2; ++s2) { \
        vf[blk][s2] = *(const u32x4*)(vp_ + (size_t)(32 * blk) * TS + 16 * s2); } } while (0)
    ATT_LOADK(qi); ATT_LOADV(qi);
    __builtin_amdgcn_sched_barrier(0);
    for (int kt = qi; kt >= 0; --kt) {
        f32x16 z;
#pragma unroll
        for (int r = 0; r < 16; ++r) z[r] = 0.f;
#pragma unroll
        for (int s = 0; s < 8; ++s) z = __builtin_amdgcn_mfma_f32_32x32x16_f16(__builtin_bit_cast(h8_t, kf[s]), __builtin_bit_cast(h8_t, qf[s]), z, 0, 0, 0);
        if (kt > 0) ATT_LOADK(kt - 1);
        float lk[16]; float TT;
        const bool edge = (kt == qi) || (kt == 0);
#pragma unroll
        for (int r = 0; r < 16; ++r) { const float zz = z[r], sp = fmaxf(zz, 0.f) + __builtin_amdgcn_logf(1.f + __builtin_amdgcn_exp2f(-fabsf(zz))); z[r] = zz - sp; lk[r] = -sp; }
        if (edge) {
#pragma unroll
            for (int r = 0; r < 16; ++r) { const int ks = 32 * kt + (r & 3) + 8 * (r >> 2) + 4 * hh; const bool vld = (ks < qs) && (ks >= 16); lk[r] = vld ? lk[r] : 0.f; z[r] = vld ? z[r] : -1e30f; }
        }
        float G[4], PG[4];
#pragma unroll
        for (int g = 0; g < 4; ++g) { G[g] = (lk[4 * g] + lk[4 * g + 1]) + (lk[4 * g + 2] + lk[4 * g + 3]); PG[g] = __shfl_xor(G[g], 32); }
        float suf[4]; suf[3] = 0.f; suf[2] = G[3] + PG[3]; suf[1] = suf[2] + (G[2] + PG[2]); suf[0] = suf[1] + (G[1] + PG[1]);
        TT = suf[0] + (G[0] + PG[0]);
#pragma unroll
        for (int g = 0; g < 4; ++g) { const float base = C + suf[g] + (hh == 0 ? PG[g] : 0.f);
            const float s2 = lk[4 * g + 3], s1 = s2 + lk[4 * g + 2], s0 = s1 + lk[4 * g + 1];
            z[4 * g + 0] = __builtin_amdgcn_exp2f(z[4 * g + 0] + (base + s0)); z[4 * g + 1] = __builtin_amdgcn_exp2f(z[4 * g + 1] + (base + s1));
            z[4 * g + 2] = __builtin_amdgcn_exp2f(z[4 * g + 2] + (base + s2)); z[4 * g + 3] = __builtin_amdgcn_exp2f(z[4 * g + 3] + base); }
#define a z
        C += TT;
        bf16x8 pf[2];
#pragma unroll
        for (int s2 = 0; s2 < 2; ++s2) { const u32x4 w = {pk2(a[8 * s2], a[8 * s2 + 1]), pk2(a[8 * s2 + 2], a[8 * s2 + 3]), pk2(a[8 * s2 + 4], a[8 * s2 + 5]), pk2(a[8 * s2 + 6], a[8 * s2 + 7])}; pf[s2] = __builtin_bit_cast(bf16x8, w); }
#undef a
#pragma unroll
        for (int blk = 0; blk < 4; ++blk)
#pragma unroll
            for (int s2 = 0; s2 < 2; ++s2) oacc[blk] = __builtin_amdgcn_mfma_f32_32x32x16_f16(__builtin_bit_cast(h8_t, vf[blk][s2]), __builtin_bit_cast(h8_t, pf[s2]), oacc[blk], 0, 0, 0);
#if ATTN_EARLY_EXIT
        if (__all(C < -151.0f)) break;
#endif
        if (kt > 0) ATT_LOADV(kt - 1);
    }
#undef ATT_LOADK
#undef ATT_LOADV
    if (qvalid) { bf16_t* op = Ob + (size_t)qrow * D + h * HD + 4 * hh;
#pragma unroll
        for (int blk = 0; blk < 4; ++blk)
#pragma unroll
            for (int g = 0; g < 4; ++g) *(u32x2*)(op + 32 * blk + 8 * g) = pk4((f32x4){oacc[blk][4 * g], oacc[blk][4 * g + 1], oacc[blk][4 * g + 2], oacc[blk][4 * g + 3]}); }
}
__device__ __forceinline__ void attn_phase(Frame& F) {
    const bf16_t* Qb = (const bf16_t*)(F.ws + WS_ACT); bf16_t* Ob = (bf16_t*)(F.ws + WS_ACT + ACT_SUB);
    const bf16_t* KB = (const bf16_t*)(F.ws + WS_KB); const bf16_t* VT = (const bf16_t*)(F.ws + WS_VT);
    int k = 0;
    for (int u = F.gw; u < NB * NH * 64; u += F.ngw, ++k) {
        F.lane = lane_id();
        const int bh = u >> 6, q0 = u & 63, qi = (k & 1) ? (64 - q0) : (1 + q0); attn_unit(F, Qb, Ob, KB, VT, bh >> 4, bh & 15, qi);
    }
}

struct Args { const float* in[13]; float* out; unsigned char* ws; };
__global__ void __launch_bounds__(NWAVES * 64, 2) yoco_fwd(Args args) {
    extern __shared__ __attribute__((aligned(16))) unsigned char lds[];
    Frame F;
    F.lds = (LAS unsigned char*)lds;
    F.tid = threadIdx.x; F.lane = F.tid & 63; F.wave = __builtin_amdgcn_readfirstlane(F.tid >> 6);
    F.G = gridDim.x; { const int bx = blockIdx.x; F.vcu = (F.G % 8 == 0) ? (bx % 8) * (F.G / 8) + bx / 8 : bx; }
    F.gw = F.vcu * NWAVES + F.wave; F.ngw = F.G * NWAVES;
    F.ws = args.ws;
    for (int u = F.tid; u < (LDS_BYTES - LDSCTL_OFF) / 4; u += NWAVES * 64) ((LAS unsigned*)(F.lds + LDSCTL_OFF))[u] = 0u;
    __syncthreads();
    unsigned* ctl = (unsigned*)(F.ws + WS_CTL);
    XcdBarrier bar = xcd_barrier_post(ctl + CW_BAR, (volatile LAS unsigned*)(F.lds + MISC_OFF) + 8);
#if PROBE
#define prof ((unsigned long long*)(F.ws + WS_CTL + 65536))
    if (blockIdx.x == 0 && threadIdx.x == 0) prof[31] = __builtin_amdgcn_s_memrealtime();
#define PACC(slot) do { if (blockIdx.x == 0 && threadIdx.x == 0) { const unsigned long long n_ = __builtin_amdgcn_s_memrealtime(); prof[slot] += n_ - prof[31]; prof[31] = n_; } } while (0)
#else
#define PACC(slot) do { } while (0)
#endif
#if EXP_KIND == 7
#define GRID_BAR() do { xcd_barrier(bar, F.wave); xcd_barrier(bar, F.wave); PHASE_BEGIN(); PACC(3); } while (0)
#else
#define GRID_BAR() do { xcd_barrier(bar, F.wave); PHASE_BEGIN(); PACC(3); } while (0)
#endif
#define PHASE_BEGIN() do { const int l_ = lane_id(); F.lane = l_; F.tid = F.wave * 64 + l_; F.gw = F.vcu * NWAVES + F.wave; \
        unsigned long long w_ = (unsigned long long)args.ws; asm volatile("" : "+s"(w_)); F.ws = (unsigned char*)(GAS unsigned char*)w_; } while (0)
#define HB ((bf16_t*)(F.ws + WS_HB))
#define ACT ((bf16_t*)(F.ws + WS_ACT))

#define STATS(q) ((float*)(F.ws + WS_STATS + (size_t)(q) * STATS_BYTES))
#define CGV(o) ((const float*)(F.ws + WS_CG) + (o))
#define CBV(o) ((const float*)(F.ws + WS_CB) + (o))
    PHASE_BEGIN();
    p0_prologue(F, args.in[0], args.in[1], args.in[2], args.in[3], args.in[4], args.in[5], args.in[6], args.in[9], args.in[10], args.in[12], args.in[11]);
    PACC(2); GRID_BAR();

    for (int l = 0; l < DEPTH; ++l) {
        for (int s = 0; s < 2; ++s) {
            const int qin = (s == 1) ? (1 + 3 * l + 1) : (l == 0 ? 0 : 1 + 3 * (l - 1) + 2), qout = 1 + 3 * l + (s == 0 ? 0 : 2);
            { const bf16_t* W1 = (const bf16_t*)(F.ws + WS_W1T + (size_t)(2 * l + s) * W1T_BYTES);
              pg8::Gemm g{HB, W1, MREAL, FF2, D}; pg8::StaticOrder S; S.init(MREAL, FF2, F.G, (int)blockIdx.x);
              EpiSwiglu E{F.ws, LnFold{qin, CGO_W1 + (2 * l + s) * FF2}, F.G == 256};
#if PROBE && PROBE_A == 16
              pg8::gemm_phase<EpiSwiglu, pg8::StaticOrder, true, GEMM_SP, true>(F.lds + RING_OFF, g, S, E, (l == 0 && s == 0) ? prof + 16 : prof + 24);
#else
#if EXP_KIND == 12
              { RangeOrder R; R.init(MREAL, FF2, F.G, (int)blockIdx.x); int nrep = 2; asm volatile("" : "+s"(nrep));
                for (int rep = 0; rep < nrep; ++rep) { R.r0 = rep ? 5 : 0; R.r1 = rep ? 11 : 5; pg8::gemm_phase<EpiSwiglu, RangeOrder, true, GEMM_SP>(F.lds + RING_OFF, g, R, E); if (rep == 0) GRID_BAR(); } }
#else
#if EXP_UP_TWICE
              int nrep = 2; asm volatile("" : "+s"(nrep)); for (int rep = 0; rep < nrep; ++rep)
#endif
              pg8::gemm_phase<EpiSwiglu, pg8::StaticOrder, true, GEMM_SP, false, EXP_EPI_TWICE != 0>(F.lds + RING_OFF, g, S, E);
#endif
#endif
#if EXP_KIND == 1
              { EpiNull EN; pg8::gemm_phase<EpiNull, pg8::StaticOrder, true, GEMM_SP>(F.lds + RING_OFF, g, S, EN); }
#elif EXP_KIND == 25
              { EpiNull EN; pg8::Gemm gc{HB, (const bf16_t*)(F.ws + WS_W1T + (size_t)((2 * l + s + 4) & 7) * W1T_BYTES), MREAL, FF2, D}; pg8::gemm_phase<EpiNull, pg8::StaticOrder, true, GEMM_SP>(F.lds + RING_OFF, gc, S, EN); }
#elif EXP_KIND == 2
              { EpiNull EN; FakeOrder FO; FO.nun = 11; pg8::gemm_phase<EpiNull, FakeOrder, true, GEMM_SP>(F.lds + RING_OFF, g, FO, EN); }
#elif EXP_KIND == 21 || EXP_KIND == 22 || EXP_KIND == 23 || EXP_KIND == 24
              { EpiNull EN; FakeOrder FO; FO.nun = 11; pg8::gemm_phase<EpiNull, FakeOrder, true, GEMM_SP, false, false, EXP_KIND - 20>(F.lds + RING_OFF, g, FO, EN); }
#elif EXP_KIND == 3
              { EpiNull EN; pg8::gemm_phase<EpiNull, pg8::StaticOrder, true, 0>(F.lds + RING_OFF, g, S, EN); }
#endif
#if EXP_KIND == 14
              meta_gemm<true, 4>(HB + (size_t)MREAL * D, D, W1, D, FF, (int)blockIdx.x, F.G, F.wave, lane_id(), F.lds + RING_OFF, E);
#endif
              if (l < NCONV) meta_gemm<true, 4>(HB + (size_t)MREAL * D, D, W1, D, FF, (int)blockIdx.x, F.G, F.wave, lane_id(), F.lds + RING_OFF, E); }
            PACC(4); GRID_BAR();
            { const bf16_t* W2 = (const bf16_t*)(F.ws + WS_W2T + (size_t)(2 * l + s) * W2T_BYTES);
              pg8::Gemm g{ACT, W2, MREAL, D, FF}; pg8::StaticOrder S; S.init(MREAL, D, F.G, (int)blockIdx.x);
              EpiResidLN E{F.ws, qin, qout, 0.5f};
#if PROBE && PROBE_A == 18
              pg8::gemm_phase<EpiResidLN, pg8::StaticOrder, true, GEMM_SP, true>(F.lds + RING_OFF, g, S, E, (l == 0 && s == 0) ? prof + 18 : prof + 26);
#else
              pg8::gemm_phase<EpiResidLN, pg8::StaticOrder, true, GEMM_SP>(F.lds + RING_OFF, g, S, E);
#if EXP_KIND == 9
              { EpiNull EN; pg8::gemm_phase<EpiNull, pg8::StaticOrder, true, GEMM_SP>(F.lds + RING_OFF, g, S, EN); }
#elif EXP_KIND == 11
              { EpiResidLN ED{F.ws, qin, 13, 0.5f}; pg8::gemm_phase<EpiResidLN, pg8::StaticOrder, true, GEMM_SP>(F.lds + RING_OFF, g, S, ED); }
#endif
#endif
              if (l < NCONV) meta_gemm<false, 8, 11>(ACT + (size_t)MREAL * FF, FF, W2, FF, D, (int)blockIdx.x, F.G, F.wave, lane_id(), F.lds + RING_OFF, E); }
            PACC(5); GRID_BAR();
            if (s == 0) {
                const int q0 = 1 + 3 * l, q1 = q0 + 1;
                if (l < NCONV) {
                    { const bf16_t* Wc = (const bf16_t*)(F.ws + WS_WCIN + (size_t)l * WCIN_BYTES);
                      pg8::Gemm g{HB, Wc, MREAL, 3 * D, D}; pg8::StaticOrder S; S.init(MREAL, 3 * D, F.G, (int)blockIdx.x);
                      const LnFold L{q0, CGO_CIN + l * 3 * D};
                      EpiConvIn E{F.ws, L, F.G == 256};
#if EXP_KIND == 13
                      int nrep = 2; asm volatile("" : "+s"(nrep)); for (int rep = 0; rep < nrep; ++rep)
#endif
                      pg8::gemm_phase<EpiConvIn, pg8::StaticOrder, true, GEMM_SP>(F.lds + RING_OFF, g, S, E);
                      MetaConvV EV{F.ws, L}; meta_gemm<true, 8>(HB + (size_t)MREAL * D, D, Wc, D, D, (int)blockIdx.x, F.G, F.wave, lane_id(), F.lds + RING_OFF, EV);
                      EpiBf16S EB{F.ws, WS_ACT + ACT_SUB, 1.0f, LnFold{q0, CGO_CIN + l * 3 * D + 2 * D}};
                      meta_gemm<false, 8>(HB + (size_t)MREAL * D, D, Wc + (size_t)(2 * D) * D, D, D, (int)blockIdx.x, F.G, F.wave, lane_id(), F.lds + RING_OFF, EB); }
                    PACC(6); GRID_BAR();
                    conv_phase(F, args.in[7] + (size_t)l * 3 * D, args.in[8] + (size_t)l * D);
#if EXP_KIND == 6
                    conv_phase(F, args.in[7] + (size_t)l * 3 * D, args.in[8] + (size_t)l * D);
#endif
                    PACC(7); GRID_BAR();
                    { const bf16_t* Wo = (const bf16_t*)(F.ws + WS_WCOUT + (size_t)l * SQ_BYTES); const bf16_t* GG = (const bf16_t*)(F.ws + WS_ACT + 2 * ACT_SUB);
                      pg8::Gemm g{GG, Wo, MREAL, D, D}; pg8::StaticOrder S; S.init(MREAL, D, F.G, (int)blockIdx.x);
                      EpiResidLN E{F.ws, q0, q1, 1.0f};
                      pg8::gemm_phase<EpiResidLN, pg8::StaticOrder, true, GEMM_SP>(F.lds + RING_OFF, g, S, E);
                      meta_gemm<false, 8>(GG + (size_t)MREAL * D, D, Wo, D, D, (int)blockIdx.x, F.G, F.wave, lane_id(), F.lds + RING_OFF, E); }
                } else {
                    const int j = l - NCONV;
                    { const bf16_t* Wq = (const bf16_t*)(F.ws + WS_WQ + (size_t)j * SQ_BYTES);
                      pg8::Gemm g{HB, Wq, MREAL, D, D}; pg8::StaticOrder S; S.init(MREAL, D, F.G, (int)blockIdx.x);
                      EpiBf16S E{F.ws, WS_ACT, QSCALE, LnFold{q0, CGO_WQ + j * D}, F.G == 256};
#if EXP_KIND == 10
                      int nrep = 2; asm volatile("" : "+s"(nrep)); for (int rep = 0; rep < nrep; ++rep)
#endif
                      pg8::gemm_phase<EpiBf16S, pg8::StaticOrder, true, GEMM_SP>(F.lds + RING_OFF, g, S, E);
                    }
                    PACC(9); GRID_BAR();
                    attn_phase(F);
#if EXP_KIND == 5
                    attn_phase(F);
#endif
                    PACC(10); GRID_BAR();
                    { const bf16_t* Wo = (const bf16_t*)(F.ws + WS_WO + (size_t)j * SQ_BYTES); const bf16_t* Ob = (const bf16_t*)(F.ws + WS_ACT + ACT_SUB);
                      pg8::Gemm g{Ob, Wo, MREAL, D, D}; pg8::StaticOrder S; S.init(MREAL, D, F.G, (int)blockIdx.x);
                      EpiResidLN E{F.ws, q0, q1, 1.0f};
                      pg8::gemm_phase<EpiResidLN, pg8::StaticOrder, true, GEMM_SP>(F.lds + RING_OFF, g, S, E);
                    }
                }
                PACC(8); GRID_BAR();
            }
        }
        if (l == NCONV - 1) {
            const bf16_t* Wkv = (const bf16_t*)(F.ws + WS_WKV); const int q = 1 + 3 * l + 2;
            pg8::Gemm g{HB, Wkv, MREAL, 2 * D, D}; pg8::StaticOrder S; S.init(MREAL, 2 * D, F.G, (int)blockIdx.x);
            EpiKV E{F.ws, LnFold{q, CGO_KV}};
#if EXP_KIND == 8
            int nrep = 2; asm volatile("" : "+s"(nrep)); for (int rep = 0; rep < nrep; ++rep)
#endif
            pg8::gemm_phase<EpiKV, pg8::StaticOrder, true, GEMM_SP>(F.lds + RING_OFF, g, S, E);
            meta_gemm<false, 8>(HB + (size_t)MREAL * D, D, Wkv, D, 2 * D, (int)blockIdx.x, F.G, F.wave, lane_id(), F.lds + RING_OFF, E);
            PACC(12); GRID_BAR();
        }
    }
    final_ln_phase(F, (const float*)(F.ws + WS_STATS + (size_t)(1 + 3 * (DEPTH - 1) + 2) * STATS_BYTES), args.in[2] + (size_t)(3 * (DEPTH - 1) + 2) * D, args.in[3] + (size_t)(3 * (DEPTH - 1) + 2) * D, args.out);
#if PROBE
    PACC(13); GRID_BAR();
    if (blockIdx.x == 0) {
        const float a_us = (float)prof[PROBE_A] * 0.01f, b_us = (float)prof[PROBE_B] * 0.01f;
        if (threadIdx.x == 0) args.out[0] += 100.f * a_us;
        for (int i = 1 + (int)threadIdx.x; i <= 4194304; i += 512) args.out[i] += b_us;
    }
#endif
}

extern "C" void kernel_launch(void* const* d_in, const int* in_sizes, int n_in, void* d_out, int out_size, void* d_ws, size_t ws_size, hipStream_t stream) {
    static int grid = 0;
    if (grid == 0) {
        if (n_in != 13 || in_sizes[0] != MREAL * D || out_size != MREAL * D || ws_size < WS_END) { fprintf(stderr, "kernel_launch: unexpected shapes (n_in %d, in0 %d, out %d, ws %zu)\n", n_in, n_in > 0 ? in_sizes[0] : -1, out_size, ws_size); grid = -1; return; }
        int dev = 0, cus = 0;
        if (hipGetDevice(&dev) != hipSuccess || hipDeviceGetAttribute(&cus, hipDeviceAttributeMultiprocessorCount, dev) != hipSuccess) { grid = -1; return; }
        if (hipFuncSetAttribute((const void*)yoco_fwd, hipFuncAttributeMaxDynamicSharedMemorySize, LDS_BYTES) != hipSuccess) { fprintf(stderr, "kernel_launch: hipFuncSetAttribute failed\n"); grid = -1; return; }
        int per_cu = 0;
        if (hipOccupancyMaxActiveBlocksPerMultiprocessor(&per_cu, (const void*)yoco_fwd, NWAVES * 64, LDS_BYTES) != hipSuccess || per_cu < 1) fprintf(stderr, "kernel_launch: occupancy query says %d\n", per_cu);
        (void)hipGetLastError();
        grid = cus;
    }
    if (grid < 0) return;
    if (hipMemsetAsync((char*)d_ws + WS_CTL, 0, CTL_ZERO_BYTES, stream) != hipSuccess) return;
    Args a{};
    for (int i = 0; i < 13; ++i) a.in[i] = (const float*)d_in[i];
    a.out = (float*)d_out; a.ws = (unsigned char*)d_ws;
    hipLaunchKernelGGL(yoco_fwd, dim3(grid), dim3(NWAVES * 64), LDS_BYTES, stream, a);
}
```
